# Optimizing an MI355X kernel written in HIP

```python
import jax, jax.numpy as jnp
from jax import lax
import numpy as np

D_MODEL = 1024
BATCH = 32
SEQ = 256
DEPTH = 2
DEC_BATCH = 8
DEC_SEQ = 1024
PAST_LEN = 512

GRID_W = 64
N_MIXERS = 2
N_GLA_LAYERS = (DEPTH + 1) // 2
N_RWKV_LAYERS = DEPTH // 2
EPS = 1e-6
GLA_HEADS = 4
GLA_DK = D_MODEL // 2
GLA_DV = D_MODEL
GLA_DKH = GLA_DK // GLA_HEADS
GLA_DVH = GLA_DV // GLA_HEADS
GLA_IN = 2 * GLA_DK + 2 * GLA_DV
GLA_GATE_RANK = 16
GLA_GATE_NORM = 16.0
GLA_CHUNK = 64
RWKV_HEAD = 64
RWKV_HEADS = D_MODEL // RWKV_HEAD
RWKV_W_RANK = 64
RWKV_A_RANK = 64
RWKV_N_MIX = 6
LNX_EPS = 64e-5

kernel_name = "bidir_gla_rwkv7_flow_trunk"

F32 = jnp.float32


def rmsnorm(x, w):
    x32 = x.astype(F32)
    y = x32 * lax.rsqrt(jnp.mean(x32 * x32, axis=-1, keepdims=True) + EPS)
    return (y * w.astype(F32)).astype(x.dtype)


def shift_ctx(x):
    p = jnp.pad(x, ((0, 0), (1, 1), (0, 0)))
    return 0.5 * (p[:, :-2] + p[:, 2:])


def shift_grid(x):
    B, T, D = x.shape
    rows = T // GRID_W
    g = x.reshape(B, rows, GRID_W, D)
    p = jnp.pad(g, ((0, 0), (1, 1), (1, 1), (0, 0)))
    nb = 0.25 * (p[:, :-2, 1:-1] + p[:, 2:, 1:-1] + p[:, 1:-1, :-2] + p[:, 1:-1, 2:])
    return nb.reshape(B, T, D)


def gla_chunked(q, k, v, log_a, s0):
    B, T, H, _ = q.shape
    dv = v.shape[-1]
    n = T // GLA_CHUNK
    ch = lambda t: t.astype(F32).reshape(B, n, GLA_CHUNK, H, t.shape[-1])
    qc, kc, vc, gc = ch(q), ch(k), ch(v), ch(log_a)
    b = jnp.cumsum(gc, axis=2)
    b_last = b[:, :, -1:]
    qb = qc * jnp.exp(b)
    kb = kc * jnp.exp(-b)
    kd = kc * jnp.exp(b_last - b)
    scores = jnp.einsum('bnchd,bnshd->bnhcs', qb, kb)
    causal = jnp.tril(jnp.ones((GLA_CHUNK, GLA_CHUNK), dtype=bool))
    scores = jnp.where(causal, scores, 0.0)
    o_intra = jnp.einsum('bnhcs,bnshe->bnche', scores, vc)
    u = jnp.einsum('bnchd,bnche->bnhde', kd, vc)
    decay = jnp.exp(b_last[:, :, 0])

    def step(s, inp):
        dec, uu = inp
        return dec[..., None] * s + uu, s

    s_fin, s_start = lax.scan(step, s0.astype(F32), (jnp.moveaxis(decay, 1, 0), jnp.moveaxis(u, 1, 0)))
    s_start = jnp.moveaxis(s_start, 0, 1)
    o_inter = jnp.einsum('bnchd,bnhde->bnche', qb, s_start)
    return (o_intra + o_inter).reshape(B, T, H, dv), s_fin


def gla_mixer(h, w_in, w_a1, w_a2, b_a, w_norm, w_out, s0_fwd, s0_bwd):
    B, T, _ = h.shape
    q, k, v, g = jnp.split(h @ w_in, [GLA_DK, 2 * GLA_DK, 2 * GLA_DK + GLA_DV], axis=-1)
    q = q.reshape(B, T, GLA_HEADS, GLA_DKH) * (GLA_DKH ** -0.5)
    k = k.reshape(B, T, GLA_HEADS, GLA_DKH)
    v = v.reshape(B, T, GLA_HEADS, GLA_DVH)

    def log_gate(d):
        z = (h @ w_a1[d]) @ w_a2[d] + b_a[d]
        return (jax.nn.log_sigmoid(z.astype(F32)) / GLA_GATE_NORM).reshape(B, T, GLA_HEADS, GLA_DKH)

    flip = lambda t: jnp.flip(t, axis=1)
    o_f, s_f = gla_chunked(q, k, v, log_gate(0), s0_fwd)
    o_b, s_b = gla_chunked(flip(q), flip(k), flip(v), flip(log_gate(1)), s0_bwd)
    o = o_f + flip(o_b)
    o = o * lax.rsqrt(jnp.mean(o * o, axis=-1, keepdims=True) + EPS) * w_norm.astype(F32)
    o = o.reshape(B, T, GLA_DV).astype(h.dtype) * jax.nn.silu(g)
    return o @ w_out, jnp.stack([s_f, s_b], axis=1).astype(h.dtype)


def rwkv7_scan(r, decay, k, v, a_vec, b_vec, s0):
    def step(s, inp):
        rt, wt, kt, vt, at, bt = inp
        sa = jnp.einsum('bhij,bhj->bhi', s, at)
        s = s * wt[:, :, None, :] + sa[..., None] * bt[:, :, None, :] + vt[..., None] * kt[:, :, None, :]
        return s, jnp.einsum('bhij,bhj->bhi', s, rt)

    xs = tuple(jnp.moveaxis(t.astype(F32), 1, 0) for t in (r, decay, k, v, a_vec, b_vec))
    s_fin, ys = lax.scan(step, s0.astype(F32), xs)
    return jnp.moveaxis(ys, 0, 1), s_fin


def rwkv7_mixer(h, h_shift, mu, w_rkvg, w0, w1, w2, a0, a1, a2, k_k, k_a, r_k, lnx_w, lnx_b, w_out,
                s0_fwd, s0_bwd):
    B, T, D = h.shape
    xm = h[None] + (h_shift - h)[None] * mu[:, None, None, :]
    r, k, v, g = jnp.einsum('pbtd,pde->pbte', xm[:4], w_rkvg)
    xw, xa = xm[4], xm[5]
    heads = lambda t: t.reshape(B, T, RWKV_HEADS, RWKV_HEAD)
    flip = lambda t: jnp.flip(t, axis=1)
    rh, vh = heads(r), heads(v)
    y_sum = 0.0
    bonus = 0.0
    states = []
    for d in range(2):
        w_log = -jax.nn.softplus(-(w0[d] + jnp.tanh(xw @ w1[d]) @ w2[d])) - 0.5
        decay = jnp.exp(-jnp.exp(w_log.astype(F32)))
        a = jax.nn.sigmoid(a0[d] + (xa @ a1[d]) @ a2[d])
        kk = heads(k * k_k[d]).astype(F32)
        kk = kk / jnp.maximum(jnp.sqrt(jnp.sum(kk * kk, axis=-1, keepdims=True)), 1e-12)
        kd = heads(k * (1.0 + (a - 1.0) * k_a[d]))
        ins = (rh, heads(decay), kd, vh, -kk, kk * heads(a).astype(F32))
        s0 = s0_fwd if d == 0 else s0_bwd
        if d == 1:
            ins = tuple(flip(t) for t in ins)
        y, s = rwkv7_scan(*ins, s0)
        y_sum = y_sum + (flip(y) if d == 1 else y)
        states.append(s)
        bonus = bonus + jnp.sum((rh * kd * r_k[d]).astype(F32), axis=-1, keepdims=True) * vh.astype(F32)
    mean = jnp.mean(y_sum, axis=-1, keepdims=True)
    var = jnp.mean(jnp.square(y_sum - mean), axis=-1, keepdims=True)
    yn = ((y_sum - mean) * lax.rsqrt(var + LNX_EPS)).reshape(B, T, D) * lnx_w.astype(F32) + lnx_b.astype(F32)
    o = (yn + bonus.reshape(B, T, D)).astype(h.dtype) * jax.nn.silu(g)
    return o @ w_out, jnp.stack(states, axis=1).astype(h.dtype)


def run_trunk(x, cond, shift_fn, gla_s0, rwkv_s0, p):
    gla_states, rwkv_states = [], []
    for i in range(DEPTH):
        mod = (jax.nn.silu(cond) @ p['w_mod'][i] + p['b_mod'][i])[:, None, :]
        shift, scale, gate = jnp.split(mod, 3, axis=-1)
        h = rmsnorm(x, p['norm_w'][i]) * (1.0 + scale) + shift
        j = i // N_MIXERS
        if i % N_MIXERS == 0:
            out, s = gla_mixer(h, p['gla_w_in'][j], p['gla_w_a1'][j], p['gla_w_a2'][j], p['gla_b_a'][j],
                               p['gla_norm'][j], p['gla_w_out'][j], gla_s0[:, j, 0], gla_s0[:, j, 1])
            gla_states.append(s)
        else:
            out, s = rwkv7_mixer(h, shift_fn(h), p['rwkv_mu'][j], p['rwkv_w_rkvg'][j], p['rwkv_w0'][j],
                                 p['rwkv_w1'][j], p['rwkv_w2'][j], p['rwkv_a0'][j], p['rwkv_a1'][j],
                                 p['rwkv_a2'][j], p['rwkv_k_k'][j], p['rwkv_k_a'][j], p['rwkv_r_k'][j],
                                 p['rwkv_lnx_w'][j], p['rwkv_lnx_b'][j], p['rwkv_w_out'][j],
                                 rwkv_s0[:, j, 0], rwkv_s0[:, j, 1])
            rwkv_states.append(s)
        x = x + gate * out
    return rmsnorm(x, p['norm_f']), jnp.stack(gla_states, axis=1), jnp.stack(rwkv_states, axis=1)


def setup_inputs(seed: int = 0) -> dict:
    key = jax.random.key(seed)
    ks = iter(list(jax.random.split(key, 40)))
    nrm = lambda shape, s: jax.random.normal(next(ks), shape, F32) * s
    uni = lambda shape, lo, hi: jax.random.uniform(next(ks), shape, F32, minval=lo, maxval=hi)
    D, Lg, Lr = D_MODEL, N_GLA_LAYERS, N_RWKV_LAYERS
    return {
        "x_prompt": nrm((BATCH, SEQ, D), 1.0),
        "x_sample": nrm((DEC_BATCH, DEC_SEQ, D), 1.0),
        "state_gla": nrm((DEC_BATCH, Lg, 2, GLA_HEADS, GLA_DKH, GLA_DVH), 1.0),
        "state_rwkv": nrm((DEC_BATCH, Lr, 2, RWKV_HEADS, RWKV_HEAD, RWKV_HEAD), 0.3),
        "c": nrm((DEC_BATCH, D), 1.0),
        "c_ctx": nrm((D,), 1.0),
        "w_mod": nrm((DEPTH, D, 3 * D), 0.5 * D ** -0.5),
        "b_mod": nrm((DEPTH, 3 * D), 0.02),
        "norm_w": 1.0 + nrm((DEPTH, D), 0.02),
        "gla_w_in": nrm((Lg, D, GLA_IN), D ** -0.5),
        "gla_w_a1": nrm((Lg, 2, D, GLA_GATE_RANK), D ** -0.5),
        "gla_w_a2": nrm((Lg, 2, GLA_GATE_RANK, GLA_DK), GLA_GATE_RANK ** -0.5),
        "gla_b_a": 1.0 + nrm((Lg, 2, GLA_DK), 0.5),
        "gla_norm": 1.0 + nrm((Lg, GLA_DVH), 0.02),
        "gla_w_out": nrm((Lg, GLA_DV, D), GLA_DV ** -0.5),
        "rwkv_mu": uni((Lr, RWKV_N_MIX, D), 0.0, 1.0),
        "rwkv_w_rkvg": nrm((Lr, 4, D, D), D ** -0.5),
        "rwkv_w0": uni((Lr, 2, D), -6.0, 1.0),
        "rwkv_w1": nrm((Lr, 2, D, RWKV_W_RANK), D ** -0.5),
        "rwkv_w2": nrm((Lr, 2, RWKV_W_RANK, D), 0.1 * RWKV_W_RANK ** -0.5),
        "rwkv_a0": nrm((Lr, 2, D), 0.1),
        "rwkv_a1": nrm((Lr, 2, D, RWKV_A_RANK), D ** -0.5),
        "rwkv_a2": nrm((Lr, 2, RWKV_A_RANK, D), 0.1 * RWKV_A_RANK ** -0.5),
        "rwkv_k_k": 0.85 + nrm((Lr, 2, D), 0.02),
        "rwkv_k_a": 1.0 + nrm((Lr, 2, D), 0.02),
        "rwkv_r_k": nrm((Lr, 2, RWKV_HEADS, RWKV_HEAD), 0.1),
        "rwkv_lnx_w": 1.0 + nrm((Lr, D), 0.02),
        "rwkv_lnx_b": nrm((Lr, D), 0.02),
        "rwkv_w_out": nrm((Lr, D, D), D ** -0.5),
        "norm_f": 1.0 + nrm((D,), 0.02),
    }


def reference(x_prompt, x_sample, state_gla, state_rwkv, c, c_ctx, w_mod, b_mod, norm_w,
              gla_w_in, gla_w_a1, gla_w_a2, gla_b_a, gla_norm, gla_w_out,
              rwkv_mu, rwkv_w_rkvg, rwkv_w0, rwkv_w1, rwkv_w2, rwkv_a0, rwkv_a1, rwkv_a2,
              rwkv_k_k, rwkv_k_a, rwkv_r_k, rwkv_lnx_w, rwkv_lnx_b, rwkv_w_out, norm_f):
    p = dict(w_mod=w_mod, b_mod=b_mod, norm_w=norm_w, gla_w_in=gla_w_in, gla_w_a1=gla_w_a1,
             gla_w_a2=gla_w_a2, gla_b_a=gla_b_a, gla_norm=gla_norm, gla_w_out=gla_w_out,
             rwkv_mu=rwkv_mu, rwkv_w_rkvg=rwkv_w_rkvg, rwkv_w0=rwkv_w0, rwkv_w1=rwkv_w1,
             rwkv_w2=rwkv_w2, rwkv_a0=rwkv_a0, rwkv_a1=rwkv_a1, rwkv_a2=rwkv_a2, rwkv_k_k=rwkv_k_k,
             rwkv_k_a=rwkv_k_a, rwkv_r_k=rwkv_r_k, rwkv_lnx_w=rwkv_lnx_w, rwkv_lnx_b=rwkv_lnx_b,
             rwkv_w_out=rwkv_w_out, norm_f=norm_f)
    Bp = x_prompt.shape[0]
    zero_gla = jnp.zeros((Bp, N_GLA_LAYERS, 2, GLA_HEADS, GLA_DKH, GLA_DVH), x_prompt.dtype)
    zero_rwkv = jnp.zeros((Bp, N_RWKV_LAYERS, 2, RWKV_HEADS, RWKV_HEAD, RWKV_HEAD), x_prompt.dtype)
    y_prompt, new_state_gla, new_state_rwkv = run_trunk(x_prompt, c_ctx[None, :], shift_ctx,
                                                        zero_gla, zero_rwkv, p)
    y_sample, _, _ = run_trunk(x_sample, c, shift_grid, state_gla, state_rwkv, p)
    return (y_prompt, y_sample, new_state_gla, new_state_rwkv)
```

```cpp
#include <hip/hip_runtime.h>
#include <cstdio>
#include <cstdint>
constexpr int NWAVES = 8, NTHR = 512;
#ifndef MK_N_LAUNCHES
#define MK_N_LAUNCHES 1
#endif
constexpr int N_PHASES = 12;
constexpr int N_LAUNCHES = MK_N_LAUNCHES;
constexpr int M = 16384, D = 1024, MP = 8192;
constexpr float EPS = 1e-6f, LNX_EPS = 64e-5f;
constexpr size_t OUT_YS = (size_t)MP * D, OUT_SG = (size_t)M * D, OUT_SR = OUT_SG + (size_t)32 * 2 * 4 * 128 * 256;
constexpr size_t MiB = 1u << 20;
constexpr size_t WS_CTL = 0, CTL_ZERO_BYTES = 1 * MiB;
constexpr size_t WS_MOD = 1 * MiB;
constexpr size_t WS_SSQ1 = 2 * MiB, WS_SSQ2 = 3 * MiB;
constexpr size_t WS_BONUS = 4 * MiB;
constexpr size_t WS_HA = 6 * MiB;
constexpr size_t WS_WIN = 8 * MiB;
constexpr size_t WS_WO0 = 15 * MiB;
constexpr size_t WS_W4 = 17 * MiB;
constexpr size_t WS_WO1 = 34 * MiB;
constexpr size_t WS_ABUF = 38 * MiB;
constexpr size_t WS_Q0 = 70 * MiB, WS_K0 = 86 * MiB, WS_V0 = 102 * MiB, WS_G0 = 134 * MiB, WS_OF = 166 * MiB, WS_OB = 198 * MiB;
constexpr size_t WS_HH = 38 * MiB;
constexpr size_t WS_YF = 38 * MiB, WS_YB = 70 * MiB;
constexpr size_t WS_R1 = 102 * MiB, WS_K1 = 134 * MiB, WS_V1 = 166 * MiB, WS_G1 = 198 * MiB;
constexpr size_t WS_LWA = 230 * MiB;
constexpr size_t WS_OG1 = 102 * MiB;
constexpr size_t WS_END = 246 * MiB;
constexpr int CW_BAR = 4096;
constexpr int RING_BYTES = 131072, LDSCTL_OFF = RING_BYTES, MISC_OFF = LDSCTL_OFF + 320, LDS_BYTES = 147456;

namespace pg8 {
#define PG8_LAS __attribute__((address_space(3)))
typedef unsigned short bf16_t;
typedef short bf16x8 __attribute__((ext_vector_type(8)));
typedef float f32x4 __attribute__((ext_vector_type(4)));
typedef unsigned u32x4 __attribute__((ext_vector_type(4)));
constexpr int BM = 256, BK = 64, HALF = 128, HTB = HALF * BK * 2  , STAGE_BYTES = 8 * HTB, NXCD = 8, WGM = 8;

__host__ __device__ __forceinline__ int lds_byte(int r, int c) { const int st = (r >> 4) * 2 + (c >> 5), rr = r & 15, cc = c & 31, ob = rr * 64 + cc * 2; return st * 1024 + (ob ^ (((ob >> 9) & 1) << 5)); }
__host__ __device__ __forceinline__ void stage_rc(int b, int& R, int& C) { const int st = b / 1024, sb = b % 1024, swz = sb ^ (((sb >> 9) & 1) << 5); R = (st >> 1) * 16 + swz / 64; C = (st & 1) * 32 + (swz % 64) / 2; }
__host__ __device__ __forceinline__ int perm32(int rho) { const int n = rho >> 4, i = rho & 15; return 8 * (i >> 2) + 4 * n + (i & 3); }

struct Unit { int pm, pn; };
struct Gemm { const bf16_t* A; const bf16_t* Bt; int M, N, K; };

struct StaticOrder {
    int nM, nN, nwg, G, c;
    __host__ __device__ void init(int M, int N, int G_, int c_) { nM = M / BM; nN = N / BM; nwg = nM * nN; G = G_; c = c_; }
    __host__ __device__ bool next(int i, Unit& u) const {
        const long L = (long)i * G + c; if (L >= nwg) return false;
        int wgid = (int)L; { const int q = nwg / NXCD, r = nwg % NXCD, xcd = wgid % NXCD, off = wgid / NXCD; wgid = (xcd < r ? xcd * (q + 1) : r * (q + 1) + (xcd - r) * q) + off; }
        const int nig = WGM * nN, gid = wgid / nig, fm = gid * WGM, gsz = (nM - fm) < WGM ? (nM - fm) : WGM;
        u.pm = fm + ((wgid % nig) % gsz); u.pn = (wgid % nig) / gsz; return true;
    }
    __device__ __forceinline__ void a_ready(const Unit&) const {}
    __device__ __forceinline__ void done(const Unit&) const {}
};

__device__ __forceinline__ unsigned cvt_pk_bf16(float lo, float hi) { unsigned r; asm volatile("v_cvt_pk_bf16_f32 %0, %1, %2" : "=v"(r) : "v"(lo), "v"(hi)); return r; }
template <int L> struct EpiPlanes {
    static constexpr bool PERM = true, AFTER_DRAIN = false;
    unsigned char* ws;
    __device__ __forceinline__ void operator()(const f32x4 (&acc)[2][2][4][2], const Unit& u, int wr, int wc, int fr, int fq) const {
        constexpr int T1 = L ? 4 : 2, T2 = L ? 8 : 4, T3 = L ? 12 : 8, T4 = L ? 16 : 12, LRC = L ? 256 : 32, LRLD = L ? 256 : 32;
        constexpr size_t O0 = L ? WS_R1 : WS_Q0, O1 = L ? WS_K1 : WS_K0, O2 = L ? WS_V1 : WS_V0, O3 = L ? WS_G1 : WS_G0, OLR = L ? WS_LWA : WS_HA;
        constexpr int LD01 = L ? 1024 : 512;
        const int row0 = u.pm * BM + wr * 64 + fr;
        if (u.pn >= T4) {
            float* lr = (float*)(ws + OLR);
#pragma unroll
            for (int ai = 0; ai < 2; ++ai)
#pragma unroll
                for (int m = 0; m < 4; ++m) { float* rowp = lr + (size_t)(row0 + ai * HALF + m * 16) * LRLD;
#pragma unroll
                    for (int bj = 0; bj < 2; ++bj)
#pragma unroll
                        for (int n = 0; n < 2; ++n) { const int col = bj * HALF + wc * 32 + 8 * fq + 4 * n; if (col < LRC) *(f32x4*)(rowp + col) = acc[ai][bj][m][n]; } }
            return;
        }
        const int pn = u.pn;
        const size_t off = pn < T1 ? O0 : pn < T2 ? O1 : pn < T3 ? O2 : O3;
        const int ld = pn < T2 ? LD01 : 1024, ts = pn < T1 ? 0 : pn < T2 ? T1 : pn < T3 ? T2 : T3;
        bf16_t* base = (bf16_t*)(ws + off);
        const int col0 = (pn - ts) * BM + wc * 32 + 8 * fq;
#pragma unroll
        for (int ai = 0; ai < 2; ++ai)
#pragma unroll
            for (int m = 0; m < 4; ++m) { bf16_t* rowp = base + (size_t)(row0 + ai * HALF + m * 16) * ld + col0;
#pragma unroll
                for (int bj = 0; bj < 2; ++bj) { const f32x4 v0 = acc[ai][bj][m][0], v1 = acc[ai][bj][m][1];
                    u32x4 w; w.x = cvt_pk_bf16(v0[0], v0[1]); w.y = cvt_pk_bf16(v0[2], v0[3]); w.z = cvt_pk_bf16(v1[0], v1[1]); w.w = cvt_pk_bf16(v1[2], v1[3]);
                    *(u32x4*)(rowp + bj * HALF) = w; } }
    }
};
struct EpiRes {
    static constexpr bool PERM = false, AFTER_DRAIN = false;
    const float* bp; const float* bs;
    float* out;
    const float* gate;
    float* ssq;
    __device__ __forceinline__ void operator()(const f32x4 (&acc)[2][2][4][2], const Unit& u, int wr, int wc, int fr, int fq) const {
#pragma unroll
        for (int ai = 0; ai < 2; ++ai)
#pragma unroll
            for (int m = 0; m < 4; ++m) {
                const int r = u.pm * BM + ai * HALF + wr * 64 + m * 16 + fr;
                const int ci = r < 8192 ? 0 : 1 + ((r - 8192) >> 10);
                const float* brow = r < 8192 ? bp + (size_t)r * 1024 : bs + (size_t)(r - 8192) * 1024;
                float* orow = out + (size_t)r * 1024; const float* grow = gate + ci * 3072;
                float s = 0.f;
#pragma unroll
                for (int bj = 0; bj < 2; ++bj)
#pragma unroll
                    for (int n = 0; n < 2; ++n) { const int c = u.pn * BM + bj * HALF + wc * 32 + n * 16 + 4 * fq;
                        const f32x4 b = *(const f32x4*)(brow + c), g = *(const f32x4*)(grow + c); const f32x4 o = b + g * acc[ai][bj][m][n];
                        *(f32x4*)(orow + c) = o; s += (o[0] * o[0] + o[1] * o[1]) + (o[2] * o[2] + o[3] * o[3]); }
                s += __shfl_xor(s, 16); s += __shfl_xor(s, 32);
                if (fq == 0) ssq[(size_t)r * 16 + u.pn * 4 + wc] = s;
            }
    }
};

template <class Epi, class Sched, bool ALIGN_EPI = false, bool SP2 = false>
__device__ __forceinline__ void gemm_phase(PG8_LAS unsigned char* lds, const Gemm g, const Sched& S, const Epi& E) {
    const int tid = threadIdx.x, wid = __builtin_amdgcn_readfirstlane(tid >> 6), lane = tid & 63, wr = wid >> 2, wc = wid & 3, fr = lane & 15, fq = lane >> 4;
    const int K = g.K, nt = K / BK;
    unsigned voffA[2], voffB[2];
#pragma unroll
    for (int i = 0; i < 2; ++i) { int R, C; stage_rc(tid * 16 + i * 8192, R, C); const int Rb = Epi::PERM ? ((R & ~31) + perm32(R & 31)) : R;
        voffA[i] = (unsigned)(R * K + C) * 2u; voffB[i] = (unsigned)(Rb * K + C) * 2u; }
    const size_t kstep = (size_t)(BK * 2);
    const size_t hstep = (size_t)HALF * K * 2;
    const size_t tstep = 2 * hstep;
    const unsigned ldsw = (unsigned)wid * 1024u;
    const int aoff = lds_byte(wr * 64 + fr, fq * 8), boff = lds_byte(wc * 32 + fr, fq * 8);
#define PG8_SA(b, h) (((b) * 2 + (h)) * HTB)
#define PG8_SB(b, h) ((4 + (b) * 2 + (h)) * HTB)
#define PG8_STAGE(bufoff, gbase, voff) do { _Pragma("unroll") for (int _i = 0; _i < 2; ++_i) \
        __builtin_amdgcn_global_load_lds((const unsigned*)((const char*)(gbase) + (voff)[_i]), (PG8_LAS unsigned*)(lds + (bufoff) + ldsw + _i * 8192), 16, 0, 0); } while (0)
#define PG8_LDA(dst, b, h) do { _Pragma("unroll") for (int m = 0; m < 4; ++m) _Pragma("unroll") for (int k = 0; k < 2; ++k) dst[m][k] = *(const PG8_LAS bf16x8*)(lds + PG8_SA(b, h) + aoff + m * 2048 + k * 1024); } while (0)
#define PG8_LDB(dst, b, h) do { _Pragma("unroll") for (int n = 0; n < 2; ++n) _Pragma("unroll") for (int k = 0; k < 2; ++k) dst[n][k] = *(const PG8_LAS bf16x8*)(lds + PG8_SB(b, h) + boff + n * 2048 + k * 1024); } while (0)
#define PG8_MMA(ai, bj, At, Bt) do { __builtin_amdgcn_s_setprio(1); _Pragma("unroll") for (int m = 0; m < 4; ++m) _Pragma("unroll") for (int n = 0; n < 2; ++n) _Pragma("unroll") for (int k = 0; k < 2; ++k) \
        acc[ai][bj][m][n] = __builtin_amdgcn_mfma_f32_16x16x32_bf16(Bt[n][k], At[m][k], acc[ai][bj][m][n], 0, 0, 0); __builtin_amdgcn_s_setprio(0); } while (0)
#define PG8_WAIT_V(n) asm volatile("s_waitcnt vmcnt(" #n ")" ::: "memory")
#define PG8_WAIT_L(n) asm volatile("s_waitcnt lgkmcnt(" #n ")" ::: "memory")
#define PG8_BAR __builtin_amdgcn_s_barrier()
#define PG8_SCHED __builtin_amdgcn_sched_barrier(0)
    Unit cur, nxt; int ui = 0;
    if (!S.next(0, cur)) return;
    f32x4 acc[2][2][4][2];
#pragma unroll
    for (int a = 0; a < 2; ++a)
#pragma unroll
        for (int b = 0; b < 2; ++b)
#pragma unroll
            for (int m = 0; m < 4; ++m)
#pragma unroll
                for (int n = 0; n < 2; ++n) acc[a][b][m][n] = (f32x4){0.f, 0.f, 0.f, 0.f};
    bf16x8 At[4][2], B0[2][2], B1[2][2];
    const char* cA = (const char*)g.A + (size_t)cur.pm * tstep; const char* cB = (const char*)g.Bt + (size_t)cur.pn * tstep;
    S.a_ready(cur);
    if constexpr (SP2) {
        PG8_STAGE(PG8_SB(0, 0), cB, voffB); PG8_STAGE(PG8_SB(0, 1), cB + hstep, voffB); PG8_STAGE(PG8_SA(0, 0), cA, voffA); PG8_STAGE(PG8_SA(0, 1), cA + hstep, voffA);
        if (wr == 1) PG8_BAR;
        PG8_WAIT_V(2); PG8_BAR;
        PG8_STAGE(PG8_SB(1, 0), cB + kstep, voffB); PG8_STAGE(PG8_SA(1, 0), cA + kstep, voffA); PG8_STAGE(PG8_SB(1, 1), cB + hstep + kstep, voffB);
        PG8_WAIT_V(6); PG8_BAR;
    } else {
        PG8_STAGE(PG8_SB(0, 0), cB, voffB); PG8_STAGE(PG8_SA(0, 0), cA, voffA); PG8_STAGE(PG8_SB(0, 1), cB + hstep, voffB); PG8_STAGE(PG8_SA(0, 1), cA + hstep, voffA);
        if (wr == 1) PG8_BAR;
        PG8_WAIT_V(4); PG8_BAR;
        PG8_STAGE(PG8_SB(1, 0), cB + kstep, voffB); PG8_STAGE(PG8_SA(1, 0), cA + kstep, voffA); PG8_STAGE(PG8_SB(1, 1), cB + hstep + kstep, voffB);
        PG8_WAIT_V(6); PG8_BAR;
    }
    for (;;) {
        const bool has_next = S.next(ui + 1, nxt);
        const char* nA = has_next ? (const char*)g.A + (size_t)nxt.pm * tstep : cA; const char* nB = has_next ? (const char*)g.Bt + (size_t)nxt.pn * tstep : cB;
        for (int t = 0; t < nt; t += 2) {
            const bool last = (t == nt - 2);
            const char* a1 = cA + (size_t)(t + 1) * kstep;
            const char* a2 = last ? nA : cA + (size_t)(t + 2) * kstep; const char* b2 = last ? nB : cB + (size_t)(t + 2) * kstep;
            const char* a3 = a2 + kstep; const char* b3 = b2 + kstep;
            if (last && has_next) S.a_ready(nxt);
            if constexpr (SP2) {
            PG8_LDB(B0, 0, 0); PG8_LDB(B1, 0, 1); PG8_SCHED; PG8_LDA(At, 0, 0); PG8_STAGE(PG8_SA(1, 1), a1 + hstep, voffA);
            PG8_WAIT_V(8); PG8_WAIT_L(0); PG8_BAR; PG8_MMA(0, 0, At, B0); PG8_MMA(0, 1, At, B1); PG8_BAR; PG8_SCHED;
            PG8_LDA(At, 0, 1); PG8_STAGE(PG8_SB(0, 0), b2, voffB); PG8_STAGE(PG8_SB(0, 1), b2 + hstep, voffB); PG8_STAGE(PG8_SA(0, 0), a2, voffA);
            PG8_WAIT_V(8); PG8_WAIT_L(0); PG8_BAR; PG8_MMA(1, 0, At, B0); PG8_MMA(1, 1, At, B1); PG8_BAR; PG8_SCHED;
            PG8_LDB(B0, 1, 0); PG8_LDB(B1, 1, 1); PG8_SCHED; PG8_LDA(At, 1, 0); PG8_STAGE(PG8_SA(0, 1), a2 + hstep, voffA);
            PG8_WAIT_V(8); PG8_WAIT_L(0); PG8_BAR; PG8_MMA(0, 0, At, B0); PG8_MMA(0, 1, At, B1); PG8_BAR; PG8_SCHED;
            PG8_LDA(At, 1, 1); PG8_STAGE(PG8_SB(1, 0), b3, voffB); PG8_STAGE(PG8_SB(1, 1), b3 + hstep, voffB); PG8_STAGE(PG8_SA(1, 0), a3, voffA);
            PG8_WAIT_V(8); PG8_WAIT_L(0); PG8_BAR; PG8_MMA(1, 0, At, B0); PG8_MMA(1, 1, At, B1); PG8_BAR; PG8_SCHED;
            } else {
            PG8_LDB(B0, 0, 0); PG8_SCHED; PG8_LDA(At, 0, 0); PG8_STAGE(PG8_SA(1, 1), a1 + hstep, voffA);
            PG8_WAIT_L(8); PG8_BAR; PG8_WAIT_L(0); PG8_MMA(0, 0, At, B0); PG8_BAR; PG8_SCHED;
            PG8_LDB(B1, 0, 1); PG8_STAGE(PG8_SB(0, 0), b2, voffB);
            PG8_BAR; PG8_WAIT_L(0); PG8_MMA(0, 1, At, B1); PG8_BAR;
            PG8_LDA(At, 0, 1); PG8_STAGE(PG8_SA(0, 0), a2, voffA);
            PG8_BAR; PG8_WAIT_L(0); PG8_MMA(1, 0, At, B0); PG8_BAR; PG8_SCHED;
            PG8_STAGE(PG8_SB(0, 1), b2 + hstep, voffB);
            PG8_WAIT_V(6); PG8_BAR; PG8_MMA(1, 1, At, B1); PG8_BAR;
            PG8_LDB(B0, 1, 0); PG8_SCHED; PG8_LDA(At, 1, 0); PG8_STAGE(PG8_SA(0, 1), a2 + hstep, voffA);
            PG8_WAIT_L(8); PG8_BAR; PG8_WAIT_L(0); PG8_MMA(0, 0, At, B0); PG8_BAR; PG8_SCHED;
            PG8_LDB(B1, 1, 1); PG8_STAGE(PG8_SB(1, 0), b3, voffB);
            PG8_BAR; PG8_WAIT_L(0); PG8_MMA(0, 1, At, B1); PG8_BAR;
            PG8_LDA(At, 1, 1); PG8_STAGE(PG8_SA(1, 0), a3, voffA);
            PG8_BAR; PG8_WAIT_L(0); PG8_MMA(1, 0, At, B0); PG8_BAR; PG8_SCHED;
            PG8_STAGE(PG8_SB(1, 1), b3 + hstep, voffB);
            PG8_WAIT_V(6); PG8_BAR; PG8_MMA(1, 1, At, B1); PG8_BAR;
            }
        }
        if constexpr (ALIGN_EPI) { if (wr == 0) PG8_BAR; }
        if constexpr (!Epi::AFTER_DRAIN) { E(acc, cur, wr, wc, fr, fq); S.done(cur); }
        if (!has_next) break;
#pragma unroll
        for (int a = 0; a < 2; ++a)
#pragma unroll
            for (int b = 0; b < 2; ++b)
#pragma unroll
                for (int m = 0; m < 4; ++m)
#pragma unroll
                    for (int n = 0; n < 2; ++n) acc[a][b][m][n] = (f32x4){0.f, 0.f, 0.f, 0.f};
        cur = nxt; cA = nA; cB = nB; ++ui;
        if constexpr (ALIGN_EPI) { if (wr == 1) PG8_BAR; }
    }
    PG8_WAIT_V(0);
    if constexpr (!ALIGN_EPI) { if (wr == 0) PG8_BAR; }
    PG8_BAR;
    if constexpr (Epi::AFTER_DRAIN) { E.fused(acc, cur, wr, wc, fr, fq, lds, wid, lane); S.done(cur); }
#undef PG8_SA
#undef PG8_SB
#undef PG8_STAGE
#undef PG8_LDA
#undef PG8_LDB
#undef PG8_MMA
#undef PG8_WAIT_V
#undef PG8_WAIT_L
#undef PG8_BAR
#undef PG8_SCHED
}
}
#define GAS __attribute__((address_space(1)))
#define LAS __attribute__((address_space(3)))
typedef unsigned short bf16;
typedef unsigned v4u __attribute__((ext_vector_type(4)));
typedef float f32x4 __attribute__((ext_vector_type(4)));
typedef short bf16x8 __attribute__((ext_vector_type(8)));
typedef GAS unsigned gu32;
typedef GAS unsigned long long gu64;
#define RLX_AGENT __ATOMIC_RELAXED, __HIP_MEMORY_SCOPE_AGENT
#define LDS_WAIT() asm volatile("s_waitcnt lgkmcnt(0)" ::: "memory")
#define VM_WAIT() asm volatile("s_waitcnt vmcnt(0)" ::: "memory")
__device__ __forceinline__ unsigned long long rt() { return __builtin_amdgcn_s_memrealtime(); }
__device__ __forceinline__ unsigned f2bf(float f) { unsigned u = __builtin_bit_cast(unsigned, f); return (u + 0x7fffu + ((u >> 16) & 1u)) >> 16; }
__device__ __forceinline__ unsigned pk2(float lo, float hi) { return f2bf(lo) | (f2bf(hi) << 16); }

#define XB_TMO      128
#define XB_XCNT(j)  (256  + 64 * (j))
#define XB_XSUB(j)  (1280 + 64 * (j))
#define XB_XGEN(j)  (2304 + 64 * (j))
#define XB_TOP      3328
#define XB_TOPGEN   3392
#define XCD_BAR_WORDS 3456
#define XB_SPIN_CAP (1u << 18)

__device__ __forceinline__ unsigned xb_ld(unsigned* p)              { return __hip_atomic_load(p, __ATOMIC_RELAXED, __HIP_MEMORY_SCOPE_AGENT); }
__device__ __forceinline__ unsigned xb_add(unsigned* p, unsigned v) { return __hip_atomic_fetch_add(p, v, __ATOMIC_RELAXED, __HIP_MEMORY_SCOPE_AGENT); }
__device__ __forceinline__ unsigned xb_xcc_id() { return (unsigned)__builtin_amdgcn_s_getreg((3 << 11) | 20) & 0xFu; }
#define XB_SPIN(cond, bar) do { unsigned _sp = 0; while (cond) { __builtin_amdgcn_s_sleep(1); \
    if ((++_sp & 255u) == 0u) { if (xb_ld(&(bar)[XB_TMO])) break; if (_sp > XB_SPIN_CAP) { atomicAdd(&(bar)[XB_TMO], 1u); break; } } } } while (0)

struct XcdBarrier {
    unsigned* bar; unsigned x;
    volatile LAS unsigned* st;
};

__device__ __forceinline__ XcdBarrier xcd_barrier_post(unsigned* bar, volatile LAS unsigned* st) {
    XcdBarrier b; b.bar = bar; b.x = xb_xcc_id(); b.st = st;
    if (threadIdx.x == 0) (void)xb_add(&bar[XB_XCNT(b.x)], 1u);
    return b;
}
__device__ __forceinline__ void xcd_barrier_complete(unsigned* bar, unsigned x, unsigned& nloc, unsigned& nx) {
    const unsigned G = gridDim.x * gridDim.y * gridDim.z;
    unsigned sum, cnt, mine, sp = 0u;
    for (;;) {
        sum = 0u; cnt = 0u; mine = 0u;
#pragma unroll
        for (unsigned j = 0; j < 16; ++j) { const unsigned c = xb_ld(&bar[XB_XCNT(j)]); sum += c; cnt += (c > 0u) ? 1u : 0u; mine = (j == x) ? c : mine; }
        if (sum == G) break;
        __builtin_amdgcn_s_sleep(1);
        if ((++sp & 255u) == 0u) { if (xb_ld(&bar[XB_TMO])) break; if (sp > XB_SPIN_CAP) { atomicAdd(&bar[XB_TMO], 1u); break; } }
    }
    nloc = mine > 0u ? mine : 1u; nx = cnt > 0u ? cnt : 1u;
}

__device__ __forceinline__ void xcd_barrier(const XcdBarrier& b) {
    asm volatile("s_waitcnt vmcnt(0)" ::: "memory");
    __syncthreads();
    if (threadIdx.x == 0) {
        unsigned* bar = b.bar;
        __builtin_amdgcn_s_waitcnt(0);
        unsigned nloc = b.st[0], nx = b.st[1];
        if (nloc == 0u) { xcd_barrier_complete(bar, b.x, nloc, nx); b.st[0] = nloc; b.st[1] = nx; }
        const unsigned old = xb_add(&bar[XB_XSUB(b.x)], 1u);
        const unsigned gen = old / nloc;
        if (old + 1u == (gen + 1u) * nloc) {
            __builtin_amdgcn_fence(__ATOMIC_RELEASE, "agent");
            asm volatile("s_waitcnt vmcnt(0)" ::: "memory");
            const unsigned og = xb_add(&bar[XB_TOP], 1u);
            const unsigned tg = og / nx;
            if (og + 1u == (tg + 1u) * nx) xb_add(&bar[XB_TOPGEN], 1u);
            else XB_SPIN(xb_ld(&bar[XB_TOPGEN]) == tg, bar);
            __builtin_amdgcn_fence(__ATOMIC_ACQUIRE, "agent");
            xb_add(&bar[XB_XGEN(b.x)], 1u);
            asm volatile("s_waitcnt vmcnt(0)" ::: "memory");
        } else {
            XB_SPIN(xb_ld(&bar[XB_XGEN(b.x)]) == gen, bar);
            __builtin_amdgcn_fence(__ATOMIC_ACQUIRE, "agent");
            asm volatile("s_waitcnt vmcnt(0)" ::: "memory");
        }
    }
    __syncthreads();
}

__device__ __forceinline__ float bf2f(unsigned short b) { return __uint_as_float(((unsigned)b) << 16); }
__device__ __forceinline__ float wave_sum(float v) {
#pragma unroll
    for (int o = 1; o < 64; o <<= 1) v += __shfl_xor(v, o);
    return v;
}
__device__ __forceinline__ float silu_f(float x) { return x / (1.f + __expf(-x)); }

struct Args { const float* in[30]; float* out; unsigned char* ws; int ph_lo, ph_hi, li, pad; };
enum { I_XP = 0, I_XS, I_SG, I_SR, I_C, I_CCTX, I_WMOD, I_BMOD, I_NORMW, I_GWIN, I_GWA1, I_GWA2, I_GBA, I_GNORM, I_GWOUT, I_MU, I_WRKVG, I_W0, I_W1, I_W2, I_A0, I_A1, I_A2, I_KK, I_KA, I_RK, I_LNW, I_LNB, I_RWOUT, I_NORMF };

__device__ __forceinline__ void tr_item(const float* W, int N, bf16* WT, int ldo, int row_off, int col_off, const float* mu, int mode, LAS float* scr, int item, int lane) {
    const int nblk = N / 32, kb = item / nblk, nb = item % nblk, k0 = 64 * kb, n0 = 32 * nb;
#pragma unroll 8
    for (int i = 0; i < 32; ++i) { const int kk = 2 * i + (lane >> 5); float s = 1.f; if (mode) { const float m_ = mu[k0 + kk]; s = mode == 1 ? 1.f - m_ : m_; }
        scr[kk * 33 + (lane & 31)] = W[(size_t)(k0 + kk) * N + n0 + (lane & 31)] * s; }
    LDS_WAIT(); asm volatile("" ::: "memory");
    const int c = lane & 7;
#pragma unroll
    for (int j = 0; j < 4; ++j) { const int n = (lane >> 3) + 8 * j; const LAS float* s = scr + (8 * c) * 33 + n;
        v4u o; o.x = pk2(s[0 * 33], s[1 * 33]); o.y = pk2(s[2 * 33], s[3 * 33]); o.z = pk2(s[4 * 33], s[5 * 33]); o.w = pk2(s[6 * 33], s[7 * 33]);
        *(v4u*)(WT + (size_t)(row_off + n0 + n) * ldo + col_off + k0 + 8 * c) = o; }
    LDS_WAIT(); asm volatile("" ::: "memory");
}
__device__ __forceinline__ void phase0(const Args& A, LAS unsigned char* lds, int tid, int lane, int wave) {
    unsigned char* ws = A.ws;
    const int G = gridDim.x, blk = blockIdx.x;
    {
        LAS float* scond = (LAS float*)lds;
        LAS float* red = scond + 9 * 1024;
        bool filled = false;
        for (int item = blk; item < 96; item += G) {
            if (!filled) {
                for (int idx = tid; idx < 9 * 1024; idx += NTHR) { const int r = idx >> 10, k = idx & 1023; const float c = r == 0 ? A.in[I_CCTX][k] : A.in[I_C][(r - 1) * 1024 + k]; scond[idx] = silu_f(c); }
                filled = true;
            }
            __syncthreads();
            const int l = item / 48, g = item % 48, col = g * 64 + lane;
            float acc[9];
#pragma unroll
            for (int r = 0; r < 9; ++r) acc[r] = 0.f;
            const float* wp = A.in[I_WMOD] + ((size_t)l * 1024 + wave * 128) * 3072 + col;
#pragma unroll 4
            for (int k = 0; k < 128; ++k) { const float wv = wp[(size_t)k * 3072];
#pragma unroll
                for (int r = 0; r < 9; ++r) acc[r] += scond[r * 1024 + wave * 128 + k] * wv; }
#pragma unroll
            for (int r = 0; r < 9; ++r) red[(wave * 9 + r) * 64 + lane] = acc[r];
            __syncthreads();
            for (int idx = tid; idx < 576; idx += NTHR) { const int r = idx >> 6, ln = idx & 63; float s = A.in[I_BMOD][l * 3072 + g * 64 + ln];
#pragma unroll
                for (int w = 0; w < 8; ++w) s += red[(w * 9 + r) * 64 + ln];
                ((float*)(ws + WS_MOD))[(l * 9 + r) * 3072 + g * 64 + ln] = s; }
            __syncthreads();
        }
        __syncthreads();
    }
    LAS float* scr = (LAS float*)(lds + wave * 16384);
    const int gw = blk * NWAVES + wave, NGW = G * NWAVES;
    bf16* WIN = (bf16*)(ws + WS_WIN); bf16* WO0 = (bf16*)(ws + WS_WO0); bf16* W4 = (bf16*)(ws + WS_W4); bf16* WO1 = (bf16*)(ws + WS_WO1);
    constexpr int I_IN = 16 * 96, I_SQ = 16 * 32, I_LR = 16 * 2;
    constexpr int NITEMS = I_IN + I_SQ + 8 * I_SQ + 8 * I_LR + I_SQ;
    for (int it = gw; it < NITEMS; it += NGW) {
        int r = it;
        if (r < I_IN) { tr_item(A.in[I_GWIN], 3072, WIN, 1024, 0, 0, nullptr, 0, scr, r, lane); continue; } r -= I_IN;
        if (r < I_SQ) { tr_item(A.in[I_GWOUT], 1024, WO0, 1024, 0, 0, nullptr, 0, scr, r, lane); continue; } r -= I_SQ;
        if (r < 8 * I_SQ) { const int p = r / (2 * I_SQ), hf = (r / I_SQ) & 1; tr_item(A.in[I_WRKVG] + (size_t)p * 1024 * 1024, 1024, W4, 2048, p * 1024, hf * 1024, A.in[I_MU] + p * 1024, 1 + hf, scr, r % I_SQ, lane); continue; } r -= 8 * I_SQ;
        if (r < 8 * I_LR) { const int q = r / I_LR, which = q >> 2, d = (q >> 1) & 1, hf = q & 1;
            tr_item((which ? A.in[I_A1] : A.in[I_W1]) + (size_t)d * 1024 * 64, 64, W4, 2048, 4096 + which * 128 + d * 64, hf * 1024, A.in[I_MU] + (4 + which) * 1024, 1 + hf, scr, r % I_LR, lane); continue; } r -= 8 * I_LR;
        tr_item(A.in[I_RWOUT], 1024, WO1, 1024, 0, 0, nullptr, 0, scr, r, lane);
    }
    const int gt = blk * NTHR + tid, NGT = G * NTHR;
    for (int idx = gt; idx < 2 * 16 * 1024; idx += NGT) { const int k = idx & 1023, j = (idx >> 10) & 15, d = idx >> 14;
        WIN[(size_t)(3072 + d * 16 + j) * 1024 + k] = (bf16)f2bf(A.in[I_GWA1][((size_t)d * 1024 + k) * 16 + j]); }
    for (int idx = gt; idx < 224 * 1024 / 8; idx += NGT) ((v4u*)(WIN + (size_t)3104 * 1024))[idx] = (v4u){0u, 0u, 0u, 0u};
}

__device__ __forceinline__ const float* xrow_in(const Args& A, int r) { return r < MP ? A.in[I_XP] + (size_t)r * D : A.in[I_XS] + (size_t)(r - MP) * D; }
__device__ __forceinline__ int cond_of(int r) { return r < MP ? 0 : 1 + ((r - MP) >> 10); }
__device__ __forceinline__ void store_bf4(bf16* p, f32x4 v) { *(unsigned long long*)p = (unsigned long long)pk2(v[0], v[1]) | ((unsigned long long)pk2(v[2], v[3]) << 32); }
__device__ __forceinline__ f32x4 load_bf4(const bf16* p) { const unsigned long long w = *(const unsigned long long*)p; const unsigned lo = (unsigned)w, hi = (unsigned)(w >> 32);
    return (f32x4){__uint_as_float(lo << 16), __uint_as_float(lo & 0xffff0000u), __uint_as_float(hi << 16), __uint_as_float(hi & 0xffff0000u)}; }

__device__ __forceinline__ void phase_h0(const Args& A, int lane, int gw, int NGW) {
    const float* MOD = (const float*)(A.ws + WS_MOD); bf16* XN = (bf16*)(A.ws + WS_ABUF); const float* nw = A.in[I_NORMW];
    for (int r = gw; r < M; r += NGW) {
        const f32x4* xr = (const f32x4*)xrow_in(A, r) + lane;
        f32x4 v[4]; float s = 0.f;
#pragma unroll
        for (int j = 0; j < 4; ++j) { v[j] = xr[64 * j]; s += (v[j][0] * v[j][0] + v[j][1] * v[j][1]) + (v[j][2] * v[j][2] + v[j][3] * v[j][3]); }
        const float rstd = 1.f / sqrtf(wave_sum(s) * (1.f / D) + EPS);
        const float* md = MOD + cond_of(r) * 3072;
#pragma unroll
        for (int j = 0; j < 4; ++j) { const int c = 256 * j + 4 * lane; const f32x4 w = *(const f32x4*)(nw + c), sh = *(const f32x4*)(md + c), sc = *(const f32x4*)(md + 1024 + c);
            store_bf4(XN + (size_t)r * D + c, (v[j] * rstd) * w * (sc + 1.f) + sh); }
    }
}
__device__ __forceinline__ void phase_og0(const Args& A, int lane, int gw, int NGW) {
    const bf16* OF = (const bf16*)(A.ws + WS_OF); const bf16* OB = (const bf16*)(A.ws + WS_OB); const bf16* G0 = (const bf16*)(A.ws + WS_G0); bf16* OG = (bf16*)(A.ws + WS_ABUF);
    const f32x4 wn = *(const f32x4*)(A.in[I_GNORM] + 4 * lane);
    for (int r = gw; r < M; r += NGW) {
#pragma unroll
        for (int j = 0; j < 4; ++j) { const size_t o = (size_t)r * D + 256 * j + 4 * lane; const f32x4 v = load_bf4(OF + o) + load_bf4(OB + o);
            const float ms = wave_sum((v[0] * v[0] + v[1] * v[1]) + (v[2] * v[2] + v[3] * v[3])) * (1.f / 256.f); const float rs = 1.f / sqrtf(ms + EPS);
            const f32x4 g = load_bf4(G0 + o); f32x4 y = v * rs * wn;
            y[0] *= silu_f(g[0]); y[1] *= silu_f(g[1]); y[2] *= silu_f(g[2]); y[3] *= silu_f(g[3]);
            store_bf4(OG + o, y); }
    }
}
__device__ __forceinline__ float row_rstd(const float* ssq, int r, int lane) { float s = lane < 16 ? ssq[(size_t)r * 16 + lane] : 0.f; return 1.f / sqrtf(wave_sum(s) * (1.f / D) + EPS); }
__device__ __forceinline__ void phase_hh(const Args& A, int lane, int gw, int NGW) {
    const float* MOD = (const float*)(A.ws + WS_MOD) + 9 * 3072; const float* ssq = (const float*)(A.ws + WS_SSQ1); bf16* HH = (bf16*)(A.ws + WS_HH); const float* nw = A.in[I_NORMW] + 1024; const float* X1 = A.out;
    for (int r = gw; r < M; r += NGW) {
        const float* md = MOD + cond_of(r) * 3072;
        int n0, n1, n2, n3; bool v0, v1, v2, v3; float wgt;
        if (r < MP) { const int t = r & 255; wgt = 0.5f; n0 = r - 1; v0 = t > 0; n1 = r + 1; v1 = t < 255; n2 = r; v2 = false; n3 = r; v3 = false; }
        else { const int t = (r - MP) & 1023, gr = t >> 6, gc = t & 63; wgt = 0.25f; n0 = r - 64; v0 = gr > 0; n1 = r + 64; v1 = gr < 15; n2 = r - 1; v2 = gc > 0; n3 = r + 1; v3 = gc < 63; }
        const int cnt = (int)v0 + (int)v1 + (int)v2 + (int)v3;
        const float rs = row_rstd(ssq, r, lane);
        f32x4 acc[4];
#pragma unroll
        for (int j = 0; j < 4; ++j) acc[j] = (f32x4){0.f, 0.f, 0.f, 0.f};
#pragma unroll
        for (int q = 0; q < 4; ++q) { const int n = q == 0 ? n0 : q == 1 ? n1 : q == 2 ? n2 : n3; const bool vld = q == 0 ? v0 : q == 1 ? v1 : q == 2 ? v2 : v3;
            if (vld) { const float rn = row_rstd(ssq, n, lane); const f32x4* xp = (const f32x4*)(X1 + (size_t)n * D) + lane;
#pragma unroll
                for (int j = 0; j < 4; ++j) acc[j] += xp[64 * j] * rn; } }
        const f32x4* xr = (const f32x4*)(X1 + (size_t)r * D) + lane;
#pragma unroll
        for (int j = 0; j < 4; ++j) { const int c = 256 * j + 4 * lane; const f32x4 w = *(const f32x4*)(nw + c), sh = *(const f32x4*)(md + c), sc = *(const f32x4*)(md + 1024 + c); const f32x4 cc = w * (sc + 1.f);
            store_bf4(HH + (size_t)r * 2048 + c, (xr[64 * j] * rs) * cc + sh);
            store_bf4(HH + (size_t)r * 2048 + 1024 + c, (acc[j] * cc + sh * (float)cnt) * wgt); }
    }
}
__device__ __forceinline__ void phase_og1(const Args& A, int lane, int gw, int NGW) {
    const bf16* YF = (const bf16*)(A.ws + WS_YF); const bf16* YB = (const bf16*)(A.ws + WS_YB); const bf16* V1 = (const bf16*)(A.ws + WS_V1); const bf16* G1 = (const bf16*)(A.ws + WS_G1);
    const float* BON = (const float*)(A.ws + WS_BONUS); bf16* OG = (bf16*)(A.ws + WS_OG1);
    for (int r = gw; r < M; r += NGW) {
#pragma unroll
        for (int j = 0; j < 4; ++j) { const int c = 256 * j + 4 * lane, h = c >> 6; const size_t o = (size_t)r * D + c; const f32x4 y = load_bf4(YF + o) + load_bf4(YB + o);
            float s = (y[0] + y[1]) + (y[2] + y[3]);
            s += __shfl_xor(s, 1); s += __shfl_xor(s, 2); s += __shfl_xor(s, 4); s += __shfl_xor(s, 8);
            const float mean = s * (1.f / 64.f); const f32x4 dv = y - mean; float q = (dv[0] * dv[0] + dv[1] * dv[1]) + (dv[2] * dv[2] + dv[3] * dv[3]);
            q += __shfl_xor(q, 1); q += __shfl_xor(q, 2); q += __shfl_xor(q, 4); q += __shfl_xor(q, 8);
            const float rs = 1.f / sqrtf(q * (1.f / 64.f) + LNX_EPS);
            const f32x4 lw = *(const f32x4*)(A.in[I_LNW] + c), lb = *(const f32x4*)(A.in[I_LNB] + c);
            const float bon = BON[((size_t)r * 16 + h) * 2] + BON[((size_t)r * 16 + h) * 2 + 1];
            const f32x4 v = load_bf4(V1 + o), g = load_bf4(G1 + o);
            f32x4 z = dv * rs * lw + lb + v * bon;
            z[0] *= silu_f(g[0]); z[1] *= silu_f(g[1]); z[2] *= silu_f(g[2]); z[3] *= silu_f(g[3]);
            store_bf4(OG + o, z); }
    }
}
__device__ __forceinline__ void phase_final(const Args& A, int lane, int gw, int NGW) {
    const float* ssq = (const float*)(A.ws + WS_SSQ2); const float* nf = A.in[I_NORMF];
    for (int r = gw; r < M; r += NGW) {
        const float rs = row_rstd(ssq, r, lane); f32x4* xr = (f32x4*)(A.out + (size_t)r * D) + lane;
#pragma unroll
        for (int j = 0; j < 4; ++j) { const f32x4 w = *(const f32x4*)(nf + 256 * j + 4 * lane); xr[64 * j] = xr[64 * j] * rs * w; }
    }
}

__device__ __forceinline__ void phase_gla_naive(const Args& A, LAS unsigned char* lds, int tid) {
    LAS float* sq = (LAS float*)lds; LAS float* sk = sq + 1024; LAS float* sal = sk + 1024; LAS float* so = sal + 1024;
    const bf16* Q0 = (const bf16*)(A.ws + WS_Q0); const bf16* K0 = (const bf16*)(A.ws + WS_K0); const bf16* V0 = (const bf16*)(A.ws + WS_V0); const float* HA = (const float*)(A.ws + WS_HA);
    const int e = tid & 255, half = tid >> 8, j = tid & 127, blk = blockIdx.x;
    for (int slot = 0; slot < 2; ++slot) {
        int item; bool sample;
        if (blk < 64) { if (slot) break; sample = true; item = blk; }
        else { const int q = blk - 64; if (slot == 0) item = q; else { if (q >= 64) break; item = 192 + q; } sample = false; }
        const int b = item >> 3, h = (item >> 1) & 3, d = item & 1, T = sample ? 1024 : 256, row0 = sample ? MP + b * 1024 : b * 256;
        bf16* OUT = (bf16*)(A.ws + (d ? WS_OB : WS_OF));
        float S[64];
        if (sample) { const float* sp = A.in[I_SG] + ((((size_t)b * 2 + d) * 4 + h) * 128 + 64 * half) * 256 + e;
#pragma unroll
            for (int jj = 0; jj < 64; ++jj) S[jj] = sp[(size_t)jj * 256]; }
        else {
#pragma unroll
            for (int jj = 0; jj < 64; ++jj) S[jj] = 0.f; }
        float wa2[16];
#pragma unroll
        for (int m = 0; m < 16; ++m) wa2[m] = A.in[I_GWA2][((size_t)d * 16 + m) * 512 + h * 128 + j];
        const float ba = A.in[I_GBA][d * 512 + h * 128 + j];
        for (int s0 = 0; s0 < T; s0 += 8) {
#pragma unroll
            for (int pp = 0; pp < 2; ++pp) { const int tok = (tid >> 7) + 4 * pp, s = s0 + tok, t = d ? T - 1 - s : s; const size_t row = (size_t)row0 + t;
                const float* ha = HA + row * 32 + d * 16; float z = ba;
#pragma unroll
                for (int m = 0; m < 16; ++m) z += ha[m] * wa2[m];
                const float ls = fminf(z, 0.f) - log1pf(expf(-fabsf(z)));
                sal[tok * 128 + j] = expf(ls * (1.f / 16.f));
                sq[tok * 128 + j] = bf2f(Q0[row * 512 + h * 128 + j]) * 0.08838834764831845f;
                sk[tok * 128 + j] = bf2f(K0[row * 512 + h * 128 + j]); }
            __syncthreads();
            for (int tok = 0; tok < 8; ++tok) { const int s = s0 + tok, t = d ? T - 1 - s : s; const size_t row = (size_t)row0 + t;
                const float v = bf2f(V0[row * 1024 + h * 256 + e]); float o = 0.f;
                const LAS f32x4* a4 = (const LAS f32x4*)(sal + tok * 128 + 64 * half); const LAS f32x4* k4 = (const LAS f32x4*)(sk + tok * 128 + 64 * half); const LAS f32x4* q4 = (const LAS f32x4*)(sq + tok * 128 + 64 * half);
#pragma unroll
                for (int g = 0; g < 16; ++g) { const f32x4 al = a4[g], kk = k4[g], qq = q4[g];
#pragma unroll
                    for (int c = 0; c < 4; ++c) { S[4 * g + c] = al[c] * S[4 * g + c] + kk[c] * v; o += qq[c] * S[4 * g + c]; }
                    if ((g & 3) == 3) asm volatile("" ::: "memory"); }
                so[(tok * 2 + half) * 256 + e] = o; }
            __syncthreads();
            for (int idx = tid; idx < 8 * 256; idx += NTHR) { const int tok = idx >> 8, ee = idx & 255, s = s0 + tok, t = d ? T - 1 - s : s; const size_t row = (size_t)row0 + t;
                OUT[row * 1024 + h * 256 + ee] = (bf16)f2bf(so[(tok * 2) * 256 + ee] + so[(tok * 2 + 1) * 256 + ee]); }
        }
        if (!sample) { float* dst = A.out + OUT_SG + ((((size_t)b * 2 + d) * 4 + h) * 128 + 64 * half) * 256 + e;
#pragma unroll
            for (int jj = 0; jj < 64; ++jj) dst[(size_t)jj * 256] = S[jj]; }
        __syncthreads();
    }
}

__device__ __forceinline__ void phase_rwkv_naive(const Args& A, LAS unsigned char* lds, int lane, int wave) {
    const int blk = blockIdx.x;
    int idx; bool sample;
    if (wave == 0) { sample = true; idx = blk; if (idx >= 256) return; }
    else if (wave <= 4) { sample = false; idx = blk * 4 + (wave - 1); if (idx >= 1024) return; }
    else return;
    const int b = idx >> 5, h = (idx >> 1) & 15, d = idx & 1, T = sample ? 1024 : 256, row0 = sample ? MP + b * 1024 : b * 256, hc = h * 64 + lane;
    LAS float* sl = (LAS float*)(lds + wave * 2048);
    LAS float* a2l = (LAS float*)(lds + 16384 + wave * 16384) + lane;
    const bf16* R1 = (const bf16*)(A.ws + WS_R1); const bf16* K1 = (const bf16*)(A.ws + WS_K1); const bf16* V1 = (const bf16*)(A.ws + WS_V1); const float* LWA = (const float*)(A.ws + WS_LWA);
    float* BON = (float*)(A.ws + WS_BONUS); bf16* YO = (bf16*)(A.ws + (d ? WS_YB : WS_YF));
    float S[64], w2c[64];
#pragma unroll
    for (int m = 0; m < 64; ++m) { w2c[m] = A.in[I_W2][((size_t)d * 64 + m) * 1024 + hc]; a2l[m * 64] = A.in[I_A2][((size_t)d * 64 + m) * 1024 + hc]; }
    const float w0v = A.in[I_W0][d * 1024 + hc], a0v = A.in[I_A0][d * 1024 + hc], kkw = A.in[I_KK][d * 1024 + hc], kaw = A.in[I_KA][d * 1024 + hc], rkw = A.in[I_RK][(d * 16 + h) * 64 + lane];
    if (sample) { const f32x4* sp = (const f32x4*)(A.in[I_SR] + ((((size_t)b * 2 + d) * 16 + h) * 64 + lane) * 64);
#pragma unroll
        for (int g = 0; g < 16; ++g) { const f32x4 v = sp[g]; S[4 * g] = v[0]; S[4 * g + 1] = v[1]; S[4 * g + 2] = v[2]; S[4 * g + 3] = v[3]; } }
    else {
#pragma unroll
        for (int jj = 0; jj < 64; ++jj) S[jj] = 0.f; }
    for (int s = 0; s < T; ++s) {
        const int t = d ? T - 1 - s : s; const size_t row = (size_t)row0 + t;
        sl[lane] = tanhf(LWA[row * 256 + d * 64 + lane]); sl[64 + lane] = LWA[row * 256 + 128 + d * 64 + lane];
        LDS_WAIT();
        float wpre = w0v, apre = a0v;
#pragma unroll
        for (int g = 0; g < 16; ++g) { const f32x4 x = ((const LAS f32x4*)sl)[g], y = ((const LAS f32x4*)(sl + 64))[g];
#pragma unroll
            for (int c = 0; c < 4; ++c) { wpre += x[c] * w2c[4 * g + c]; apre += y[c] * a2l[(4 * g + c) * 64]; } }
        const float sp_ = fmaxf(-wpre, 0.f) + log1pf(expf(-fabsf(wpre)));
        const float dec = expf(-expf(-sp_ - 0.5f));
        const float av = 1.f / (1.f + expf(-apre));
        const float kv = bf2f(K1[row * 1024 + hc]), rv = bf2f(R1[row * 1024 + hc]);
        float kk = kv * kkw; const float nrm = sqrtf(wave_sum(kk * kk)); kk = kk / fmaxf(nrm, 1e-12f);
        const float kd = kv * (1.f + (av - 1.f) * kaw);
        const float bon = wave_sum(rv * kd * rkw);
        if (lane == 0) BON[(row * 16 + h) * 2 + d] = bon;
        sl[128 + lane] = dec; sl[192 + lane] = -kk; sl[256 + lane] = kk * av; sl[320 + lane] = kd; sl[384 + lane] = rv;
        LDS_WAIT();
        const float vv = bf2f(V1[row * 1024 + hc]);
        float sa0 = 0.f, sa1 = 0.f, sa2 = 0.f, sa3 = 0.f;
#pragma unroll
        for (int g = 0; g < 16; ++g) { const f32x4 x = ((const LAS f32x4*)(sl + 192))[g]; sa0 += S[4 * g] * x[0]; sa1 += S[4 * g + 1] * x[1]; sa2 += S[4 * g + 2] * x[2]; sa3 += S[4 * g + 3] * x[3]; }
        const float sa = (sa0 + sa1) + (sa2 + sa3);
        float y0 = 0.f, y1 = 0.f, y2 = 0.f, y3 = 0.f;
#pragma unroll
        for (int g = 0; g < 16; ++g) { const f32x4 dw = ((const LAS f32x4*)(sl + 128))[g], bb = ((const LAS f32x4*)(sl + 256))[g], kx = ((const LAS f32x4*)(sl + 320))[g], rr = ((const LAS f32x4*)(sl + 384))[g];
#pragma unroll
            for (int c = 0; c < 4; ++c) S[4 * g + c] = S[4 * g + c] * dw[c] + sa * bb[c] + vv * kx[c];
            y0 += S[4 * g] * rr[0]; y1 += S[4 * g + 1] * rr[1]; y2 += S[4 * g + 2] * rr[2]; y3 += S[4 * g + 3] * rr[3]; }
        YO[row * 1024 + hc] = (bf16)f2bf((y0 + y1) + (y2 + y3));
        LDS_WAIT();
    }
    if (!sample) { f32x4* dp = (f32x4*)(A.out + OUT_SR + ((((size_t)b * 2 + d) * 16 + h) * 64 + lane) * 64);
#pragma unroll
        for (int g = 0; g < 16; ++g) dp[g] = (f32x4){S[4 * g], S[4 * g + 1], S[4 * g + 2], S[4 * g + 3]}; }
}

__global__ void __launch_bounds__(NTHR, 2) trunk_fwd(Args args) {
    extern __shared__ __attribute__((aligned(16))) unsigned char lds_raw[];
    LAS unsigned char* lds = (LAS unsigned char*)lds_raw;
    const int tid = threadIdx.x, lane = tid & 63, wave = __builtin_amdgcn_readfirstlane(tid >> 6);
    const int G = gridDim.x, gw = blockIdx.x * NWAVES + wave, NGW = G * NWAVES;
    volatile LAS unsigned* MISC = (volatile LAS unsigned*)(lds + MISC_OFF);
    for (int u = tid; u < (LDS_BYTES - LDSCTL_OFF) / 4; u += NTHR) ((LAS unsigned*)(lds + LDSCTL_OFF))[u] = 0u;
    __syncthreads();
    unsigned char* ws = args.ws;
    XcdBarrier bar; bar.bar = (unsigned*)(ws + WS_CTL) + CW_BAR; bar.x = 0; bar.st = nullptr;
    if (N_LAUNCHES == 1) bar = xcd_barrier_post((unsigned*)(ws + WS_CTL) + CW_BAR, MISC + 8);
    const int lo = args.ph_lo, hi = args.ph_hi;
#define IN(k) (lo <= (k) && (k) < hi)
#define SEAM(k) do { if (IN(k) && IN((k) + 1)) xcd_barrier(bar); } while (0)
    if (IN(0)) { phase0(args, lds, tid, lane, wave); } SEAM(0);
    if (IN(1)) { phase_h0(args, lane, gw, NGW); } SEAM(1);
    if (IN(2)) {
        pg8::Gemm g{(const pg8::bf16_t*)(ws + WS_ABUF), (const pg8::bf16_t*)(ws + WS_WIN), M, 3328, 1024}; pg8::StaticOrder S; S.init(M, 3328, G, (int)blockIdx.x);
        pg8::EpiPlanes<0> E{ws};
        pg8::gemm_phase<pg8::EpiPlanes<0>, pg8::StaticOrder, true, true>(lds, g, S, E);
    } SEAM(2);
    if (IN(3)) { phase_gla_naive(args, lds, tid); } SEAM(3);
    if (IN(4)) { phase_og0(args, lane, gw, NGW); } SEAM(4);
    if (IN(5)) {
        pg8::Gemm g{(const pg8::bf16_t*)(ws + WS_ABUF), (const pg8::bf16_t*)(ws + WS_WO0), M, 1024, 1024}; pg8::StaticOrder S; S.init(M, 1024, G, (int)blockIdx.x);
        pg8::EpiRes E{args.in[I_XP], args.in[I_XS], args.out, (const float*)(ws + WS_MOD) + 2048, (float*)(ws + WS_SSQ1)};
        pg8::gemm_phase<pg8::EpiRes, pg8::StaticOrder, true, true>(lds, g, S, E);
    } SEAM(5);
    if (IN(6)) { phase_hh(args, lane, gw, NGW); } SEAM(6);
    if (IN(7)) {
        pg8::Gemm g{(const pg8::bf16_t*)(ws + WS_HH), (const pg8::bf16_t*)(ws + WS_W4), M, 4352, 2048}; pg8::StaticOrder S; S.init(M, 4352, G, (int)blockIdx.x);
        pg8::EpiPlanes<1> E{ws};
        pg8::gemm_phase<pg8::EpiPlanes<1>, pg8::StaticOrder, true, true>(lds, g, S, E);
    } SEAM(7);
    if (IN(8)) { phase_rwkv_naive(args, lds, lane, wave); } SEAM(8);
    if (IN(9)) { phase_og1(args, lane, gw, NGW); } SEAM(9);
    if (IN(10)) {
        pg8::Gemm g{(const pg8::bf16_t*)(ws + WS_OG1), (const pg8::bf16_t*)(ws + WS_WO1), M, 1024, 1024}; pg8::StaticOrder S; S.init(M, 1024, G, (int)blockIdx.x);
        pg8::EpiRes E{args.out, args.out + OUT_YS, args.out, (const float*)(ws + WS_MOD) + 9 * 3072 + 2048, (float*)(ws + WS_SSQ2)};
        pg8::gemm_phase<pg8::EpiRes, pg8::StaticOrder, true, true>(lds, g, S, E);
    } SEAM(10);
    if (IN(11)) { phase_final(args, lane, gw, NGW); }
#undef IN
#undef SEAM
}

extern "C" void kernel_launch(void* const* d_in, const int* in_sizes, int n_in, void* d_out, int out_size, void* d_ws, size_t ws_size, hipStream_t stream) {
    static int grid = 0;
    if (grid == 0) {
        if (n_in != 30 || ws_size < WS_END) { fprintf(stderr, "kernel_launch: built for 30 inputs and >= %zu bytes of workspace; got n_in %d ws %zu\n", (size_t)WS_END, n_in, ws_size); grid = -1; return; }
        int dev = 0, cus = 0, per_cu = 0;
        if (hipGetDevice(&dev) != hipSuccess || hipDeviceGetAttribute(&cus, hipDeviceAttributeMultiprocessorCount, dev) != hipSuccess) { grid = -1; return; }
        if (hipFuncSetAttribute((const void*)trunk_fwd, hipFuncAttributeMaxDynamicSharedMemorySize, LDS_BYTES) != hipSuccess) { fprintf(stderr, "kernel_launch: hipFuncSetAttribute failed\n"); grid = -1; return; }
        if (hipOccupancyMaxActiveBlocksPerMultiprocessor(&per_cu, (const void*)trunk_fwd, NTHR, LDS_BYTES) != hipSuccess || per_cu < 1) { fprintf(stderr, "kernel_launch: occupancy query reports %d workgroups per CU\n", per_cu); per_cu = 1; }
        (void)hipGetLastError();
        grid = cus;
        if (grid > 256) grid = 256;
    }
    if (grid < 0) return;
    (void)hipMemsetAsync((char*)d_ws + WS_CTL, 0, CTL_ZERO_BYTES, stream);
    Args a{};
    for (int i = 0; i < 30; ++i) a.in[i] = (const float*)d_in[i];
    a.out = (float*)d_out; a.ws = (unsigned char*)d_ws;
    if (N_LAUNCHES == 1) {
        a.ph_lo = 0; a.ph_hi = N_PHASES; a.li = 0;
        void* kargs[] = {&a};
        hipError_t e = hipLaunchCooperativeKernel((const void*)trunk_fwd, dim3(grid), dim3(NTHR), kargs, LDS_BYTES, stream);
        if (e != hipSuccess) fprintf(stderr, "kernel_launch: cooperative launch failed: %s (grid %d)\n", hipGetErrorString(e), grid);
    } else {
        for (int li = 0; li < N_PHASES; ++li) { a.ph_lo = li; a.ph_hi = li + 1; a.li = li;
            hipLaunchKernelGGL(trunk_fwd, dim3(grid), dim3(NTHR), LDS_BYTES, stream, a); }
    }
}
```

```cpp
#include <hip/hip_runtime.h>
#include <cstdio>
#include <cstdint>
constexpr int NWAVES = 8, NTHR = 512;
#ifndef MK_N_LAUNCHES
#define MK_N_LAUNCHES 1
#endif
constexpr int N_PHASES = 12;
constexpr int N_LAUNCHES = MK_N_LAUNCHES;
constexpr int M = 16384, D = 1024, MP = 8192;
constexpr float EPS = 1e-6f, LNX_EPS = 64e-5f;
constexpr size_t OUT_YS = (size_t)MP * D, OUT_SG = (size_t)M * D, OUT_SR = OUT_SG + (size_t)32 * 2 * 4 * 128 * 256;
constexpr size_t MiB = 1u << 20;
constexpr size_t WS_CTL = 0, CTL_ZERO_BYTES = 1 * MiB;
constexpr size_t WS_MOD = 1 * MiB;
constexpr size_t WS_SSQ1 = 2 * MiB, WS_SSQ2 = 3 * MiB;
constexpr size_t WS_BONUS = 4 * MiB;
constexpr size_t WS_HA = 6 * MiB;
constexpr size_t WS_WIN = 8 * MiB;
constexpr size_t WS_WO0 = 15 * MiB;
constexpr size_t WS_W4 = 17 * MiB;
constexpr size_t WS_WO1 = 34 * MiB;
constexpr size_t WS_ABUF = 38 * MiB;
constexpr size_t WS_Q0 = 70 * MiB, WS_K0 = 86 * MiB, WS_V0 = 102 * MiB, WS_G0 = 134 * MiB, WS_OF = 166 * MiB, WS_OB = 198 * MiB;
constexpr size_t WS_HH = 38 * MiB;
constexpr size_t WS_YF = 38 * MiB, WS_YB = 70 * MiB;
constexpr size_t WS_R1 = 102 * MiB, WS_K1 = 134 * MiB, WS_V1 = 166 * MiB, WS_G1 = 198 * MiB;
constexpr size_t WS_LWA = 230 * MiB;
constexpr size_t WS_OG1 = 102 * MiB;
constexpr size_t WS_END = 246 * MiB;
constexpr int CW_BAR = 4096;
constexpr int RING_BYTES = 131072, LDSCTL_OFF = RING_BYTES, MISC_OFF = LDSCTL_OFF + 320, LDS_BYTES = 147456;


struct Args { const float* in[30]; float* out; unsigned char* ws; int ph_lo, ph_hi, li, pad; };
enum { I_XP = 0, I_XS, I_SG, I_SR, I_C, I_CCTX, I_WMOD, I_BMOD, I_NORMW, I_GWIN, I_GWA1, I_GWA2, I_GBA, I_GNORM, I_GWOUT, I_MU, I_WRKVG, I_W0, I_W1, I_W2, I_A0, I_A1, I_A2, I_KK, I_KA, I_RK, I_LNW, I_LNB, I_RWOUT, I_NORMF };

namespace pg8 {
#define PG8_LAS __attribute__((address_space(3)))
typedef unsigned short bf16_t;
typedef short bf16x8 __attribute__((ext_vector_type(8)));
typedef float f32x4 __attribute__((ext_vector_type(4)));
typedef unsigned u32x4 __attribute__((ext_vector_type(4)));
constexpr int BM = 256, BK = 64, HALF = 128, HTB = HALF * BK * 2  , STAGE_BYTES = 8 * HTB, NXCD = 8, WGM = 8;

__host__ __device__ __forceinline__ int lds_byte(int r, int c) { const int st = (r >> 4) * 2 + (c >> 5), rr = r & 15, cc = c & 31, ob = rr * 64 + cc * 2; return st * 1024 + (ob ^ (((ob >> 9) & 1) << 5)); }
__host__ __device__ __forceinline__ void stage_rc(int b, int& R, int& C) { const int st = b / 1024, sb = b % 1024, swz = sb ^ (((sb >> 9) & 1) << 5); R = (st >> 1) * 16 + swz / 64; C = (st & 1) * 32 + (swz % 64) / 2; }
__host__ __device__ __forceinline__ int perm32(int rho) { const int n = rho >> 4, i = rho & 15; return 8 * (i >> 2) + 4 * n + (i & 3); }

struct Unit { int pm, pn; };
struct Gemm { const bf16_t* A; const bf16_t* Bt; int M, N, K; };

struct StaticOrder {
    int nM, nN, nwg, G, c;
    __host__ __device__ void init(int M, int N, int G_, int c_) { nM = M / BM; nN = N / BM; nwg = nM * nN; G = G_; c = c_; }
    __host__ __device__ bool next(int i, Unit& u) const {
        const long L = (long)i * G + c; if (L >= nwg) return false;
        int wgid = (int)L; { const int q = nwg / NXCD, r = nwg % NXCD, xcd = wgid % NXCD, off = wgid / NXCD; wgid = (xcd < r ? xcd * (q + 1) : r * (q + 1) + (xcd - r) * q) + off; }
        const int nig = WGM * nN, gid = wgid / nig, fm = gid * WGM, gsz = (nM - fm) < WGM ? (nM - fm) : WGM;
        u.pm = fm + ((wgid % nig) % gsz); u.pn = (wgid % nig) / gsz; return true;
    }
    __device__ __forceinline__ void a_ready(const Unit&) const {}
    __device__ __forceinline__ void done(const Unit&) const {}
};

__device__ __forceinline__ unsigned cvt_pk_bf16(float lo, float hi) { unsigned r; asm volatile("v_cvt_pk_bf16_f32 %0, %1, %2" : "=v"(r) : "v"(lo), "v"(hi)); return r; }
template <int L> struct EpiPlanes {
    static constexpr bool PERM = true, AFTER_DRAIN = false;
    unsigned char* ws;
    __device__ __forceinline__ void operator()(const f32x4 (&acc)[2][2][4][2], const Unit& u, int wr, int wc, int fr, int fq) const {
        constexpr int T1 = L ? 4 : 2, T2 = L ? 8 : 4, T3 = L ? 12 : 8, T4 = L ? 16 : 12, LRC = L ? 256 : 32, LRLD = L ? 256 : 32;
        constexpr size_t O0 = L ? WS_R1 : WS_Q0, O1 = L ? WS_K1 : WS_K0, O2 = L ? WS_V1 : WS_V0, O3 = L ? WS_G1 : WS_G0, OLR = L ? WS_LWA : WS_HA;
        constexpr int LD01 = L ? 1024 : 512;
        const int row0 = u.pm * BM + wr * 64 + fr;
        if (u.pn >= T4) {
            float* lr = (float*)(ws + OLR);
#pragma unroll
            for (int ai = 0; ai < 2; ++ai)
#pragma unroll
                for (int m = 0; m < 4; ++m) { float* rowp = lr + (size_t)(row0 + ai * HALF + m * 16) * LRLD;
#pragma unroll
                    for (int bj = 0; bj < 2; ++bj)
#pragma unroll
                        for (int n = 0; n < 2; ++n) { const int col = bj * HALF + wc * 32 + 8 * fq + 4 * n; if (col < LRC) *(f32x4*)(rowp + col) = acc[ai][bj][m][n]; } }
            return;
        }
        const int pn = u.pn;
        const size_t off = pn < T1 ? O0 : pn < T2 ? O1 : pn < T3 ? O2 : O3;
        const int ld = pn < T2 ? LD01 : 1024, ts = pn < T1 ? 0 : pn < T2 ? T1 : pn < T3 ? T2 : T3;
        bf16_t* base = (bf16_t*)(ws + off);
        const int col0 = (pn - ts) * BM + wc * 32 + 8 * fq;
#pragma unroll
        for (int ai = 0; ai < 2; ++ai)
#pragma unroll
            for (int m = 0; m < 4; ++m) { bf16_t* rowp = base + (size_t)(row0 + ai * HALF + m * 16) * ld + col0;
#pragma unroll
                for (int bj = 0; bj < 2; ++bj) { const f32x4 v0 = acc[ai][bj][m][0], v1 = acc[ai][bj][m][1];
                    u32x4 w; w.x = cvt_pk_bf16(v0[0], v0[1]); w.y = cvt_pk_bf16(v0[2], v0[3]); w.z = cvt_pk_bf16(v1[0], v1[1]); w.w = cvt_pk_bf16(v1[2], v1[3]);
                    *(u32x4*)(rowp + bj * HALF) = w; } }
    }
};
struct EpiRes {
    static constexpr bool PERM = false, AFTER_DRAIN = false;
    const float* bp; const float* bs;
    float* out;
    const float* gate;
    float* ssq;
    __device__ __forceinline__ void operator()(const f32x4 (&acc)[2][2][4][2], const Unit& u, int wr, int wc, int fr, int fq) const {
#pragma unroll
        for (int ai = 0; ai < 2; ++ai)
#pragma unroll
            for (int m = 0; m < 4; ++m) {
                const int r = u.pm * BM + ai * HALF + wr * 64 + m * 16 + fr;
                const int ci = r < 8192 ? 0 : 1 + ((r - 8192) >> 10);
                const float* brow = r < 8192 ? bp + (size_t)r * 1024 : bs + (size_t)(r - 8192) * 1024;
                float* orow = out + (size_t)r * 1024; const float* grow = gate + ci * 3072;
                float s = 0.f;
#pragma unroll
                for (int bj = 0; bj < 2; ++bj)
#pragma unroll
                    for (int n = 0; n < 2; ++n) { const int c = u.pn * BM + bj * HALF + wc * 32 + n * 16 + 4 * fq;
                        const f32x4 b = *(const f32x4*)(brow + c), g = *(const f32x4*)(grow + c); const f32x4 o = b + g * acc[ai][bj][m][n];
                        *(f32x4*)(orow + c) = o; s += (o[0] * o[0] + o[1] * o[1]) + (o[2] * o[2] + o[3] * o[3]); }
                s += __shfl_xor(s, 16); s += __shfl_xor(s, 32);
                if (fq == 0) ssq[(size_t)r * 16 + u.pn * 4 + wc] = s;
            }
    }
};

template <class Epi, class Sched, bool ALIGN_EPI = false, bool SP2 = false>
__device__ __forceinline__ void gemm_phase(PG8_LAS unsigned char* lds, const Gemm g, const Sched& S, const Epi& E) {
    const int tid = threadIdx.x, wid = __builtin_amdgcn_readfirstlane(tid >> 6), lane = tid & 63, wr = wid >> 2, wc = wid & 3, fr = lane & 15, fq = lane >> 4;
    const int K = g.K, nt = K / BK;
    unsigned voffA[2], voffB[2];
#pragma unroll
    for (int i = 0; i < 2; ++i) { int R, C; stage_rc(tid * 16 + i * 8192, R, C); const int Rb = Epi::PERM ? ((R & ~31) + perm32(R & 31)) : R;
        voffA[i] = (unsigned)(R * K + C) * 2u; voffB[i] = (unsigned)(Rb * K + C) * 2u; }
    const size_t kstep = (size_t)(BK * 2);
    const size_t hstep = (size_t)HALF * K * 2;
    const size_t tstep = 2 * hstep;
    const unsigned ldsw = (unsigned)wid * 1024u;
    const int aoff = lds_byte(wr * 64 + fr, fq * 8), boff = lds_byte(wc * 32 + fr, fq * 8);
#define PG8_SA(b, h) (((b) * 2 + (h)) * HTB)
#define PG8_SB(b, h) ((4 + (b) * 2 + (h)) * HTB)
#define PG8_STAGE(bufoff, gbase, voff) do { _Pragma("unroll") for (int _i = 0; _i < 2; ++_i) \
        __builtin_amdgcn_global_load_lds((const unsigned*)((const char*)(gbase) + (voff)[_i]), (PG8_LAS unsigned*)(lds + (bufoff) + ldsw + _i * 8192), 16, 0, 0); } while (0)
#define PG8_LDA(dst, b, h) do { _Pragma("unroll") for (int m = 0; m < 4; ++m) _Pragma("unroll") for (int k = 0; k < 2; ++k) dst[m][k] = *(const PG8_LAS bf16x8*)(lds + PG8_SA(b, h) + aoff + m * 2048 + k * 1024); } while (0)
#define PG8_LDB(dst, b, h) do { _Pragma("unroll") for (int n = 0; n < 2; ++n) _Pragma("unroll") for (int k = 0; k < 2; ++k) dst[n][k] = *(const PG8_LAS bf16x8*)(lds + PG8_SB(b, h) + boff + n * 2048 + k * 1024); } while (0)
#define PG8_MMA(ai, bj, At, Bt) do { __builtin_amdgcn_s_setprio(1); _Pragma("unroll") for (int m = 0; m < 4; ++m) _Pragma("unroll") for (int n = 0; n < 2; ++n) _Pragma("unroll") for (int k = 0; k < 2; ++k) \
        acc[ai][bj][m][n] = __builtin_amdgcn_mfma_f32_16x16x32_bf16(Bt[n][k], At[m][k], acc[ai][bj][m][n], 0, 0, 0); __builtin_amdgcn_s_setprio(0); } while (0)
#define PG8_WAIT_V(n) asm volatile("s_waitcnt vmcnt(" #n ")" ::: "memory")
#define PG8_WAIT_L(n) asm volatile("s_waitcnt lgkmcnt(" #n ")" ::: "memory")
#define PG8_BAR __builtin_amdgcn_s_barrier()
#define PG8_SCHED __builtin_amdgcn_sched_barrier(0)
    Unit cur, nxt; int ui = 0;
    if (!S.next(0, cur)) return;
    f32x4 acc[2][2][4][2];
#pragma unroll
    for (int a = 0; a < 2; ++a)
#pragma unroll
        for (int b = 0; b < 2; ++b)
#pragma unroll
            for (int m = 0; m < 4; ++m)
#pragma unroll
                for (int n = 0; n < 2; ++n) acc[a][b][m][n] = (f32x4){0.f, 0.f, 0.f, 0.f};
    bf16x8 At[4][2], B0[2][2], B1[2][2];
    const char* cA = (const char*)g.A + (size_t)cur.pm * tstep; const char* cB = (const char*)g.Bt + (size_t)cur.pn * tstep;
    S.a_ready(cur);
    if constexpr (SP2) {
        PG8_STAGE(PG8_SB(0, 0), cB, voffB); PG8_STAGE(PG8_SB(0, 1), cB + hstep, voffB); PG8_STAGE(PG8_SA(0, 0), cA, voffA); PG8_STAGE(PG8_SA(0, 1), cA + hstep, voffA);
        if (wr == 1) PG8_BAR;
        PG8_WAIT_V(2); PG8_BAR;
        PG8_STAGE(PG8_SB(1, 0), cB + kstep, voffB); PG8_STAGE(PG8_SA(1, 0), cA + kstep, voffA); PG8_STAGE(PG8_SB(1, 1), cB + hstep + kstep, voffB);
        PG8_WAIT_V(6); PG8_BAR;
    } else {
        PG8_STAGE(PG8_SB(0, 0), cB, voffB); PG8_STAGE(PG8_SA(0, 0), cA, voffA); PG8_STAGE(PG8_SB(0, 1), cB + hstep, voffB); PG8_STAGE(PG8_SA(0, 1), cA + hstep, voffA);
        if (wr == 1) PG8_BAR;
        PG8_WAIT_V(4); PG8_BAR;
        PG8_STAGE(PG8_SB(1, 0), cB + kstep, voffB); PG8_STAGE(PG8_SA(1, 0), cA + kstep, voffA); PG8_STAGE(PG8_SB(1, 1), cB + hstep + kstep, voffB);
        PG8_WAIT_V(6); PG8_BAR;
    }
    for (;;) {
        const bool has_next = S.next(ui + 1, nxt);
        const char* nA = has_next ? (const char*)g.A + (size_t)nxt.pm * tstep : cA; const char* nB = has_next ? (const char*)g.Bt + (size_t)nxt.pn * tstep : cB;
        for (int t = 0; t < nt; t += 2) {
            const bool last = (t == nt - 2);
            const char* a1 = cA + (size_t)(t + 1) * kstep;
            const char* a2 = last ? nA : cA + (size_t)(t + 2) * kstep; const char* b2 = last ? nB : cB + (size_t)(t + 2) * kstep;
            const char* a3 = a2 + kstep; const char* b3 = b2 + kstep;
            if (last && has_next) S.a_ready(nxt);
            if constexpr (SP2) {
            PG8_LDB(B0, 0, 0); PG8_LDB(B1, 0, 1); PG8_SCHED; PG8_LDA(At, 0, 0); PG8_STAGE(PG8_SA(1, 1), a1 + hstep, voffA);
            PG8_WAIT_V(8); PG8_WAIT_L(0); PG8_BAR; PG8_MMA(0, 0, At, B0); PG8_MMA(0, 1, At, B1); PG8_BAR; PG8_SCHED;
            PG8_LDA(At, 0, 1); PG8_STAGE(PG8_SB(0, 0), b2, voffB); PG8_STAGE(PG8_SB(0, 1), b2 + hstep, voffB); PG8_STAGE(PG8_SA(0, 0), a2, voffA);
            PG8_WAIT_V(8); PG8_WAIT_L(0); PG8_BAR; PG8_MMA(1, 0, At, B0); PG8_MMA(1, 1, At, B1); PG8_BAR; PG8_SCHED;
            PG8_LDB(B0, 1, 0); PG8_LDB(B1, 1, 1); PG8_SCHED; PG8_LDA(At, 1, 0); PG8_STAGE(PG8_SA(0, 1), a2 + hstep, voffA);
            PG8_WAIT_V(8); PG8_WAIT_L(0); PG8_BAR; PG8_MMA(0, 0, At, B0); PG8_MMA(0, 1, At, B1); PG8_BAR; PG8_SCHED;
            PG8_LDA(At, 1, 1); PG8_STAGE(PG8_SB(1, 0), b3, voffB); PG8_STAGE(PG8_SB(1, 1), b3 + hstep, voffB); PG8_STAGE(PG8_SA(1, 0), a3, voffA);
            PG8_WAIT_V(8); PG8_WAIT_L(0); PG8_BAR; PG8_MMA(1, 0, At, B0); PG8_MMA(1, 1, At, B1); PG8_BAR; PG8_SCHED;
            } else {
            PG8_LDB(B0, 0, 0); PG8_SCHED; PG8_LDA(At, 0, 0); PG8_STAGE(PG8_SA(1, 1), a1 + hstep, voffA);
            PG8_WAIT_L(8); PG8_BAR; PG8_WAIT_L(0); PG8_MMA(0, 0, At, B0); PG8_BAR; PG8_SCHED;
            PG8_LDB(B1, 0, 1); PG8_STAGE(PG8_SB(0, 0), b2, voffB);
            PG8_BAR; PG8_WAIT_L(0); PG8_MMA(0, 1, At, B1); PG8_BAR;
            PG8_LDA(At, 0, 1); PG8_STAGE(PG8_SA(0, 0), a2, voffA);
            PG8_BAR; PG8_WAIT_L(0); PG8_MMA(1, 0, At, B0); PG8_BAR; PG8_SCHED;
            PG8_STAGE(PG8_SB(0, 1), b2 + hstep, voffB);
            PG8_WAIT_V(6); PG8_BAR; PG8_MMA(1, 1, At, B1); PG8_BAR;
            PG8_LDB(B0, 1, 0); PG8_SCHED; PG8_LDA(At, 1, 0); PG8_STAGE(PG8_SA(0, 1), a2 + hstep, voffA);
            PG8_WAIT_L(8); PG8_BAR; PG8_WAIT_L(0); PG8_MMA(0, 0, At, B0); PG8_BAR; PG8_SCHED;
            PG8_LDB(B1, 1, 1); PG8_STAGE(PG8_SB(1, 0), b3, voffB);
            PG8_BAR; PG8_WAIT_L(0); PG8_MMA(0, 1, At, B1); PG8_BAR;
            PG8_LDA(At, 1, 1); PG8_STAGE(PG8_SA(1, 0), a3, voffA);
            PG8_BAR; PG8_WAIT_L(0); PG8_MMA(1, 0, At, B0); PG8_BAR; PG8_SCHED;
            PG8_STAGE(PG8_SB(1, 1), b3 + hstep, voffB);
            PG8_WAIT_V(6); PG8_BAR; PG8_MMA(1, 1, At, B1); PG8_BAR;
            }
        }
        if constexpr (ALIGN_EPI) { if (wr == 0) PG8_BAR; }
        if constexpr (!Epi::AFTER_DRAIN) { E(acc, cur, wr, wc, fr, fq); S.done(cur); }
        if (!has_next) break;
#pragma unroll
        for (int a = 0; a < 2; ++a)
#pragma unroll
            for (int b = 0; b < 2; ++b)
#pragma unroll
                for (int m = 0; m < 4; ++m)
#pragma unroll
                    for (int n = 0; n < 2; ++n) acc[a][b][m][n] = (f32x4){0.f, 0.f, 0.f, 0.f};
        cur = nxt; cA = nA; cB = nB; ++ui;
        if constexpr (ALIGN_EPI) { if (wr == 1) PG8_BAR; }
    }
    PG8_WAIT_V(0);
    if constexpr (!ALIGN_EPI) { if (wr == 0) PG8_BAR; }
    PG8_BAR;
    if constexpr (Epi::AFTER_DRAIN) { E.fused(acc, cur, wr, wc, fr, fq, lds, wid, lane); S.done(cur); }
#undef PG8_SA
#undef PG8_SB
#undef PG8_STAGE
#undef PG8_LDA
#undef PG8_LDB
#undef PG8_MMA
#undef PG8_WAIT_V
#undef PG8_WAIT_L
#undef PG8_BAR
#undef PG8_SCHED
}
}
#define GAS __attribute__((address_space(1)))
#define LAS __attribute__((address_space(3)))
typedef unsigned short bf16;
typedef unsigned v4u __attribute__((ext_vector_type(4)));
typedef float f32x4 __attribute__((ext_vector_type(4)));
typedef short bf16x8 __attribute__((ext_vector_type(8)));
typedef GAS unsigned gu32;
typedef GAS unsigned long long gu64;
#define RLX_AGENT __ATOMIC_RELAXED, __HIP_MEMORY_SCOPE_AGENT
#define LDS_WAIT() asm volatile("s_waitcnt lgkmcnt(0)" ::: "memory")
#define VM_WAIT() asm volatile("s_waitcnt vmcnt(0)" ::: "memory")
__device__ __forceinline__ unsigned long long rt() { return __builtin_amdgcn_s_memrealtime(); }
__device__ __forceinline__ unsigned f2bf(float f) { unsigned u = __builtin_bit_cast(unsigned, f); return (u + 0x7fffu + ((u >> 16) & 1u)) >> 16; }
__device__ __forceinline__ unsigned pk2(float lo, float hi) { return f2bf(lo) | (f2bf(hi) << 16); }

#define XB_TMO      128
#define XB_XCNT(j)  (256  + 64 * (j))
#define XB_XSUB(j)  (1280 + 64 * (j))
#define XB_XGEN(j)  (2304 + 64 * (j))
#define XB_TOP      3328
#define XB_TOPGEN   3392
#define XCD_BAR_WORDS 3456
#define XB_SPIN_CAP (1u << 18)

__device__ __forceinline__ unsigned xb_ld(unsigned* p)              { return __hip_atomic_load(p, __ATOMIC_RELAXED, __HIP_MEMORY_SCOPE_AGENT); }
__device__ __forceinline__ unsigned xb_add(unsigned* p, unsigned v) { return __hip_atomic_fetch_add(p, v, __ATOMIC_RELAXED, __HIP_MEMORY_SCOPE_AGENT); }
__device__ __forceinline__ unsigned xb_xcc_id() { return (unsigned)__builtin_amdgcn_s_getreg((3 << 11) | 20) & 0xFu; }
#define XB_SPIN(cond, bar) do { unsigned _sp = 0; while (cond) { __builtin_amdgcn_s_sleep(1); \
    if ((++_sp & 255u) == 0u) { if (xb_ld(&(bar)[XB_TMO])) break; if (_sp > XB_SPIN_CAP) { atomicAdd(&(bar)[XB_TMO], 1u); break; } } } } while (0)

struct XcdBarrier {
    unsigned* bar; unsigned x;
    volatile LAS unsigned* st;
};

__device__ __forceinline__ XcdBarrier xcd_barrier_post(unsigned* bar, volatile LAS unsigned* st) {
    XcdBarrier b; b.bar = bar; b.x = xb_xcc_id(); b.st = st;
    if (threadIdx.x == 0) (void)xb_add(&bar[XB_XCNT(b.x)], 1u);
    return b;
}
__device__ __forceinline__ void xcd_barrier_complete(unsigned* bar, unsigned x, unsigned& nloc, unsigned& nx) {
    const unsigned G = gridDim.x * gridDim.y * gridDim.z;
    unsigned sum, cnt, mine, sp = 0u;
    for (;;) {
        sum = 0u; cnt = 0u; mine = 0u;
#pragma unroll
        for (unsigned j = 0; j < 16; ++j) { const unsigned c = xb_ld(&bar[XB_XCNT(j)]); sum += c; cnt += (c > 0u) ? 1u : 0u; mine = (j == x) ? c : mine; }
        if (sum == G) break;
        __builtin_amdgcn_s_sleep(1);
        if ((++sp & 255u) == 0u) { if (xb_ld(&bar[XB_TMO])) break; if (sp > XB_SPIN_CAP) { atomicAdd(&bar[XB_TMO], 1u); break; } }
    }
    nloc = mine > 0u ? mine : 1u; nx = cnt > 0u ? cnt : 1u;
}

__device__ __forceinline__ void xcd_barrier(const XcdBarrier& b) {
    asm volatile("s_waitcnt vmcnt(0)" ::: "memory");
    __syncthreads();
    if (threadIdx.x == 0) {
        unsigned* bar = b.bar;
        __builtin_amdgcn_s_waitcnt(0);
        unsigned nloc = b.st[0], nx = b.st[1];
        if (nloc == 0u) { xcd_barrier_complete(bar, b.x, nloc, nx); b.st[0] = nloc; b.st[1] = nx; }
        const unsigned old = xb_add(&bar[XB_XSUB(b.x)], 1u);
        const unsigned gen = old / nloc;
        if (old + 1u == (gen + 1u) * nloc) {
            __builtin_amdgcn_fence(__ATOMIC_RELEASE, "agent");
            asm volatile("s_waitcnt vmcnt(0)" ::: "memory");
            const unsigned og = xb_add(&bar[XB_TOP], 1u);
            const unsigned tg = og / nx;
            if (og + 1u == (tg + 1u) * nx) xb_add(&bar[XB_TOPGEN], 1u);
            else XB_SPIN(xb_ld(&bar[XB_TOPGEN]) == tg, bar);
            __builtin_amdgcn_fence(__ATOMIC_ACQUIRE, "agent");
            xb_add(&bar[XB_XGEN(b.x)], 1u);
            asm volatile("s_waitcnt vmcnt(0)" ::: "memory");
        } else {
            XB_SPIN(xb_ld(&bar[XB_XGEN(b.x)]) == gen, bar);
            __builtin_amdgcn_fence(__ATOMIC_ACQUIRE, "agent");
            asm volatile("s_waitcnt vmcnt(0)" ::: "memory");
        }
    }
    __syncthreads();
}

typedef float f32x16 __attribute__((ext_vector_type(16)));
typedef unsigned v2u __attribute__((ext_vector_type(2)));
#define BAR() __syncthreads()
#define MFMA32(a, b, c) __builtin_amdgcn_mfma_f32_32x32x16_bf16(a, b, c, 0, 0, 0)
#define MFMA16(a, b, c) __builtin_amdgcn_mfma_f32_16x16x32_bf16(a, b, c, 0, 0, 0)
#define SHFLX(v, m) __shfl_xor(v, m)
#define RFL(x) __builtin_amdgcn_readfirstlane(x)
#define FORCEINLINE __device__ __forceinline__
__device__ __forceinline__ unsigned CVTPK(float lo, float hi) { unsigned r; asm volatile("v_cvt_pk_bf16_f32 %0, %1, %2" : "=v"(r) : "v"(lo), "v"(hi)); return r; }
__device__ __forceinline__ float bf2f(unsigned short b) { return __uint_as_float(((unsigned)b) << 16); }
__device__ __forceinline__ float wave_sum(float v) {
#pragma unroll
    for (int o = 1; o < 64; o <<= 1) v += __shfl_xor(v, o);
    return v;
}
__device__ __forceinline__ float silu_f(float x) { return x / (1.f + __expf(-x)); }

constexpr int GL_QB = 0;
constexpr int GL_KB = GL_QB + 64 * 272;
constexpr int GL_KDT = GL_KB + 64 * 272;
constexpr int GL_VT = GL_KDT + 128 * 144;
constexpr int GL_SC = GL_VT + 256 * 144;
constexpr int GL_DEC = GL_SC + 64 * 144;
constexpr int GL_TOT = GL_DEC + 512;
constexpr int GL_END = GL_TOT + 2048;
static_assert(GL_END <= 131072, "GLA LDS map");

FORCEINLINE void phase_gla_chunk(const Args& A, LAS unsigned char* lds, int tid, int blk) {
    LAS bf16* QB = (LAS bf16*)(lds + GL_QB); LAS bf16* KB = (LAS bf16*)(lds + GL_KB); LAS bf16* KDT = (LAS bf16*)(lds + GL_KDT); LAS bf16* VT = (LAS bf16*)(lds + GL_VT);
    LAS bf16* SC = (LAS bf16*)(lds + GL_SC); LAS float* DEC = (LAS float*)(lds + GL_DEC); LAS float* TOT = (LAS float*)(lds + GL_TOT);
    const bf16* Q0 = (const bf16*)(A.ws + WS_Q0); const bf16* K0 = (const bf16*)(A.ws + WS_K0); const bf16* V0 = (const bf16*)(A.ws + WS_V0); const float* HA = (const float*)(A.ws + WS_HA);
    const int lane = tid & 63, wave = RFL(tid >> 6), l31 = lane & 31, hh = lane >> 5;
    const int j = tid & 127, qtr = RFL(tid >> 7);
    for (int slot = 0; slot < 2; ++slot) {
        int item; bool sample;
        if (blk < 64) { if (slot) break; sample = true; item = blk; }
        else { const int q = blk - 64; if (slot == 0) item = q; else { if (q >= 64) break; item = 192 + q; } sample = false; }
        const int b = item >> 3, h = (item >> 1) & 3, d = item & 1, T = sample ? 1024 : 256, row0 = sample ? MP + b * 1024 : b * 256;
        bf16* OUT = (bf16*)(A.ws + (d ? WS_OB : WS_OF));
        const int ecol = 32 * wave + l31;
        f32x16 S[4];
        if (sample) { const float* sp = A.in[I_SG] + ((((size_t)b * 2 + d) * 4 + h) * 128) * 256 + ecol;
#pragma unroll
            for (int t = 0; t < 4; ++t)
#pragma unroll
                for (int r = 0; r < 16; ++r) S[t][r] = sp[(size_t)(32 * t + (r & 3) + 8 * (r >> 2) + 4 * hh) * 256]; }
        else {
#pragma unroll
            for (int t = 0; t < 4; ++t)
#pragma unroll
                for (int r = 0; r < 16; ++r) S[t][r] = 0.f; }
        float wa2[16];
#pragma unroll
        for (int m = 0; m < 16; ++m) wa2[m] = A.in[I_GWA2][((size_t)d * 16 + m) * 512 + h * 128 + j];
        const float ba = A.in[I_GBA][d * 512 + h * 128 + j];
        for (int ch = 0; ch < T / 64; ++ch) {
            float bl[16]; float run = 0.f;
#pragma unroll
            for (int ii = 0; ii < 16; ++ii) { const int s = 64 * ch + 16 * qtr + ii, t = d ? T - 1 - s : s; const float* ha = HA + ((size_t)row0 + t) * 32 + d * 16; float z = ba;
#pragma unroll
                for (int m = 0; m < 16; ++m) z += ha[m] * wa2[m];
                const float ls = fminf(z, 0.f) - log1pf(expf(-fabsf(z)));
                run += ls * (1.f / 16.f); bl[ii] = run; }
            TOT[qtr * 128 + j] = run;
            BAR();
            float off = 0.f, tot = 0.f;
#pragma unroll
            for (int q = 0; q < 4; ++q) { const float tv = TOT[q * 128 + j]; off += q < qtr ? tv : 0.f; tot += tv; }
            if (qtr == 0) DEC[j] = expf(tot);
            unsigned kdp[8];
#pragma unroll
            for (int ii = 0; ii < 16; ii += 2) { float kdv[2];
#pragma unroll
                for (int u = 0; u < 2; ++u) { const int i = 16 * qtr + ii + u, s = 64 * ch + i, t = d ? T - 1 - s : s; const size_t row = (size_t)row0 + t; const float bb = bl[ii + u] + off;
                    const float qv = bf2f(Q0[row * 512 + h * 128 + j]), kv = bf2f(K0[row * 512 + h * 128 + j]);
                    QB[i * 136 + j] = (bf16)f2bf(qv * expf(bb) * 0.08838834764831845f); KB[i * 136 + j] = (bf16)f2bf(kv * expf(-bb)); kdv[u] = kv * expf(tot - bb); }
                kdp[ii >> 1] = CVTPK(kdv[0], kdv[1]); }
            *(LAS v4u*)(KDT + j * 72 + 16 * qtr) = (v4u){kdp[0], kdp[1], kdp[2], kdp[3]};
            *(LAS v4u*)(KDT + j * 72 + 16 * qtr + 8) = (v4u){kdp[4], kdp[5], kdp[6], kdp[7]};
            { const int sv = tid & 63, cg = tid >> 6, s = 64 * ch + sv, t = d ? T - 1 - s : s; const bf16* vrow = V0 + ((size_t)row0 + t) * 1024 + h * 256;
#pragma unroll
                for (int i4 = 0; i4 < 4; ++i4) { const int e0 = (cg * 4 + i4) * 8; const v4u w = *(const v4u*)(vrow + e0);
#pragma unroll
                    for (int u = 0; u < 4; ++u) { VT[(e0 + 2 * u) * 72 + sv] = (bf16)(w[u] & 0xffffu); VT[(e0 + 2 * u + 1) * 72 + sv] = (bf16)(w[u] >> 16); } } }
            BAR();
            if (wave < 3) { const int ct = wave == 0 ? 0 : 1, st = wave == 2 ? 1 : 0;
                f32x16 sc;
#pragma unroll
                for (int r = 0; r < 16; ++r) sc[r] = 0.f;
#pragma unroll
                for (int ks = 0; ks < 8; ++ks) { const bf16x8 a = *(const LAS bf16x8*)(QB + (32 * ct + l31) * 136 + 16 * ks + 8 * hh), bf = *(const LAS bf16x8*)(KB + (32 * st + l31) * 136 + 16 * ks + 8 * hh); sc = MFMA32(a, bf, sc); }
#pragma unroll
                for (int r = 0; r < 16; ++r) { const int c = 32 * ct + (r & 3) + 8 * (r >> 2) + 4 * hh, s_ = 32 * st + l31; SC[c * 72 + s_] = (bf16)f2bf(c >= s_ ? sc[r] : 0.f); } }
            f32x16 O[2];
#pragma unroll
            for (int ct = 0; ct < 2; ++ct)
#pragma unroll
                for (int r = 0; r < 16; ++r) O[ct][r] = 0.f;
#pragma unroll
            for (int t = 0; t < 4; ++t)
#pragma unroll
                for (int ks = 0; ks < 2; ++ks) {
                    v4u pk; pk[0] = CVTPK(S[t][8 * ks + 0], S[t][8 * ks + 1]); pk[1] = CVTPK(S[t][8 * ks + 2], S[t][8 * ks + 3]); pk[2] = CVTPK(S[t][8 * ks + 4], S[t][8 * ks + 5]); pk[3] = CVTPK(S[t][8 * ks + 6], S[t][8 * ks + 7]);
                    const bf16x8 bfrag = __builtin_bit_cast(bf16x8, pk);
#pragma unroll
                    for (int ct = 0; ct < 2; ++ct) { const LAS bf16* ap = QB + (32 * ct + l31) * 136 + 32 * t + 16 * ks + 4 * hh;
                        const v2u lo = *(const LAS v2u*)ap, hi = *(const LAS v2u*)(ap + 8); const v4u av = (v4u){lo[0], lo[1], hi[0], hi[1]};
                        O[ct] = MFMA32(__builtin_bit_cast(bf16x8, av), bfrag, O[ct]); } }
            bf16x8 vb[4];
#pragma unroll
            for (int ks = 0; ks < 4; ++ks) vb[ks] = *(const LAS bf16x8*)(VT + ecol * 72 + 16 * ks + 8 * hh);
#pragma unroll
            for (int t = 0; t < 4; ++t) {
#pragma unroll
                for (int g = 0; g < 4; ++g) { const f32x4 dc = *(const LAS f32x4*)(DEC + 32 * t + 8 * g + 4 * hh);
#pragma unroll
                    for (int c = 0; c < 4; ++c) S[t][4 * g + c] *= dc[c]; }
#pragma unroll
                for (int ks = 0; ks < 4; ++ks) { const bf16x8 a = *(const LAS bf16x8*)(KDT + (32 * t + l31) * 72 + 16 * ks + 8 * hh); S[t] = MFMA32(a, vb[ks], S[t]); } }
            BAR();
#pragma unroll
            for (int ct = 0; ct < 2; ++ct)
#pragma unroll
                for (int ks = 0; ks < 4; ++ks) if (ks < (ct ? 4 : 2)) { const bf16x8 a = *(const LAS bf16x8*)(SC + (32 * ct + l31) * 72 + 16 * ks + 8 * hh); O[ct] = MFMA32(a, vb[ks], O[ct]); }
#pragma unroll
            for (int ct = 0; ct < 2; ++ct)
#pragma unroll
                for (int r = 0; r < 16; ++r) { const int c = 32 * ct + (r & 3) + 8 * (r >> 2) + 4 * hh, s = 64 * ch + c, t = d ? T - 1 - s : s;
                    OUT[((size_t)row0 + t) * 1024 + h * 256 + ecol] = (bf16)f2bf(O[ct][r]); }
        }
        if (!sample) { float* dst = A.out + OUT_SG + ((((size_t)b * 2 + d) * 4 + h) * 128) * 256 + ecol;
#pragma unroll
            for (int t = 0; t < 4; ++t)
#pragma unroll
                for (int r = 0; r < 16; ++r) dst[(size_t)(32 * t + (r & 3) + 8 * (r >> 2) + 4 * hh) * 256] = S[t][r]; }
        BAR();
    }
}
__device__ __forceinline__ void tr_item(const float* W, int N, bf16* WT, int ldo, int row_off, int col_off, const float* mu, int mode, LAS float* scr, int item, int lane) {
    const int nblk = N / 32, kb = item / nblk, nb = item % nblk, k0 = 64 * kb, n0 = 32 * nb;
#pragma unroll 8
    for (int i = 0; i < 32; ++i) { const int kk = 2 * i + (lane >> 5); float s = 1.f; if (mode) { const float m_ = mu[k0 + kk]; s = mode == 1 ? 1.f - m_ : m_; }
        scr[kk * 33 + (lane & 31)] = W[(size_t)(k0 + kk) * N + n0 + (lane & 31)] * s; }
    LDS_WAIT(); asm volatile("" ::: "memory");
    const int c = lane & 7;
#pragma unroll
    for (int j = 0; j < 4; ++j) { const int n = (lane >> 3) + 8 * j; const LAS float* s = scr + (8 * c) * 33 + n;
        v4u o; o.x = pk2(s[0 * 33], s[1 * 33]); o.y = pk2(s[2 * 33], s[3 * 33]); o.z = pk2(s[4 * 33], s[5 * 33]); o.w = pk2(s[6 * 33], s[7 * 33]);
        *(v4u*)(WT + (size_t)(row_off + n0 + n) * ldo + col_off + k0 + 8 * c) = o; }
    LDS_WAIT(); asm volatile("" ::: "memory");
}
__device__ __forceinline__ void phase0(const Args& A, LAS unsigned char* lds, int tid, int lane, int wave) {
    unsigned char* ws = A.ws;
    const int G = gridDim.x, blk = blockIdx.x;
    {
        LAS float* scond = (LAS float*)lds;
        LAS float* red = scond + 9 * 1024;
        bool filled = false;
        for (int item = blk; item < 96; item += G) {
            if (!filled) {
                for (int idx = tid; idx < 9 * 1024; idx += NTHR) { const int r = idx >> 10, k = idx & 1023; const float c = r == 0 ? A.in[I_CCTX][k] : A.in[I_C][(r - 1) * 1024 + k]; scond[idx] = silu_f(c); }
                filled = true;
            }
            __syncthreads();
            const int l = item / 48, g = item % 48, col = g * 64 + lane;
            float acc[9];
#pragma unroll
            for (int r = 0; r < 9; ++r) acc[r] = 0.f;
            const float* wp = A.in[I_WMOD] + ((size_t)l * 1024 + wave * 128) * 3072 + col;
#pragma unroll 4
            for (int k = 0; k < 128; ++k) { const float wv = wp[(size_t)k * 3072];
#pragma unroll
                for (int r = 0; r < 9; ++r) acc[r] += scond[r * 1024 + wave * 128 + k] * wv; }
#pragma unroll
            for (int r = 0; r < 9; ++r) red[(wave * 9 + r) * 64 + lane] = acc[r];
            __syncthreads();
            for (int idx = tid; idx < 576; idx += NTHR) { const int r = idx >> 6, ln = idx & 63; float s = A.in[I_BMOD][l * 3072 + g * 64 + ln];
#pragma unroll
                for (int w = 0; w < 8; ++w) s += red[(w * 9 + r) * 64 + ln];
                ((float*)(ws + WS_MOD))[(l * 9 + r) * 3072 + g * 64 + ln] = s; }
            __syncthreads();
        }
        __syncthreads();
    }
    LAS float* scr = (LAS float*)(lds + wave * 16384);
    const int gw = blk * NWAVES + wave, NGW = G * NWAVES;
    bf16* WIN = (bf16*)(ws + WS_WIN); bf16* WO0 = (bf16*)(ws + WS_WO0); bf16* W4 = (bf16*)(ws + WS_W4); bf16* WO1 = (bf16*)(ws + WS_WO1);
    constexpr int I_IN = 16 * 96, I_SQ = 16 * 32, I_LR = 16 * 2;
    constexpr int NITEMS = I_IN + I_SQ + 8 * I_SQ + 8 * I_LR + I_SQ;
    for (int it = gw; it < NITEMS; it += NGW) {
        int r = it;
        if (r < I_IN) { tr_item(A.in[I_GWIN], 3072, WIN, 1024, 0, 0, nullptr, 0, scr, r, lane); continue; } r -= I_IN;
        if (r < I_SQ) { tr_item(A.in[I_GWOUT], 1024, WO0, 1024, 0, 0, nullptr, 0, scr, r, lane); continue; } r -= I_SQ;
        if (r < 8 * I_SQ) { const int p = r / (2 * I_SQ), hf = (r / I_SQ) & 1; tr_item(A.in[I_WRKVG] + (size_t)p * 1024 * 1024, 1024, W4, 2048, p * 1024, hf * 1024, A.in[I_MU] + p * 1024, 1 + hf, scr, r % I_SQ, lane); continue; } r -= 8 * I_SQ;
        if (r < 8 * I_LR) { const int q = r / I_LR, which = q >> 2, d = (q >> 1) & 1, hf = q & 1;
            tr_item((which ? A.in[I_A1] : A.in[I_W1]) + (size_t)d * 1024 * 64, 64, W4, 2048, 4096 + which * 128 + d * 64, hf * 1024, A.in[I_MU] + (4 + which) * 1024, 1 + hf, scr, r % I_LR, lane); continue; } r -= 8 * I_LR;
        tr_item(A.in[I_RWOUT], 1024, WO1, 1024, 0, 0, nullptr, 0, scr, r, lane);
    }
    const int gt = blk * NTHR + tid, NGT = G * NTHR;
    for (int idx = gt; idx < 2 * 16 * 1024; idx += NGT) { const int k = idx & 1023, j = (idx >> 10) & 15, d = idx >> 14;
        WIN[(size_t)(3072 + d * 16 + j) * 1024 + k] = (bf16)f2bf(A.in[I_GWA1][((size_t)d * 1024 + k) * 16 + j]); }
    for (int idx = gt; idx < 224 * 1024 / 8; idx += NGT) ((v4u*)(WIN + (size_t)3104 * 1024))[idx] = (v4u){0u, 0u, 0u, 0u};
}

__device__ __forceinline__ const float* xrow_in(const Args& A, int r) { return r < MP ? A.in[I_XP] + (size_t)r * D : A.in[I_XS] + (size_t)(r - MP) * D; }
__device__ __forceinline__ int cond_of(int r) { return r < MP ? 0 : 1 + ((r - MP) >> 10); }
__device__ __forceinline__ void store_bf4(bf16* p, f32x4 v) { *(unsigned long long*)p = (unsigned long long)pk2(v[0], v[1]) | ((unsigned long long)pk2(v[2], v[3]) << 32); }
__device__ __forceinline__ f32x4 load_bf4(const bf16* p) { const unsigned long long w = *(const unsigned long long*)p; const unsigned lo = (unsigned)w, hi = (unsigned)(w >> 32);
    return (f32x4){__uint_as_float(lo << 16), __uint_as_float(lo & 0xffff0000u), __uint_as_float(hi << 16), __uint_as_float(hi & 0xffff0000u)}; }

__device__ __forceinline__ void phase_h0(const Args& A, int lane, int gw, int NGW) {
    const float* MOD = (const float*)(A.ws + WS_MOD); bf16* XN = (bf16*)(A.ws + WS_ABUF); const float* nw = A.in[I_NORMW];
    for (int r = gw; r < M; r += NGW) {
        const f32x4* xr = (const f32x4*)xrow_in(A, r) + lane;
        f32x4 v[4]; float s = 0.f;
#pragma unroll
        for (int j = 0; j < 4; ++j) { v[j] = xr[64 * j]; s += (v[j][0] * v[j][0] + v[j][1] * v[j][1]) + (v[j][2] * v[j][2] + v[j][3] * v[j][3]); }
        const float rstd = 1.f / sqrtf(wave_sum(s) * (1.f / D) + EPS);
        const float* md = MOD + cond_of(r) * 3072;
#pragma unroll
        for (int j = 0; j < 4; ++j) { const int c = 256 * j + 4 * lane; const f32x4 w = *(const f32x4*)(nw + c), sh = *(const f32x4*)(md + c), sc = *(const f32x4*)(md + 1024 + c);
            store_bf4(XN + (size_t)r * D + c, (v[j] * rstd) * w * (sc + 1.f) + sh); }
    }
}
__device__ __forceinline__ void phase_og0(const Args& A, int lane, int gw, int NGW) {
    const bf16* OF = (const bf16*)(A.ws + WS_OF); const bf16* OB = (const bf16*)(A.ws + WS_OB); const bf16* G0 = (const bf16*)(A.ws + WS_G0); bf16* OG = (bf16*)(A.ws + WS_ABUF);
    const f32x4 wn = *(const f32x4*)(A.in[I_GNORM] + 4 * lane);
    for (int r = gw; r < M; r += NGW) {
#pragma unroll
        for (int j = 0; j < 4; ++j) { const size_t o = (size_t)r * D + 256 * j + 4 * lane; const f32x4 v = load_bf4(OF + o) + load_bf4(OB + o);
            const float ms = wave_sum((v[0] * v[0] + v[1] * v[1]) + (v[2] * v[2] + v[3] * v[3])) * (1.f / 256.f); const float rs = 1.f / sqrtf(ms + EPS);
            const f32x4 g = load_bf4(G0 + o); f32x4 y = v * rs * wn;
            y[0] *= silu_f(g[0]); y[1] *= silu_f(g[1]); y[2] *= silu_f(g[2]); y[3] *= silu_f(g[3]);
            store_bf4(OG + o, y); }
    }
}
__device__ __forceinline__ float row_rstd(const float* ssq, int r, int lane) { float s = lane < 16 ? ssq[(size_t)r * 16 + lane] : 0.f; return 1.f / sqrtf(wave_sum(s) * (1.f / D) + EPS); }
__device__ __forceinline__ void phase_hh(const Args& A, int lane, int gw, int NGW) {
    const float* MOD = (const float*)(A.ws + WS_MOD) + 9 * 3072; const float* ssq = (const float*)(A.ws + WS_SSQ1); bf16* HH = (bf16*)(A.ws + WS_HH); const float* nw = A.in[I_NORMW] + 1024; const float* X1 = A.out;
    for (int r = gw; r < M; r += NGW) {
        const float* md = MOD + cond_of(r) * 3072;
        int n0, n1, n2, n3; bool v0, v1, v2, v3; float wgt;
        if (r < MP) { const int t = r & 255; wgt = 0.5f; n0 = r - 1; v0 = t > 0; n1 = r + 1; v1 = t < 255; n2 = r; v2 = false; n3 = r; v3 = false; }
        else { const int t = (r - MP) & 1023, gr = t >> 6, gc = t & 63; wgt = 0.25f; n0 = r - 64; v0 = gr > 0; n1 = r + 64; v1 = gr < 15; n2 = r - 1; v2 = gc > 0; n3 = r + 1; v3 = gc < 63; }
        const int cnt = (int)v0 + (int)v1 + (int)v2 + (int)v3;
        const float rs = row_rstd(ssq, r, lane);
        f32x4 acc[4];
#pragma unroll
        for (int j = 0; j < 4; ++j) acc[j] = (f32x4){0.f, 0.f, 0.f, 0.f};
#pragma unroll
        for (int q = 0; q < 4; ++q) { const int n = q == 0 ? n0 : q == 1 ? n1 : q == 2 ? n2 : n3; const bool vld = q == 0 ? v0 : q == 1 ? v1 : q == 2 ? v2 : v3;
            if (vld) { const float rn = row_rstd(ssq, n, lane); const f32x4* xp = (const f32x4*)(X1 + (size_t)n * D) + lane;
#pragma unroll
                for (int j = 0; j < 4; ++j) acc[j] += xp[64 * j] * rn; } }
        const f32x4* xr = (const f32x4*)(X1 + (size_t)r * D) + lane;
#pragma unroll
        for (int j = 0; j < 4; ++j) { const int c = 256 * j + 4 * lane; const f32x4 w = *(const f32x4*)(nw + c), sh = *(const f32x4*)(md + c), sc = *(const f32x4*)(md + 1024 + c); const f32x4 cc = w * (sc + 1.f);
            store_bf4(HH + (size_t)r * 2048 + c, (xr[64 * j] * rs) * cc + sh);
            store_bf4(HH + (size_t)r * 2048 + 1024 + c, (acc[j] * cc + sh * (float)cnt) * wgt); }
    }
}
__device__ __forceinline__ void phase_og1(const Args& A, int lane, int gw, int NGW) {
    const bf16* YF = (const bf16*)(A.ws + WS_YF); const bf16* YB = (const bf16*)(A.ws + WS_YB); const bf16* V1 = (const bf16*)(A.ws + WS_V1); const bf16* G1 = (const bf16*)(A.ws + WS_G1);
    const float* BON = (const float*)(A.ws + WS_BONUS); bf16* OG = (bf16*)(A.ws + WS_OG1);
    for (int r = gw; r < M; r += NGW) {
#pragma unroll
        for (int j = 0; j < 4; ++j) { const int c = 256 * j + 4 * lane, h = c >> 6; const size_t o = (size_t)r * D + c; const f32x4 y = load_bf4(YF + o) + load_bf4(YB + o);
            float s = (y[0] + y[1]) + (y[2] + y[3]);
            s += __shfl_xor(s, 1); s += __shfl_xor(s, 2); s += __shfl_xor(s, 4); s += __shfl_xor(s, 8);
            const float mean = s * (1.f / 64.f); const f32x4 dv = y - mean; float q = (dv[0] * dv[0] + dv[1] * dv[1]) + (dv[2] * dv[2] + dv[3] * dv[3]);
            q += __shfl_xor(q, 1); q += __shfl_xor(q, 2); q += __shfl_xor(q, 4); q += __shfl_xor(q, 8);
            const float rs = 1.f / sqrtf(q * (1.f / 64.f) + LNX_EPS);
            const f32x4 lw = *(const f32x4*)(A.in[I_LNW] + c), lb = *(const f32x4*)(A.in[I_LNB] + c);
            const float bon = BON[((size_t)r * 16 + h) * 2] + BON[((size_t)r * 16 + h) * 2 + 1];
            const f32x4 v = load_bf4(V1 + o), g = load_bf4(G1 + o);
            f32x4 z = dv * rs * lw + lb + v * bon;
            z[0] *= silu_f(g[0]); z[1] *= silu_f(g[1]); z[2] *= silu_f(g[2]); z[3] *= silu_f(g[3]);
            store_bf4(OG + o, z); }
    }
}
__device__ __forceinline__ void phase_final(const Args& A, int lane, int gw, int NGW) {
    const float* ssq = (const float*)(A.ws + WS_SSQ2); const float* nf = A.in[I_NORMF];
    for (int r = gw; r < M; r += NGW) {
        const float rs = row_rstd(ssq, r, lane); f32x4* xr = (f32x4*)(A.out + (size_t)r * D) + lane;
#pragma unroll
        for (int j = 0; j < 4; ++j) { const f32x4 w = *(const f32x4*)(nf + 256 * j + 4 * lane); xr[64 * j] = xr[64 * j] * rs * w; }
    }
}

__device__ __forceinline__ void phase_gla_naive(const Args& A, LAS unsigned char* lds, int tid) {
    LAS float* sq = (LAS float*)lds; LAS float* sk = sq + 1024; LAS float* sal = sk + 1024; LAS float* so = sal + 1024;
    const bf16* Q0 = (const bf16*)(A.ws + WS_Q0); const bf16* K0 = (const bf16*)(A.ws + WS_K0); const bf16* V0 = (const bf16*)(A.ws + WS_V0); const float* HA = (const float*)(A.ws + WS_HA);
    const int e = tid & 255, half = tid >> 8, j = tid & 127, blk = blockIdx.x;
    for (int slot = 0; slot < 2; ++slot) {
        int item; bool sample;
        if (blk < 64) { if (slot) break; sample = true; item = blk; }
        else { const int q = blk - 64; if (slot == 0) item = q; else { if (q >= 64) break; item = 192 + q; } sample = false; }
        const int b = item >> 3, h = (item >> 1) & 3, d = item & 1, T = sample ? 1024 : 256, row0 = sample ? MP + b * 1024 : b * 256;
        bf16* OUT = (bf16*)(A.ws + (d ? WS_OB : WS_OF));
        float S[64];
        if (sample) { const float* sp = A.in[I_SG] + ((((size_t)b * 2 + d) * 4 + h) * 128 + 64 * half) * 256 + e;
#pragma unroll
            for (int jj = 0; jj < 64; ++jj) S[jj] = sp[(size_t)jj * 256]; }
        else {
#pragma unroll
            for (int jj = 0; jj < 64; ++jj) S[jj] = 0.f; }
        float wa2[16];
#pragma unroll
        for (int m = 0; m < 16; ++m) wa2[m] = A.in[I_GWA2][((size_t)d * 16 + m) * 512 + h * 128 + j];
        const float ba = A.in[I_GBA][d * 512 + h * 128 + j];
        for (int s0 = 0; s0 < T; s0 += 8) {
#pragma unroll
            for (int pp = 0; pp < 2; ++pp) { const int tok = (tid >> 7) + 4 * pp, s = s0 + tok, t = d ? T - 1 - s : s; const size_t row = (size_t)row0 + t;
                const float* ha = HA + row * 32 + d * 16; float z = ba;
#pragma unroll
                for (int m = 0; m < 16; ++m) z += ha[m] * wa2[m];
                const float ls = fminf(z, 0.f) - log1pf(expf(-fabsf(z)));
                sal[tok * 128 + j] = expf(ls * (1.f / 16.f));
                sq[tok * 128 + j] = bf2f(Q0[row * 512 + h * 128 + j]) * 0.08838834764831845f;
                sk[tok * 128 + j] = bf2f(K0[row * 512 + h * 128 + j]); }
            __syncthreads();
            for (int tok = 0; tok < 8; ++tok) { const int s = s0 + tok, t = d ? T - 1 - s : s; const size_t row = (size_t)row0 + t;
                const float v = bf2f(V0[row * 1024 + h * 256 + e]); float o = 0.f;
                const LAS f32x4* a4 = (const LAS f32x4*)(sal + tok * 128 + 64 * half); const LAS f32x4* k4 = (const LAS f32x4*)(sk + tok * 128 + 64 * half); const LAS f32x4* q4 = (const LAS f32x4*)(sq + tok * 128 + 64 * half);
#pragma unroll
                for (int g = 0; g < 16; ++g) { const f32x4 al = a4[g], kk = k4[g], qq = q4[g];
#pragma unroll
                    for (int c = 0; c < 4; ++c) { S[4 * g + c] = al[c] * S[4 * g + c] + kk[c] * v; o += qq[c] * S[4 * g + c]; }
                    if ((g & 3) == 3) asm volatile("" ::: "memory"); }
                so[(tok * 2 + half) * 256 + e] = o; }
            __syncthreads();
            for (int idx = tid; idx < 8 * 256; idx += NTHR) { const int tok = idx >> 8, ee = idx & 255, s = s0 + tok, t = d ? T - 1 - s : s; const size_t row = (size_t)row0 + t;
                OUT[row * 1024 + h * 256 + ee] = (bf16)f2bf(so[(tok * 2) * 256 + ee] + so[(tok * 2 + 1) * 256 + ee]); }
        }
        if (!sample) { float* dst = A.out + OUT_SG + ((((size_t)b * 2 + d) * 4 + h) * 128 + 64 * half) * 256 + e;
#pragma unroll
            for (int jj = 0; jj < 64; ++jj) dst[(size_t)jj * 256] = S[jj]; }
        __syncthreads();
    }
}

__device__ __forceinline__ void phase_rwkv_naive(const Args& A, LAS unsigned char* lds, int lane, int wave) {
    const int blk = blockIdx.x;
    int idx; bool sample;
    if (wave == 0) { sample = true; idx = blk; if (idx >= 256) return; }
    else if (wave <= 4) { sample = false; idx = blk * 4 + (wave - 1); if (idx >= 1024) return; }
    else return;
    const int b = idx >> 5, h = (idx >> 1) & 15, d = idx & 1, T = sample ? 1024 : 256, row0 = sample ? MP + b * 1024 : b * 256, hc = h * 64 + lane;
    LAS float* sl = (LAS float*)(lds + wave * 2048);
    LAS float* a2l = (LAS float*)(lds + 16384 + wave * 16384) + lane;
    const bf16* R1 = (const bf16*)(A.ws + WS_R1); const bf16* K1 = (const bf16*)(A.ws + WS_K1); const bf16* V1 = (const bf16*)(A.ws + WS_V1); const float* LWA = (const float*)(A.ws + WS_LWA);
    float* BON = (float*)(A.ws + WS_BONUS); bf16* YO = (bf16*)(A.ws + (d ? WS_YB : WS_YF));
    float S[64], w2c[64];
#pragma unroll
    for (int m = 0; m < 64; ++m) { w2c[m] = A.in[I_W2][((size_t)d * 64 + m) * 1024 + hc]; a2l[m * 64] = A.in[I_A2][((size_t)d * 64 + m) * 1024 + hc]; }
    const float w0v = A.in[I_W0][d * 1024 + hc], a0v = A.in[I_A0][d * 1024 + hc], kkw = A.in[I_KK][d * 1024 + hc], kaw = A.in[I_KA][d * 1024 + hc], rkw = A.in[I_RK][(d * 16 + h) * 64 + lane];
    if (sample) { const f32x4* sp = (const f32x4*)(A.in[I_SR] + ((((size_t)b * 2 + d) * 16 + h) * 64 + lane) * 64);
#pragma unroll
        for (int g = 0; g < 16; ++g) { const f32x4 v = sp[g]; S[4 * g] = v[0]; S[4 * g + 1] = v[1]; S[4 * g + 2] = v[2]; S[4 * g + 3] = v[3]; } }
    else {
#pragma unroll
        for (int jj = 0; jj < 64; ++jj) S[jj] = 0.f; }
    for (int s = 0; s < T; ++s) {
        const int t = d ? T - 1 - s : s; const size_t row = (size_t)row0 + t;
        sl[lane] = tanhf(LWA[row * 256 + d * 64 + lane]); sl[64 + lane] = LWA[row * 256 + 128 + d * 64 + lane];
        LDS_WAIT();
        float wpre = w0v, apre = a0v;
#pragma unroll
        for (int g = 0; g < 16; ++g) { const f32x4 x = ((const LAS f32x4*)sl)[g], y = ((const LAS f32x4*)(sl + 64))[g];
#pragma unroll
            for (int c = 0; c < 4; ++c) { wpre += x[c] * w2c[4 * g + c]; apre += y[c] * a2l[(4 * g + c) * 64]; } }
        const float sp_ = fmaxf(-wpre, 0.f) + log1pf(expf(-fabsf(wpre)));
        const float dec = expf(-expf(-sp_ - 0.5f));
        const float av = 1.f / (1.f + expf(-apre));
        const float kv = bf2f(K1[row * 1024 + hc]), rv = bf2f(R1[row * 1024 + hc]);
        float kk = kv * kkw; const float nrm = sqrtf(wave_sum(kk * kk)); kk = kk / fmaxf(nrm, 1e-12f);
        const float kd = kv * (1.f + (av - 1.f) * kaw);
        const float bon = wave_sum(rv * kd * rkw);
        if (lane == 0) BON[(row * 16 + h) * 2 + d] = bon;
        sl[128 + lane] = dec; sl[192 + lane] = -kk; sl[256 + lane] = kk * av; sl[320 + lane] = kd; sl[384 + lane] = rv;
        LDS_WAIT();
        const float vv = bf2f(V1[row * 1024 + hc]);
        float sa0 = 0.f, sa1 = 0.f, sa2 = 0.f, sa3 = 0.f;
#pragma unroll
        for (int g = 0; g < 16; ++g) { const f32x4 x = ((const LAS f32x4*)(sl + 192))[g]; sa0 += S[4 * g] * x[0]; sa1 += S[4 * g + 1] * x[1]; sa2 += S[4 * g + 2] * x[2]; sa3 += S[4 * g + 3] * x[3]; }
        const float sa = (sa0 + sa1) + (sa2 + sa3);
        float y0 = 0.f, y1 = 0.f, y2 = 0.f, y3 = 0.f;
#pragma unroll
        for (int g = 0; g < 16; ++g) { const f32x4 dw = ((const LAS f32x4*)(sl + 128))[g], bb = ((const LAS f32x4*)(sl + 256))[g], kx = ((const LAS f32x4*)(sl + 320))[g], rr = ((const LAS f32x4*)(sl + 384))[g];
#pragma unroll
            for (int c = 0; c < 4; ++c) S[4 * g + c] = S[4 * g + c] * dw[c] + sa * bb[c] + vv * kx[c];
            y0 += S[4 * g] * rr[0]; y1 += S[4 * g + 1] * rr[1]; y2 += S[4 * g + 2] * rr[2]; y3 += S[4 * g + 3] * rr[3]; }
        YO[row * 1024 + hc] = (bf16)f2bf((y0 + y1) + (y2 + y3));
        LDS_WAIT();
    }
    if (!sample) { f32x4* dp = (f32x4*)(A.out + OUT_SR + ((((size_t)b * 2 + d) * 16 + h) * 64 + lane) * 64);
#pragma unroll
        for (int g = 0; g < 16; ++g) dp[g] = (f32x4){S[4 * g], S[4 * g + 1], S[4 * g + 2], S[4 * g + 3]}; }
}

__global__ void __launch_bounds__(NTHR, 2) trunk_fwd(Args args) {
    extern __shared__ __attribute__((aligned(16))) unsigned char lds_raw[];
    LAS unsigned char* lds = (LAS unsigned char*)lds_raw;
    const int tid = threadIdx.x, lane = tid & 63, wave = __builtin_amdgcn_readfirstlane(tid >> 6);
    const int G = gridDim.x, gw = blockIdx.x * NWAVES + wave, NGW = G * NWAVES;
    volatile LAS unsigned* MISC = (volatile LAS unsigned*)(lds + MISC_OFF);
    for (int u = tid; u < (LDS_BYTES - LDSCTL_OFF) / 4; u += NTHR) ((LAS unsigned*)(lds + LDSCTL_OFF))[u] = 0u;
    __syncthreads();
    unsigned char* ws = args.ws;
    XcdBarrier bar; bar.bar = (unsigned*)(ws + WS_CTL) + CW_BAR; bar.x = 0; bar.st = nullptr;
    if (N_LAUNCHES == 1) bar = xcd_barrier_post((unsigned*)(ws + WS_CTL) + CW_BAR, MISC + 8);
    const int lo = args.ph_lo, hi = args.ph_hi;
#define IN(k) (lo <= (k) && (k) < hi)
#define SEAM(k) do { if (IN(k) && IN((k) + 1)) xcd_barrier(bar); } while (0)
    if (IN(0)) { phase0(args, lds, tid, lane, wave); } SEAM(0);
    if (IN(1)) { phase_h0(args, lane, gw, NGW); } SEAM(1);
    if (IN(2)) {
        pg8::Gemm g{(const pg8::bf16_t*)(ws + WS_ABUF), (const pg8::bf16_t*)(ws + WS_WIN), M, 3328, 1024}; pg8::StaticOrder S; S.init(M, 3328, G, (int)blockIdx.x);
        pg8::EpiPlanes<0> E{ws};
        pg8::gemm_phase<pg8::EpiPlanes<0>, pg8::StaticOrder, true, true>(lds, g, S, E);
    } SEAM(2);
    #ifdef GLA_NAIVE
    if (IN(3)) { phase_gla_naive(args, lds, tid); } SEAM(3);
#else
    if (IN(3)) { phase_gla_chunk(args, lds, tid, (int)blockIdx.x); } SEAM(3);
#endif
    if (IN(4)) { phase_og0(args, lane, gw, NGW); } SEAM(4);
    if (IN(5)) {
        pg8::Gemm g{(const pg8::bf16_t*)(ws + WS_ABUF), (const pg8::bf16_t*)(ws + WS_WO0), M, 1024, 1024}; pg8::StaticOrder S; S.init(M, 1024, G, (int)blockIdx.x);
        pg8::EpiRes E{args.in[I_XP], args.in[I_XS], args.out, (const float*)(ws + WS_MOD) + 2048, (float*)(ws + WS_SSQ1)};
        pg8::gemm_phase<pg8::EpiRes, pg8::StaticOrder, true, true>(lds, g, S, E);
    } SEAM(5);
    if (IN(6)) { phase_hh(args, lane, gw, NGW); } SEAM(6);
    if (IN(7)) {
        pg8::Gemm g{(const pg8::bf16_t*)(ws + WS_HH), (const pg8::bf16_t*)(ws + WS_W4), M, 4352, 2048}; pg8::StaticOrder S; S.init(M, 4352, G, (int)blockIdx.x);
        pg8::EpiPlanes<1> E{ws};
        pg8::gemm_phase<pg8::EpiPlanes<1>, pg8::StaticOrder, true, true>(lds, g, S, E);
    } SEAM(7);
    if (IN(8)) { phase_rwkv_naive(args, lds, lane, wave); } SEAM(8);
    if (IN(9)) { phase_og1(args, lane, gw, NGW); } SEAM(9);
    if (IN(10)) {
        pg8::Gemm g{(const pg8::bf16_t*)(ws + WS_OG1), (const pg8::bf16_t*)(ws + WS_WO1), M, 1024, 1024}; pg8::StaticOrder S; S.init(M, 1024, G, (int)blockIdx.x);
        pg8::EpiRes E{args.out, args.out + OUT_YS, args.out, (const float*)(ws + WS_MOD) + 9 * 3072 + 2048, (float*)(ws + WS_SSQ2)};
        pg8::gemm_phase<pg8::EpiRes, pg8::StaticOrder, true, true>(lds, g, S, E);
    } SEAM(10);
    if (IN(11)) { phase_final(args, lane, gw, NGW); }
#undef IN
#undef SEAM
}

extern "C" void kernel_launch(void* const* d_in, const int* in_sizes, int n_in, void* d_out, int out_size, void* d_ws, size_t ws_size, hipStream_t stream) {
    static int grid = 0;
    if (grid == 0) {
        if (n_in != 30 || ws_size < WS_END) { fprintf(stderr, "kernel_launch: built for 30 inputs and >= %zu bytes of workspace; got n_in %d ws %zu\n", (size_t)WS_END, n_in, ws_size); grid = -1; return; }
        int dev = 0, cus = 0, per_cu = 0;
        if (hipGetDevice(&dev) != hipSuccess || hipDeviceGetAttribute(&cus, hipDeviceAttributeMultiprocessorCount, dev) != hipSuccess) { grid = -1; return; }
        if (hipFuncSetAttribute((const void*)trunk_fwd, hipFuncAttributeMaxDynamicSharedMemorySize, LDS_BYTES) != hipSuccess) { fprintf(stderr, "kernel_launch: hipFuncSetAttribute failed\n"); grid = -1; return; }
        if (hipOccupancyMaxActiveBlocksPerMultiprocessor(&per_cu, (const void*)trunk_fwd, NTHR, LDS_BYTES) != hipSuccess || per_cu < 1) { fprintf(stderr, "kernel_launch: occupancy query reports %d workgroups per CU\n", per_cu); per_cu = 1; }
        (void)hipGetLastError();
        grid = cus;
        if (grid > 256) grid = 256;
    }
    if (grid < 0) return;
    (void)hipMemsetAsync((char*)d_ws + WS_CTL, 0, CTL_ZERO_BYTES, stream);
    Args a{};
    for (int i = 0; i < 30; ++i) a.in[i] = (const float*)d_in[i];
    a.out = (float*)d_out; a.ws = (unsigned char*)d_ws;
    if (N_LAUNCHES == 1) {
        a.ph_lo = 0; a.ph_hi = N_PHASES; a.li = 0;
        void* kargs[] = {&a};
        hipError_t e = hipLaunchCooperativeKernel((const void*)trunk_fwd, dim3(grid), dim3(NTHR), kargs, LDS_BYTES, stream);
        if (e != hipSuccess) fprintf(stderr, "kernel_launch: cooperative launch failed: %s (grid %d)\n", hipGetErrorString(e), grid);
    } else {
        for (int li = 0; li < N_PHASES; ++li) { a.ph_lo = li; a.ph_hi = li + 1; a.li = li;
            hipLaunchKernelGGL(trunk_fwd, dim3(grid), dim3(NTHR), LDS_BYTES, stream, a); }
    }
}
```

```cpp
#include <hip/hip_runtime.h>
#include <cstdio>
#include <cstdint>
constexpr int NWAVES = 8, NTHR = 512;
#ifndef MK_N_LAUNCHES
#define MK_N_LAUNCHES 1
#endif
constexpr int N_PHASES = 12;
constexpr int N_LAUNCHES = MK_N_LAUNCHES;
constexpr int M = 16384, D = 1024, MP = 8192;
constexpr float EPS = 1e-6f, LNX_EPS = 64e-5f;
constexpr size_t OUT_YS = (size_t)MP * D, OUT_SG = (size_t)M * D, OUT_SR = OUT_SG + (size_t)32 * 2 * 4 * 128 * 256;
constexpr size_t MiB = 1u << 20;
constexpr size_t WS_CTL = 0, CTL_ZERO_BYTES = 1 * MiB;
constexpr size_t WS_MOD = 1 * MiB;
constexpr size_t WS_SSQ1 = 2 * MiB, WS_SSQ2 = 3 * MiB;
constexpr size_t WS_BONUS = 4 * MiB;
constexpr size_t WS_HA = 6 * MiB;
constexpr size_t WS_WIN = 8 * MiB;
constexpr size_t WS_WO0 = 15 * MiB;
constexpr size_t WS_W4 = 17 * MiB;
constexpr size_t WS_WO1 = 34 * MiB;
constexpr size_t WS_ABUF = 38 * MiB;
constexpr size_t WS_Q0 = 70 * MiB, WS_K0 = 86 * MiB, WS_V0 = 102 * MiB, WS_G0 = 134 * MiB, WS_OF = 166 * MiB, WS_OB = 198 * MiB;
constexpr size_t WS_HH = 38 * MiB;
constexpr size_t WS_YF = 38 * MiB, WS_YB = 70 * MiB;
constexpr size_t WS_R1 = 102 * MiB, WS_K1 = 134 * MiB, WS_V1 = 166 * MiB, WS_G1 = 198 * MiB;
constexpr size_t WS_LWA = 230 * MiB;
constexpr size_t WS_OG1 = 102 * MiB;
constexpr size_t WS_END = 246 * MiB;
constexpr int CW_BAR = 4096;
constexpr int RING_BYTES = 131072, LDSCTL_OFF = RING_BYTES, MISC_OFF = LDSCTL_OFF + 320, LDS_BYTES = 147456;


struct Args { const float* in[30]; float* out; unsigned char* ws; int ph_lo, ph_hi, li, pad; };
enum { I_XP = 0, I_XS, I_SG, I_SR, I_C, I_CCTX, I_WMOD, I_BMOD, I_NORMW, I_GWIN, I_GWA1, I_GWA2, I_GBA, I_GNORM, I_GWOUT, I_MU, I_WRKVG, I_W0, I_W1, I_W2, I_A0, I_A1, I_A2, I_KK, I_KA, I_RK, I_LNW, I_LNB, I_RWOUT, I_NORMF };

namespace pg8 {
#define PG8_LAS __attribute__((address_space(3)))
typedef unsigned short bf16_t;
typedef short bf16x8 __attribute__((ext_vector_type(8)));
typedef float f32x4 __attribute__((ext_vector_type(4)));
typedef unsigned u32x4 __attribute__((ext_vector_type(4)));
constexpr int BM = 256, BK = 64, HALF = 128, HTB = HALF * BK * 2  , STAGE_BYTES = 8 * HTB, NXCD = 8, WGM = 8;

__host__ __device__ __forceinline__ int lds_byte(int r, int c) { const int st = (r >> 4) * 2 + (c >> 5), rr = r & 15, cc = c & 31, ob = rr * 64 + cc * 2; return st * 1024 + (ob ^ (((ob >> 9) & 1) << 5)); }
__host__ __device__ __forceinline__ void stage_rc(int b, int& R, int& C) { const int st = b / 1024, sb = b % 1024, swz = sb ^ (((sb >> 9) & 1) << 5); R = (st >> 1) * 16 + swz / 64; C = (st & 1) * 32 + (swz % 64) / 2; }
__host__ __device__ __forceinline__ int perm32(int rho) { const int n = rho >> 4, i = rho & 15; return 8 * (i >> 2) + 4 * n + (i & 3); }

struct Unit { int pm, pn; };
struct Gemm { const bf16_t* A; const bf16_t* Bt; int M, N, K; };

struct StaticOrder {
    int nM, nN, nwg, G, c;
    __host__ __device__ void init(int M, int N, int G_, int c_) { nM = M / BM; nN = N / BM; nwg = nM * nN; G = G_; c = c_; }
    __host__ __device__ bool next(int i, Unit& u) const {
        const long L = (long)i * G + c; if (L >= nwg) return false;
        int wgid = (int)L; { const int q = nwg / NXCD, r = nwg % NXCD, xcd = wgid % NXCD, off = wgid / NXCD; wgid = (xcd < r ? xcd * (q + 1) : r * (q + 1) + (xcd - r) * q) + off; }
        const int nig = WGM * nN, gid = wgid / nig, fm = gid * WGM, gsz = (nM - fm) < WGM ? (nM - fm) : WGM;
        u.pm = fm + ((wgid % nig) % gsz); u.pn = (wgid % nig) / gsz; return true;
    }
    __device__ __forceinline__ void a_ready(const Unit&) const {}
    __device__ __forceinline__ void done(const Unit&) const {}
};

__device__ __forceinline__ unsigned cvt_pk_bf16(float lo, float hi) { unsigned r; asm volatile("v_cvt_pk_bf16_f32 %0, %1, %2" : "=v"(r) : "v"(lo), "v"(hi)); return r; }
template <int L> struct EpiPlanes {
    static constexpr bool PERM = true, AFTER_DRAIN = false;
    unsigned char* ws;
    __device__ __forceinline__ void operator()(const f32x4 (&acc)[2][2][4][2], const Unit& u, int wr, int wc, int fr, int fq) const {
        constexpr int T1 = L ? 4 : 2, T2 = L ? 8 : 4, T3 = L ? 12 : 8, T4 = L ? 16 : 12, LRC = L ? 256 : 32, LRLD = L ? 256 : 32;
        constexpr size_t O0 = L ? WS_R1 : WS_Q0, O1 = L ? WS_K1 : WS_K0, O2 = L ? WS_V1 : WS_V0, O3 = L ? WS_G1 : WS_G0, OLR = L ? WS_LWA : WS_HA;
        constexpr int LD01 = L ? 1024 : 512;
        const int row0 = u.pm * BM + wr * 64 + fr;
        if (u.pn >= T4) {
            float* lr = (float*)(ws + OLR);
#pragma unroll
            for (int ai = 0; ai < 2; ++ai)
#pragma unroll
                for (int m = 0; m < 4; ++m) { float* rowp = lr + (size_t)(row0 + ai * HALF + m * 16) * LRLD;
#pragma unroll
                    for (int bj = 0; bj < 2; ++bj)
#pragma unroll
                        for (int n = 0; n < 2; ++n) { const int col = bj * HALF + wc * 32 + 8 * fq + 4 * n; if (col < LRC) *(f32x4*)(rowp + col) = acc[ai][bj][m][n]; } }
            return;
        }
        const int pn = u.pn;
        const size_t off = pn < T1 ? O0 : pn < T2 ? O1 : pn < T3 ? O2 : O3;
        const int ld = pn < T2 ? LD01 : 1024, ts = pn < T1 ? 0 : pn < T2 ? T1 : pn < T3 ? T2 : T3;
        bf16_t* base = (bf16_t*)(ws + off);
        const int col0 = (pn - ts) * BM + wc * 32 + 8 * fq;
#pragma unroll
        for (int ai = 0; ai < 2; ++ai)
#pragma unroll
            for (int m = 0; m < 4; ++m) { bf16_t* rowp = base + (size_t)(row0 + ai * HALF + m * 16) * ld + col0;
#pragma unroll
                for (int bj = 0; bj < 2; ++bj) { const f32x4 v0 = acc[ai][bj][m][0], v1 = acc[ai][bj][m][1];
                    u32x4 w; w.x = cvt_pk_bf16(v0[0], v0[1]); w.y = cvt_pk_bf16(v0[2], v0[3]); w.z = cvt_pk_bf16(v1[0], v1[1]); w.w = cvt_pk_bf16(v1[2], v1[3]);
                    *(u32x4*)(rowp + bj * HALF) = w; } }
    }
};
struct EpiRes {
    static constexpr bool PERM = false, AFTER_DRAIN = false;
    const float* bp; const float* bs;
    float* out;
    const float* gate;
    float* ssq;
    __device__ __forceinline__ void operator()(const f32x4 (&acc)[2][2][4][2], const Unit& u, int wr, int wc, int fr, int fq) const {
#pragma unroll
        for (int ai = 0; ai < 2; ++ai)
#pragma unroll
            for (int m = 0; m < 4; ++m) {
                const int r = u.pm * BM + ai * HALF + wr * 64 + m * 16 + fr;
                const int ci = r < 8192 ? 0 : 1 + ((r - 8192) >> 10);
                const float* brow = r < 8192 ? bp + (size_t)r * 1024 : bs + (size_t)(r - 8192) * 1024;
                float* orow = out + (size_t)r * 1024; const float* grow = gate + ci * 3072;
                float s = 0.f;
#pragma unroll
                for (int bj = 0; bj < 2; ++bj)
#pragma unroll
                    for (int n = 0; n < 2; ++n) { const int c = u.pn * BM + bj * HALF + wc * 32 + n * 16 + 4 * fq;
                        const f32x4 b = *(const f32x4*)(brow + c), g = *(const f32x4*)(grow + c); const f32x4 o = b + g * acc[ai][bj][m][n];
                        *(f32x4*)(orow + c) = o; s += (o[0] * o[0] + o[1] * o[1]) + (o[2] * o[2] + o[3] * o[3]); }
                s += __shfl_xor(s, 16); s += __shfl_xor(s, 32);
                if (fq == 0) ssq[(size_t)r * 16 + u.pn * 4 + wc] = s;
            }
    }
};

template <class Epi, class Sched, bool ALIGN_EPI = false, bool SP2 = false>
__device__ __forceinline__ void gemm_phase(PG8_LAS unsigned char* lds, const Gemm g, const Sched& S, const Epi& E) {
    const int tid = threadIdx.x, wid = __builtin_amdgcn_readfirstlane(tid >> 6), lane = tid & 63, wr = wid >> 2, wc = wid & 3, fr = lane & 15, fq = lane >> 4;
    const int K = g.K, nt = K / BK;
    unsigned voffA[2], voffB[2];
#pragma unroll
    for (int i = 0; i < 2; ++i) { int R, C; stage_rc(tid * 16 + i * 8192, R, C); const int Rb = Epi::PERM ? ((R & ~31) + perm32(R & 31)) : R;
        voffA[i] = (unsigned)(R * K + C) * 2u; voffB[i] = (unsigned)(Rb * K + C) * 2u; }
    const size_t kstep = (size_t)(BK * 2);
    const size_t hstep = (size_t)HALF * K * 2;
    const size_t tstep = 2 * hstep;
    const unsigned ldsw = (unsigned)wid * 1024u;
    const int aoff = lds_byte(wr * 64 + fr, fq * 8), boff = lds_byte(wc * 32 + fr, fq * 8);
#define PG8_SA(b, h) (((b) * 2 + (h)) * HTB)
#define PG8_SB(b, h) ((4 + (b) * 2 + (h)) * HTB)
#define PG8_STAGE(bufoff, gbase, voff) do { _Pragma("unroll") for (int _i = 0; _i < 2; ++_i) \
        __builtin_amdgcn_global_load_lds((const unsigned*)((const char*)(gbase) + (voff)[_i]), (PG8_LAS unsigned*)(lds + (bufoff) + ldsw + _i * 8192), 16, 0, 0); } while (0)
#define PG8_LDA(dst, b, h) do { _Pragma("unroll") for (int m = 0; m < 4; ++m) _Pragma("unroll") for (int k = 0; k < 2; ++k) dst[m][k] = *(const PG8_LAS bf16x8*)(lds + PG8_SA(b, h) + aoff + m * 2048 + k * 1024); } while (0)
#define PG8_LDB(dst, b, h) do { _Pragma("unroll") for (int n = 0; n < 2; ++n) _Pragma("unroll") for (int k = 0; k < 2; ++k) dst[n][k] = *(const PG8_LAS bf16x8*)(lds + PG8_SB(b, h) + boff + n * 2048 + k * 1024); } while (0)
#define PG8_MMA(ai, bj, At, Bt) do { __builtin_amdgcn_s_setprio(1); _Pragma("unroll") for (int m = 0; m < 4; ++m) _Pragma("unroll") for (int n = 0; n < 2; ++n) _Pragma("unroll") for (int k = 0; k < 2; ++k) \
        acc[ai][bj][m][n] = __builtin_amdgcn_mfma_f32_16x16x32_bf16(Bt[n][k], At[m][k], acc[ai][bj][m][n], 0, 0, 0); __builtin_amdgcn_s_setprio(0); } while (0)
#define PG8_WAIT_V(n) asm volatile("s_waitcnt vmcnt(" #n ")" ::: "memory")
#define PG8_WAIT_L(n) asm volatile("s_waitcnt lgkmcnt(" #n ")" ::: "memory")
#define PG8_BAR __builtin_amdgcn_s_barrier()
#define PG8_SCHED __builtin_amdgcn_sched_barrier(0)
    Unit cur, nxt; int ui = 0;
    if (!S.next(0, cur)) return;
    f32x4 acc[2][2][4][2];
#pragma unroll
    for (int a = 0; a < 2; ++a)
#pragma unroll
        for (int b = 0; b < 2; ++b)
#pragma unroll
            for (int m = 0; m < 4; ++m)
#pragma unroll
                for (int n = 0; n < 2; ++n) acc[a][b][m][n] = (f32x4){0.f, 0.f, 0.f, 0.f};
    bf16x8 At[4][2], B0[2][2], B1[2][2];
    const char* cA = (const char*)g.A + (size_t)cur.pm * tstep; const char* cB = (const char*)g.Bt + (size_t)cur.pn * tstep;
    S.a_ready(cur);
    if constexpr (SP2) {
        PG8_STAGE(PG8_SB(0, 0), cB, voffB); PG8_STAGE(PG8_SB(0, 1), cB + hstep, voffB); PG8_STAGE(PG8_SA(0, 0), cA, voffA); PG8_STAGE(PG8_SA(0, 1), cA + hstep, voffA);
        if (wr == 1) PG8_BAR;
        PG8_WAIT_V(2); PG8_BAR;
        PG8_STAGE(PG8_SB(1, 0), cB + kstep, voffB); PG8_STAGE(PG8_SA(1, 0), cA + kstep, voffA); PG8_STAGE(PG8_SB(1, 1), cB + hstep + kstep, voffB);
        PG8_WAIT_V(6); PG8_BAR;
    } else {
        PG8_STAGE(PG8_SB(0, 0), cB, voffB); PG8_STAGE(PG8_SA(0, 0), cA, voffA); PG8_STAGE(PG8_SB(0, 1), cB + hstep, voffB); PG8_STAGE(PG8_SA(0, 1), cA + hstep, voffA);
        if (wr == 1) PG8_BAR;
        PG8_WAIT_V(4); PG8_BAR;
        PG8_STAGE(PG8_SB(1, 0), cB + kstep, voffB); PG8_STAGE(PG8_SA(1, 0), cA + kstep, voffA); PG8_STAGE(PG8_SB(1, 1), cB + hstep + kstep, voffB);
        PG8_WAIT_V(6); PG8_BAR;
    }
    for (;;) {
        const bool has_next = S.next(ui + 1, nxt);
        const char* nA = has_next ? (const char*)g.A + (size_t)nxt.pm * tstep : cA; const char* nB = has_next ? (const char*)g.Bt + (size_t)nxt.pn * tstep : cB;
        for (int t = 0; t < nt; t += 2) {
            const bool last = (t == nt - 2);
            const char* a1 = cA + (size_t)(t + 1) * kstep;
            const char* a2 = last ? nA : cA + (size_t)(t + 2) * kstep; const char* b2 = last ? nB : cB + (size_t)(t + 2) * kstep;
            const char* a3 = a2 + kstep; const char* b3 = b2 + kstep;
            if (last && has_next) S.a_ready(nxt);
            if constexpr (SP2) {
            PG8_LDB(B0, 0, 0); PG8_LDB(B1, 0, 1); PG8_SCHED; PG8_LDA(At, 0, 0); PG8_STAGE(PG8_SA(1, 1), a1 + hstep, voffA);
            PG8_WAIT_V(8); PG8_WAIT_L(0); PG8_BAR; PG8_MMA(0, 0, At, B0); PG8_MMA(0, 1, At, B1); PG8_BAR; PG8_SCHED;
            PG8_LDA(At, 0, 1); PG8_STAGE(PG8_SB(0, 0), b2, voffB); PG8_STAGE(PG8_SB(0, 1), b2 + hstep, voffB); PG8_STAGE(PG8_SA(0, 0), a2, voffA);
            PG8_WAIT_V(8); PG8_WAIT_L(0); PG8_BAR; PG8_MMA(1, 0, At, B0); PG8_MMA(1, 1, At, B1); PG8_BAR; PG8_SCHED;
            PG8_LDB(B0, 1, 0); PG8_LDB(B1, 1, 1); PG8_SCHED; PG8_LDA(At, 1, 0); PG8_STAGE(PG8_SA(0, 1), a2 + hstep, voffA);
            PG8_WAIT_V(8); PG8_WAIT_L(0); PG8_BAR; PG8_MMA(0, 0, At, B0); PG8_MMA(0, 1, At, B1); PG8_BAR; PG8_SCHED;
            PG8_LDA(At, 1, 1); PG8_STAGE(PG8_SB(1, 0), b3, voffB); PG8_STAGE(PG8_SB(1, 1), b3 + hstep, voffB); PG8_STAGE(PG8_SA(1, 0), a3, voffA);
            PG8_WAIT_V(8); PG8_WAIT_L(0); PG8_BAR; PG8_MMA(1, 0, At, B0); PG8_MMA(1, 1, At, B1); PG8_BAR; PG8_SCHED;
            } else {
            PG8_LDB(B0, 0, 0); PG8_SCHED; PG8_LDA(At, 0, 0); PG8_STAGE(PG8_SA(1, 1), a1 + hstep, voffA);
            PG8_WAIT_L(8); PG8_BAR; PG8_WAIT_L(0); PG8_MMA(0, 0, At, B0); PG8_BAR; PG8_SCHED;
            PG8_LDB(B1, 0, 1); PG8_STAGE(PG8_SB(0, 0), b2, voffB);
            PG8_BAR; PG8_WAIT_L(0); PG8_MMA(0, 1, At, B1); PG8_BAR;
            PG8_LDA(At, 0, 1); PG8_STAGE(PG8_SA(0, 0), a2, voffA);
            PG8_BAR; PG8_WAIT_L(0); PG8_MMA(1, 0, At, B0); PG8_BAR; PG8_SCHED;
            PG8_STAGE(PG8_SB(0, 1), b2 + hstep, voffB);
            PG8_WAIT_V(6); PG8_BAR; PG8_MMA(1, 1, At, B1); PG8_BAR;
            PG8_LDB(B0, 1, 0); PG8_SCHED; PG8_LDA(At, 1, 0); PG8_STAGE(PG8_SA(0, 1), a2 + hstep, voffA);
            PG8_WAIT_L(8); PG8_BAR; PG8_WAIT_L(0); PG8_MMA(0, 0, At, B0); PG8_BAR; PG8_SCHED;
            PG8_LDB(B1, 1, 1); PG8_STAGE(PG8_SB(1, 0), b3, voffB);
            PG8_BAR; PG8_WAIT_L(0); PG8_MMA(0, 1, At, B1); PG8_BAR;
            PG8_LDA(At, 1, 1); PG8_STAGE(PG8_SA(1, 0), a3, voffA);
            PG8_BAR; PG8_WAIT_L(0); PG8_MMA(1, 0, At, B0); PG8_BAR; PG8_SCHED;
            PG8_STAGE(PG8_SB(1, 1), b3 + hstep, voffB);
            PG8_WAIT_V(6); PG8_BAR; PG8_MMA(1, 1, At, B1); PG8_BAR;
            }
        }
        if constexpr (ALIGN_EPI) { if (wr == 0) PG8_BAR; }
        if constexpr (!Epi::AFTER_DRAIN) { E(acc, cur, wr, wc, fr, fq); S.done(cur); }
        if (!has_next) break;
#pragma unroll
        for (int a = 0; a < 2; ++a)
#pragma unroll
            for (int b = 0; b < 2; ++b)
#pragma unroll
                for (int m = 0; m < 4; ++m)
#pragma unroll
                    for (int n = 0; n < 2; ++n) acc[a][b][m][n] = (f32x4){0.f, 0.f, 0.f, 0.f};
        cur = nxt; cA = nA; cB = nB; ++ui;
        if constexpr (ALIGN_EPI) { if (wr == 1) PG8_BAR; }
    }
    PG8_WAIT_V(0);
    if constexpr (!ALIGN_EPI) { if (wr == 0) PG8_BAR; }
    PG8_BAR;
    if constexpr (Epi::AFTER_DRAIN) { E.fused(acc, cur, wr, wc, fr, fq, lds, wid, lane); S.done(cur); }
#undef PG8_SA
#undef PG8_SB
#undef PG8_STAGE
#undef PG8_LDA
#undef PG8_LDB
#undef PG8_MMA
#undef PG8_WAIT_V
#undef PG8_WAIT_L
#undef PG8_BAR
#undef PG8_SCHED
}
}
#define GAS __attribute__((address_space(1)))
#define LAS __attribute__((address_space(3)))
typedef unsigned short bf16;
typedef unsigned v4u __attribute__((ext_vector_type(4)));
typedef float f32x4 __attribute__((ext_vector_type(4)));
typedef short bf16x8 __attribute__((ext_vector_type(8)));
typedef GAS unsigned gu32;
typedef GAS unsigned long long gu64;
#define RLX_AGENT __ATOMIC_RELAXED, __HIP_MEMORY_SCOPE_AGENT
#define LDS_WAIT() asm volatile("s_waitcnt lgkmcnt(0)" ::: "memory")
#define VM_WAIT() asm volatile("s_waitcnt vmcnt(0)" ::: "memory")
__device__ __forceinline__ unsigned long long rt() { return __builtin_amdgcn_s_memrealtime(); }
__device__ __forceinline__ unsigned f2bf(float f) { unsigned u = __builtin_bit_cast(unsigned, f); return (u + 0x7fffu + ((u >> 16) & 1u)) >> 16; }
__device__ __forceinline__ unsigned pk2(float lo, float hi) { return f2bf(lo) | (f2bf(hi) << 16); }

#define XB_TMO      128
#define XB_XCNT(j)  (256  + 64 * (j))
#define XB_XSUB(j)  (1280 + 64 * (j))
#define XB_XGEN(j)  (2304 + 64 * (j))
#define XB_TOP      3328
#define XB_TOPGEN   3392
#define XCD_BAR_WORDS 3456
#define XB_SPIN_CAP (1u << 18)

__device__ __forceinline__ unsigned xb_ld(unsigned* p)              { return __hip_atomic_load(p, __ATOMIC_RELAXED, __HIP_MEMORY_SCOPE_AGENT); }
__device__ __forceinline__ unsigned xb_add(unsigned* p, unsigned v) { return __hip_atomic_fetch_add(p, v, __ATOMIC_RELAXED, __HIP_MEMORY_SCOPE_AGENT); }
__device__ __forceinline__ unsigned xb_xcc_id() { return (unsigned)__builtin_amdgcn_s_getreg((3 << 11) | 20) & 0xFu; }
#define XB_SPIN(cond, bar) do { unsigned _sp = 0; while (cond) { __builtin_amdgcn_s_sleep(1); \
    if ((++_sp & 255u) == 0u) { if (xb_ld(&(bar)[XB_TMO])) break; if (_sp > XB_SPIN_CAP) { atomicAdd(&(bar)[XB_TMO], 1u); break; } } } } while (0)

struct XcdBarrier {
    unsigned* bar; unsigned x;
    volatile LAS unsigned* st;
};

__device__ __forceinline__ XcdBarrier xcd_barrier_post(unsigned* bar, volatile LAS unsigned* st) {
    XcdBarrier b; b.bar = bar; b.x = xb_xcc_id(); b.st = st;
    if (threadIdx.x == 0) (void)xb_add(&bar[XB_XCNT(b.x)], 1u);
    return b;
}
__device__ __forceinline__ void xcd_barrier_complete(unsigned* bar, unsigned x, unsigned& nloc, unsigned& nx) {
    const unsigned G = gridDim.x * gridDim.y * gridDim.z;
    unsigned sum, cnt, mine, sp = 0u;
    for (;;) {
        sum = 0u; cnt = 0u; mine = 0u;
#pragma unroll
        for (unsigned j = 0; j < 16; ++j) { const unsigned c = xb_ld(&bar[XB_XCNT(j)]); sum += c; cnt += (c > 0u) ? 1u : 0u; mine = (j == x) ? c : mine; }
        if (sum == G) break;
        __builtin_amdgcn_s_sleep(1);
        if ((++sp & 255u) == 0u) { if (xb_ld(&bar[XB_TMO])) break; if (sp > XB_SPIN_CAP) { atomicAdd(&bar[XB_TMO], 1u); break; } }
    }
    nloc = mine > 0u ? mine : 1u; nx = cnt > 0u ? cnt : 1u;
}

__device__ __forceinline__ void xcd_barrier(const XcdBarrier& b) {
    asm volatile("s_waitcnt vmcnt(0)" ::: "memory");
    __syncthreads();
    if (threadIdx.x == 0) {
        unsigned* bar = b.bar;
        __builtin_amdgcn_s_waitcnt(0);
        unsigned nloc = b.st[0], nx = b.st[1];
        if (nloc == 0u) { xcd_barrier_complete(bar, b.x, nloc, nx); b.st[0] = nloc; b.st[1] = nx; }
        const unsigned old = xb_add(&bar[XB_XSUB(b.x)], 1u);
        const unsigned gen = old / nloc;
        if (old + 1u == (gen + 1u) * nloc) {
            __builtin_amdgcn_fence(__ATOMIC_RELEASE, "agent");
            asm volatile("s_waitcnt vmcnt(0)" ::: "memory");
            const unsigned og = xb_add(&bar[XB_TOP], 1u);
            const unsigned tg = og / nx;
            if (og + 1u == (tg + 1u) * nx) xb_add(&bar[XB_TOPGEN], 1u);
            else XB_SPIN(xb_ld(&bar[XB_TOPGEN]) == tg, bar);
            __builtin_amdgcn_fence(__ATOMIC_ACQUIRE, "agent");
            xb_add(&bar[XB_XGEN(b.x)], 1u);
            asm volatile("s_waitcnt vmcnt(0)" ::: "memory");
        } else {
            XB_SPIN(xb_ld(&bar[XB_XGEN(b.x)]) == gen, bar);
            __builtin_amdgcn_fence(__ATOMIC_ACQUIRE, "agent");
            asm volatile("s_waitcnt vmcnt(0)" ::: "memory");
        }
    }
    __syncthreads();
}

typedef float f32x16 __attribute__((ext_vector_type(16)));
typedef unsigned v2u __attribute__((ext_vector_type(2)));
#define BAR() __syncthreads()
#define MFMA32(a, b, c) __builtin_amdgcn_mfma_f32_32x32x16_bf16(a, b, c, 0, 0, 0)
#define MFMA16(a, b, c) __builtin_amdgcn_mfma_f32_16x16x32_bf16(a, b, c, 0, 0, 0)
#define SHFLX(v, m) __shfl_xor(v, m)
#define RFL(x) __builtin_amdgcn_readfirstlane(x)
#define FORCEINLINE __device__ __forceinline__
#define FEXP(x) __expf(x)
#define FLOG(x) __logf(x)
__device__ __forceinline__ unsigned CVTPK(float lo, float hi) { unsigned r; asm volatile("v_cvt_pk_bf16_f32 %0, %1, %2" : "=v"(r) : "v"(lo), "v"(hi)); return r; }
__device__ __forceinline__ float bf2f(unsigned short b) { return __uint_as_float(((unsigned)b) << 16); }
__device__ __forceinline__ float wave_sum(float v) {
#pragma unroll
    for (int o = 1; o < 64; o <<= 1) v += __shfl_xor(v, o);
    return v;
}
__device__ __forceinline__ float silu_f(float x) { return x / (1.f + __expf(-x)); }

constexpr int GL_QB = 0;
constexpr int GL_KB = GL_QB + 64 * 272;
constexpr int GL_KDT = GL_KB + 64 * 272;
constexpr int GL_VT = GL_KDT + 128 * 144;
constexpr int GL_SC = GL_VT + 256 * 144;
constexpr int GL_DEC = GL_SC + 64 * 144;
constexpr int GL_TOT = GL_DEC + 512;
constexpr int GL_END = GL_TOT + 2048;
static_assert(GL_END <= 131072, "GLA LDS map");

FORCEINLINE void phase_gla_chunk(const Args& A, LAS unsigned char* lds, int tid, int blk) {
    LAS bf16* QB = (LAS bf16*)(lds + GL_QB); LAS bf16* KB = (LAS bf16*)(lds + GL_KB); LAS bf16* KDT = (LAS bf16*)(lds + GL_KDT); LAS bf16* VT = (LAS bf16*)(lds + GL_VT);
    LAS bf16* SC = (LAS bf16*)(lds + GL_SC); LAS float* DEC = (LAS float*)(lds + GL_DEC); LAS float* TOT = (LAS float*)(lds + GL_TOT);
    const bf16* Q0 = (const bf16*)(A.ws + WS_Q0); const bf16* K0 = (const bf16*)(A.ws + WS_K0); const bf16* V0 = (const bf16*)(A.ws + WS_V0); const float* HA = (const float*)(A.ws + WS_HA);
    const int lane = tid & 63, wave = RFL(tid >> 6), l31 = lane & 31, hh = lane >> 5;
    const int j = tid & 127, qtr = RFL(tid >> 7);
    for (int slot = 0; slot < 2; ++slot) {
        int item; bool sample;
        if (blk < 64) { if (slot) break; sample = true; item = blk; }
        else { const int q = blk - 64; if (slot == 0) item = q; else { if (q >= 64) break; item = 192 + q; } sample = false; }
        const int b = item >> 3, h = (item >> 1) & 3, d = item & 1, T = sample ? 1024 : 256, row0 = sample ? MP + b * 1024 : b * 256;
        bf16* OUT = (bf16*)(A.ws + (d ? WS_OB : WS_OF));
        const int ecol = 32 * wave + l31;
        f32x16 S[4];
        if (sample) { const float* sp = A.in[I_SG] + ((((size_t)b * 2 + d) * 4 + h) * 128) * 256 + ecol;
#pragma unroll
            for (int t = 0; t < 4; ++t)
#pragma unroll
                for (int r = 0; r < 16; ++r) S[t][r] = sp[(size_t)(32 * t + (r & 3) + 8 * (r >> 2) + 4 * hh) * 256]; }
        else {
#pragma unroll
            for (int t = 0; t < 4; ++t)
#pragma unroll
                for (int r = 0; r < 16; ++r) S[t][r] = 0.f; }
        float wa2[16];
#pragma unroll
        for (int m = 0; m < 16; ++m) wa2[m] = A.in[I_GWA2][((size_t)d * 16 + m) * 512 + h * 128 + j];
        const float ba = A.in[I_GBA][d * 512 + h * 128 + j];
        for (int ch = 0; ch < T / 64; ++ch) {
            float bl[16]; float run = 0.f;
#pragma unroll
            for (int ii = 0; ii < 16; ++ii) { const int s = 64 * ch + 16 * qtr + ii, t = d ? T - 1 - s : s; const float* ha = HA + ((size_t)row0 + t) * 32 + d * 16; float z = ba;
#pragma unroll
                for (int m = 0; m < 16; ++m) z += ha[m] * wa2[m];
                const float ls = fminf(z, 0.f) - log1pf(expf(-fabsf(z)));
                run += ls * (1.f / 16.f); bl[ii] = run; }
            TOT[qtr * 128 + j] = run;
            BAR();
            float off = 0.f, tot = 0.f;
#pragma unroll
            for (int q = 0; q < 4; ++q) { const float tv = TOT[q * 128 + j]; off += q < qtr ? tv : 0.f; tot += tv; }
            if (qtr == 0) DEC[j] = expf(tot);
            unsigned kdp[8];
#pragma unroll
            for (int ii = 0; ii < 16; ii += 2) { float kdv[2];
#pragma unroll
                for (int u = 0; u < 2; ++u) { const int i = 16 * qtr + ii + u, s = 64 * ch + i, t = d ? T - 1 - s : s; const size_t row = (size_t)row0 + t; const float bb = bl[ii + u] + off;
                    const float qv = bf2f(Q0[row * 512 + h * 128 + j]), kv = bf2f(K0[row * 512 + h * 128 + j]);
                    QB[i * 136 + j] = (bf16)f2bf(qv * expf(bb) * 0.08838834764831845f); KB[i * 136 + j] = (bf16)f2bf(kv * expf(-bb)); kdv[u] = kv * expf(tot - bb); }
                kdp[ii >> 1] = CVTPK(kdv[0], kdv[1]); }
            *(LAS v4u*)(KDT + j * 72 + 16 * qtr) = (v4u){kdp[0], kdp[1], kdp[2], kdp[3]};
            *(LAS v4u*)(KDT + j * 72 + 16 * qtr + 8) = (v4u){kdp[4], kdp[5], kdp[6], kdp[7]};
            { const int sv = tid & 63, cg = tid >> 6, s = 64 * ch + sv, t = d ? T - 1 - s : s; const bf16* vrow = V0 + ((size_t)row0 + t) * 1024 + h * 256;
#pragma unroll
                for (int i4 = 0; i4 < 4; ++i4) { const int e0 = (cg * 4 + i4) * 8; const v4u w = *(const v4u*)(vrow + e0);
#pragma unroll
                    for (int u = 0; u < 4; ++u) { VT[(e0 + 2 * u) * 72 + sv] = (bf16)(w[u] & 0xffffu); VT[(e0 + 2 * u + 1) * 72 + sv] = (bf16)(w[u] >> 16); } } }
            BAR();
            if (wave < 3) { const int ct = wave == 0 ? 0 : 1, st = wave == 2 ? 1 : 0;
                f32x16 sc;
#pragma unroll
                for (int r = 0; r < 16; ++r) sc[r] = 0.f;
#pragma unroll
                for (int ks = 0; ks < 8; ++ks) { const bf16x8 a = *(const LAS bf16x8*)(QB + (32 * ct + l31) * 136 + 16 * ks + 8 * hh), bf = *(const LAS bf16x8*)(KB + (32 * st + l31) * 136 + 16 * ks + 8 * hh); sc = MFMA32(a, bf, sc); }
#pragma unroll
                for (int r = 0; r < 16; ++r) { const int c = 32 * ct + (r & 3) + 8 * (r >> 2) + 4 * hh, s_ = 32 * st + l31; SC[c * 72 + s_] = (bf16)f2bf(c >= s_ ? sc[r] : 0.f); } }
            f32x16 O[2];
#pragma unroll
            for (int ct = 0; ct < 2; ++ct)
#pragma unroll
                for (int r = 0; r < 16; ++r) O[ct][r] = 0.f;
#pragma unroll
            for (int t = 0; t < 4; ++t)
#pragma unroll
                for (int ks = 0; ks < 2; ++ks) {
                    v4u pk; pk[0] = CVTPK(S[t][8 * ks + 0], S[t][8 * ks + 1]); pk[1] = CVTPK(S[t][8 * ks + 2], S[t][8 * ks + 3]); pk[2] = CVTPK(S[t][8 * ks + 4], S[t][8 * ks + 5]); pk[3] = CVTPK(S[t][8 * ks + 6], S[t][8 * ks + 7]);
                    const bf16x8 bfrag = __builtin_bit_cast(bf16x8, pk);
#pragma unroll
                    for (int ct = 0; ct < 2; ++ct) { const LAS bf16* ap = QB + (32 * ct + l31) * 136 + 32 * t + 16 * ks + 4 * hh;
                        const v2u lo = *(const LAS v2u*)ap, hi = *(const LAS v2u*)(ap + 8); const v4u av = (v4u){lo[0], lo[1], hi[0], hi[1]};
                        O[ct] = MFMA32(__builtin_bit_cast(bf16x8, av), bfrag, O[ct]); } }
            bf16x8 vb[4];
#pragma unroll
            for (int ks = 0; ks < 4; ++ks) vb[ks] = *(const LAS bf16x8*)(VT + ecol * 72 + 16 * ks + 8 * hh);
#pragma unroll
            for (int t = 0; t < 4; ++t) {
#pragma unroll
                for (int g = 0; g < 4; ++g) { const f32x4 dc = *(const LAS f32x4*)(DEC + 32 * t + 8 * g + 4 * hh);
#pragma unroll
                    for (int c = 0; c < 4; ++c) S[t][4 * g + c] *= dc[c]; }
#pragma unroll
                for (int ks = 0; ks < 4; ++ks) { const bf16x8 a = *(const LAS bf16x8*)(KDT + (32 * t + l31) * 72 + 16 * ks + 8 * hh); S[t] = MFMA32(a, vb[ks], S[t]); } }
            BAR();
#pragma unroll
            for (int ct = 0; ct < 2; ++ct)
#pragma unroll
                for (int ks = 0; ks < 4; ++ks) if (ks < (ct ? 4 : 2)) { const bf16x8 a = *(const LAS bf16x8*)(SC + (32 * ct + l31) * 72 + 16 * ks + 8 * hh); O[ct] = MFMA32(a, vb[ks], O[ct]); }
#pragma unroll
            for (int ct = 0; ct < 2; ++ct)
#pragma unroll
                for (int r = 0; r < 16; ++r) { const int c = 32 * ct + (r & 3) + 8 * (r >> 2) + 4 * hh, s = 64 * ch + c, t = d ? T - 1 - s : s;
                    OUT[((size_t)row0 + t) * 1024 + h * 256 + ecol] = (bf16)f2bf(O[ct][r]); }
        }
        if (!sample) { float* dst = A.out + OUT_SG + ((((size_t)b * 2 + d) * 4 + h) * 128) * 256 + ecol;
#pragma unroll
            for (int t = 0; t < 4; ++t)
#pragma unroll
                for (int r = 0; r < 16; ++r) dst[(size_t)(32 * t + (r & 3) + 8 * (r >> 2) + 4 * hh) * 256] = S[t][r]; }
        BAR();
    }
}
constexpr int RW_SET = 17664;
constexpr int RW_XS = 0;
constexpr int RW_YS = 4608;
constexpr int RW_YT = 9216;
constexpr int RW_VT = 14336;
constexpr int RW_GC = 17408;
constexpr int RW_LAB = 2 * RW_SET;
constexpr int RW_BONL = RW_LAB + 4096;
constexpr int RW_END = RW_BONL + 512;
static_assert(RW_END <= 131072, "RWKV LDS map");

FORCEINLINE float fast_exp(float x) { return FEXP(x); }

FORCEINLINE void phase_rwkv_chunk(const Args& A, LAS unsigned char* lds, int tid, int blk) {
    const int lane = tid & 63, wave = RFL(tid >> 6), l31 = lane & 31, hh = lane >> 5, j16 = lane & 15, q = lane >> 4;
    const bf16* R1 = (const bf16*)(A.ws + WS_R1); const bf16* K1 = (const bf16*)(A.ws + WS_K1); const bf16* V1 = (const bf16*)(A.ws + WS_V1); const float* LWA = (const float*)(A.ws + WS_LWA);
    float* BON = (float*)(A.ws + WS_BONUS);
    const int p_sel = wave >> 2, p_nt = wave & 3;
    const int c_sel = wave >> 1, c_it = wave & 1;
    LAS unsigned char* pset = lds + p_sel * RW_SET;
    LAS bf16* pXS = (LAS bf16*)(pset + RW_XS); LAS bf16* pYS = (LAS bf16*)(pset + RW_YS); LAS bf16* pYT = (LAS bf16*)(pset + RW_YT); LAS bf16* pVT = (LAS bf16*)(pset + RW_VT); LAS float* pGC = (LAS float*)(pset + RW_GC);
    LAS float* BONL = (LAS float*)(lds + RW_BONL);
    LAS unsigned char* cset = lds + (c_sel & 1) * RW_SET;
    const LAS bf16* cXS = (const LAS bf16*)(cset + RW_XS); const LAS bf16* cYS = (const LAS bf16*)(cset + RW_YS); const LAS bf16* cYT = (const LAS bf16*)(cset + RW_YT); const LAS bf16* cVT = (const LAS bf16*)(cset + RW_VT); const LAS float* cGC = (const LAS float*)(cset + RW_GC);
    LAS float* LAB = (LAS float*)(lds + RW_LAB) + (wave & 3) * 256;
    const int sb = blk >> 5, sh = (blk >> 1) & 15, sd = blk & 1;
    f32x16 Z[2];
    bf16x8 Bw[2], Ba[2];
    float w0v = 0.f, a0v = 0.f, kav = 0.f, rkv = 0.f; float kkw[4];
#pragma unroll
    for (int r = 0; r < 16; ++r) { Z[0][r] = 0.f; Z[1][r] = 0.f; }
    for (int rd = 0; rd < 64; ++rd) {
        const int pidx = blk * 4 + (rd >> 4), pb = pidx >> 5, ph = (pidx >> 1) & 15, pd = pidx & 1;
        {
            const bool smp = p_sel == 0;
            const int b = smp ? sb : pb, h = smp ? sh : ph, d = smp ? sd : pd, T = smp ? 1024 : 256, row0 = smp ? MP + b * 1024 : b * 256, ch = smp ? rd : (rd & 15);
            const int jc = 16 * p_nt + j16, hj = h * 64 + jc;
            if (smp ? rd == 0 : (rd & 15) == 0) {
#pragma unroll
                for (int ks = 0; ks < 2; ++ks) { v4u pw_, pa_;
#pragma unroll
                    for (int u = 0; u < 4; ++u) { const int m = 32 * ks + 8 * q + 2 * u;
                        pw_[u] = CVTPK(A.in[I_W2][((size_t)d * 64 + m) * 1024 + hj], A.in[I_W2][((size_t)d * 64 + m + 1) * 1024 + hj]);
                        pa_[u] = CVTPK(A.in[I_A2][((size_t)d * 64 + m) * 1024 + hj], A.in[I_A2][((size_t)d * 64 + m + 1) * 1024 + hj]); }
                    Bw[ks] = __builtin_bit_cast(bf16x8, pw_); Ba[ks] = __builtin_bit_cast(bf16x8, pa_); }
                w0v = A.in[I_W0][d * 1024 + hj]; a0v = A.in[I_A0][d * 1024 + hj]; kav = A.in[I_KA][d * 1024 + hj]; rkv = A.in[I_RK][(d * 16 + h) * 64 + jc];
#pragma unroll
                for (int n2 = 0; n2 < 4; ++n2) kkw[n2] = A.in[I_KK][d * 1024 + h * 64 + 16 * n2 + j16];
            }
            f32x4 Dw = (f32x4){0.f, 0.f, 0.f, 0.f}, Da = (f32x4){0.f, 0.f, 0.f, 0.f};
            { const int s = 16 * ch + j16, t = d ? T - 1 - s : s; const float* lrow = LWA + ((size_t)row0 + t) * 256 + d * 64;
#pragma unroll
                for (int ks = 0; ks < 2; ++ks) { const f32x4 x0 = *(const f32x4*)(lrow + 32 * ks + 8 * q), x1 = *(const f32x4*)(lrow + 32 * ks + 8 * q + 4), y0 = *(const f32x4*)(lrow + 128 + 32 * ks + 8 * q), y1 = *(const f32x4*)(lrow + 128 + 32 * ks + 8 * q + 4);
                    const v4u aw = (v4u){CVTPK(tanhf(x0[0]), tanhf(x0[1])), CVTPK(tanhf(x0[2]), tanhf(x0[3])), CVTPK(tanhf(x1[0]), tanhf(x1[1])), CVTPK(tanhf(x1[2]), tanhf(x1[3]))};
                    const v4u aa = (v4u){CVTPK(y0[0], y0[1]), CVTPK(y0[2], y0[3]), CVTPK(y1[0], y1[1]), CVTPK(y1[2], y1[3])};
                    Dw = MFMA16(__builtin_bit_cast(bf16x8, aw), Bw[ks], Dw); Da = MFMA16(__builtin_bit_cast(bf16x8, aa), Ba[ks], Da); } }
            float lwd[4], asg[4], kkv[4], kdv[4], rvv[4], bonp[4];
#pragma unroll
            for (int rr = 0; rr < 4; ++rr) { const int s = 16 * ch + 4 * q + rr, t = d ? T - 1 - s : s; const size_t row = (size_t)row0 + t;
                const float wpre = w0v + Dw[rr], apre = a0v + Da[rr];
                const float sp = fmaxf(-wpre, 0.f) + FLOG(1.f + fast_exp(-fabsf(wpre)));
                lwd[rr] = -fast_exp(-sp - 0.5f);
                asg[rr] = 1.f / (1.f + fast_exp(-apre));
                float n2s = 0.f, kraw = 0.f, kself = 0.f;
#pragma unroll
                for (int n2 = 0; n2 < 4; ++n2) { const float kx = bf2f(K1[row * 1024 + h * 64 + 16 * n2 + j16]); const float kq = kx * kkw[n2]; n2s += kq * kq; if (n2 == p_nt) { kraw = kx; kself = kkw[n2]; } }
                n2s += SHFLX(n2s, 1); n2s += SHFLX(n2s, 2); n2s += SHFLX(n2s, 4); n2s += SHFLX(n2s, 8);
                const float inv = 1.f / fmaxf(sqrtf(n2s), 1e-12f);
                kkv[rr] = kraw * kself * inv;
                kdv[rr] = kraw * (1.f + (asg[rr] - 1.f) * kav);
                rvv[rr] = bf2f(R1[row * 1024 + hj]);
                float bp = rvv[rr] * kdv[rr] * rkv;
                bp += SHFLX(bp, 1); bp += SHFLX(bp, 2); bp += SHFLX(bp, 4); bp += SHFLX(bp, 8);
                bonp[rr] = bp; }
            if (j16 == 0) {
#pragma unroll
                for (int rr = 0; rr < 4; ++rr) BONL[(p_sel * 4 + p_nt) * 16 + 4 * q + rr] = bonp[rr]; }
            const float tot = (lwd[0] + lwd[1]) + (lwd[2] + lwd[3]);
            const float bq = SHFLX(tot, 16), pr = tot + bq, cq = SHFLX(pr, 32);
            float cum = ((q & 1) ? bq : 0.f) + ((q & 2) ? cq : 0.f);
            unsigned ybt[2], ykt[2]; float yb_[4], yk_[4];
#pragma unroll
            for (int rr = 0; rr < 4; ++rr) { const float cprev = cum; cum += lwd[rr];
                const float g = fast_exp(cum), gi = fast_exp(-cum), gp = fast_exp(cprev);
                const float at = -kkv[rr] * gp, bt = kkv[rr] * asg[rr] * gi, kt = kdv[rr] * gi, rt = rvv[rr] * g;
                const int rho = rr + 8 * q;
                pXS[rho * 72 + jc] = (bf16)f2bf(at); pXS[(rho + 4) * 72 + jc] = (bf16)f2bf(rt);
                pYS[rho * 72 + jc] = (bf16)f2bf(bt); pYS[(rho + 4) * 72 + jc] = (bf16)f2bf(kt);
                yb_[rr] = bt; yk_[rr] = kt; }
            ybt[0] = CVTPK(yb_[0], yb_[1]); ybt[1] = CVTPK(yb_[2], yb_[3]); ykt[0] = CVTPK(yk_[0], yk_[1]); ykt[1] = CVTPK(yk_[2], yk_[3]);
            *(LAS v2u*)(pYT + jc * 40 + 4 * q) = (v2u){ybt[0], ybt[1]};
            *(LAS v2u*)(pYT + jc * 40 + 16 + 4 * q) = (v2u){ykt[0], ykt[1]};
            if (q == 0) pGC[jc] = fast_exp(pr + cq);
            { unsigned short vv[4];
#pragma unroll
                for (int rr = 0; rr < 4; ++rr) { const int s = 16 * ch + 4 * q + rr, t = d ? T - 1 - s : s; vv[rr] = V1[((size_t)row0 + t) * 1024 + h * 64 + 16 * p_nt + j16]; }
                *(LAS v2u*)(pVT + (16 * p_nt + j16) * 24 + 4 * q) = (v2u){(unsigned)vv[0] | ((unsigned)vv[1] << 16), (unsigned)vv[2] | ((unsigned)vv[3] << 16)}; }
        }
        BAR();
        if (wave < 4) {
            const bool smp = c_sel == 0;
            const int b = smp ? sb : pb, h = smp ? sh : ph, d = smp ? sd : pd, T = smp ? 1024 : 256, row0 = smp ? MP + b * 1024 : b * 256, ch = smp ? rd : (rd & 15);
            const int icol = 32 * c_it + l31;
            if (smp ? rd == 0 : (rd & 15) == 0) {
                if (smp) { const float* sp = A.in[I_SR] + ((((size_t)b * 2 + d) * 16 + h) * 64 + icol) * 64;
#pragma unroll
                    for (int jt = 0; jt < 2; ++jt)
#pragma unroll
                        for (int g = 0; g < 4; ++g) { const f32x4 v = *(const f32x4*)(sp + 32 * jt + 8 * g + 4 * hh); Z[jt][4 * g] = v[0]; Z[jt][4 * g + 1] = v[1]; Z[jt][4 * g + 2] = v[2]; Z[jt][4 * g + 3] = v[3]; } }
                else {
#pragma unroll
                    for (int r = 0; r < 16; ++r) { Z[0][r] = 0.f; Z[1][r] = 0.f; } }
            }
            f32x16 Gp;
#pragma unroll
            for (int r = 0; r < 16; ++r) Gp[r] = 0.f;
#pragma unroll
            for (int ks = 0; ks < 4; ++ks) { const bf16x8 a = *(const LAS bf16x8*)(cYS + l31 * 72 + 16 * ks + 8 * hh), bx = *(const LAS bf16x8*)(cXS + l31 * 72 + 16 * ks + 8 * hh); Gp = MFMA32(a, bx, Gp); }
            const int hx = (l31 >> 2) & 1, tx = (l31 & 3) + 4 * (l31 >> 3);
#pragma unroll
            for (int r = 0; r < 16; ++r) Gp[r] = r < tx + hx ? Gp[r] : 0.f;
            if (hh == 0 && hx == 0) {
#pragma unroll
                for (int g = 0; g < 4; ++g) *(LAS f32x4*)(LAB + tx * 16 + 4 * g) = (f32x4){Gp[4 * g], Gp[4 * g + 1], Gp[4 * g + 2], Gp[4 * g + 3]}; }
            bf16x8 Ag[2];
#pragma unroll
            for (int ks = 0; ks < 2; ++ks) { const v4u pk = (v4u){CVTPK(Gp[8 * ks], Gp[8 * ks + 1]), CVTPK(Gp[8 * ks + 2], Gp[8 * ks + 3]), CVTPK(Gp[8 * ks + 4], Gp[8 * ks + 5]), CVTPK(Gp[8 * ks + 6], Gp[8 * ks + 7])}; Ag[ks] = __builtin_bit_cast(bf16x8, pk); }
            f32x16 Dm;
#pragma unroll
            for (int r = 0; r < 16; ++r) Dm[r] = 0.f;
#pragma unroll
            for (int jt = 0; jt < 2; ++jt)
#pragma unroll
                for (int ks = 0; ks < 2; ++ks) { const LAS bf16* ap = cXS + l31 * 72 + 32 * jt + 16 * ks + 4 * hh; const v2u lo = *(const LAS v2u*)ap, hi = *(const LAS v2u*)(ap + 8);
                    const v4u av = (v4u){lo[0], lo[1], hi[0], hi[1]};
                    const v4u zk = (v4u){CVTPK(Z[jt][8 * ks], Z[jt][8 * ks + 1]), CVTPK(Z[jt][8 * ks + 2], Z[jt][8 * ks + 3]), CVTPK(Z[jt][8 * ks + 4], Z[jt][8 * ks + 5]), CVTPK(Z[jt][8 * ks + 6], Z[jt][8 * ks + 7])};
                    Dm = MFMA32(__builtin_bit_cast(bf16x8, av), __builtin_bit_cast(bf16x8, zk), Dm); }
            bf16x8 Vf[2];
#pragma unroll
            for (int ks = 0; ks < 2; ++ks) { const v4u vz = *(const LAS v4u*)(cVT + icol * 24 + 8 * ks); Vf[ks] = __builtin_bit_cast(bf16x8, hh ? vz : (v4u){0u, 0u, 0u, 0u}); }
#pragma unroll
            for (int ks = 0; ks < 2; ++ks) Dm = MFMA32(Ag[ks], Vf[ks], Dm);
            LDS_WAIT();
            float u[16];
#pragma unroll
            for (int t = 0; t < 16; ++t) { float acc_ = Dm[t];
#pragma unroll
                for (int g = 0; g < 4; ++g) if (4 * g < t) { const f32x4 lv = *(const LAS f32x4*)(LAB + t * 16 + 4 * g);
#pragma unroll
                    for (int c = 0; c < 4; ++c) if (4 * g + c < t) acc_ += lv[c] * u[4 * g + c]; }
                u[t] = acc_; }
            bf16x8 Uf[2];
#pragma unroll
            for (int ks = 0; ks < 2; ++ks) { const v4u pk = (v4u){CVTPK(u[8 * ks], u[8 * ks + 1]), CVTPK(u[8 * ks + 2], u[8 * ks + 3]), CVTPK(u[8 * ks + 4], u[8 * ks + 5]), CVTPK(u[8 * ks + 6], u[8 * ks + 7])};
                Uf[ks] = __builtin_bit_cast(bf16x8, hh ? (v4u){0u, 0u, 0u, 0u} : pk); }
#pragma unroll
            for (int ks = 0; ks < 2; ++ks) Dm = MFMA32(Ag[ks], Uf[ks], Dm);
            { bf16* YO = (bf16*)(A.ws + (d ? WS_YB : WS_YF));
                if (hh) {
#pragma unroll
                    for (int r = 0; r < 16; ++r) { const int s = 16 * ch + r, t = d ? T - 1 - s : s; YO[((size_t)row0 + t) * 1024 + h * 64 + icol] = (bf16)f2bf(Dm[r]); } } }
#pragma unroll
            for (int ks = 0; ks < 2; ++ks) { const v4u uu = __builtin_bit_cast(v4u, Uf[ks]), vv = __builtin_bit_cast(v4u, Vf[ks]); Uf[ks] = __builtin_bit_cast(bf16x8, hh ? vv : uu); }
#pragma unroll
            for (int jt = 0; jt < 2; ++jt) {
#pragma unroll
                for (int ks = 0; ks < 2; ++ks) { const bf16x8 a = *(const LAS bf16x8*)(cYT + (32 * jt + l31) * 40 + 16 * hh + 8 * ks); Z[jt] = MFMA32(a, Uf[ks], Z[jt]); }
#pragma unroll
                for (int g = 0; g < 4; ++g) { const f32x4 dc = *(const LAS f32x4*)(cGC + 32 * jt + 8 * g + 4 * hh);
#pragma unroll
                    for (int c = 0; c < 4; ++c) Z[jt][4 * g + c] *= dc[c]; } }
            if (c_it == 0 && lane < 16) { const int s = 16 * ch + lane, t = d ? T - 1 - s : s; const LAS float* bl = BONL + (c_sel * 4) * 16 + lane;
                BON[(((size_t)row0 + t) * 16 + h) * 2 + d] = (bl[0] + bl[16]) + (bl[32] + bl[48]); }
            if (!smp && (rd & 15) == 15) { float* dp = A.out + OUT_SR + ((((size_t)b * 2 + d) * 16 + h) * 64 + icol) * 64;
#pragma unroll
                for (int jt = 0; jt < 2; ++jt)
#pragma unroll
                    for (int g = 0; g < 4; ++g) *(f32x4*)(dp + 32 * jt + 8 * g + 4 * hh) = (f32x4){Z[jt][4 * g], Z[jt][4 * g + 1], Z[jt][4 * g + 2], Z[jt][4 * g + 3]}; }
        }
        BAR();
    }
}
__device__ __forceinline__ void tr_item(const float* W, int N, bf16* WT, int ldo, int row_off, int col_off, const float* mu, int mode, LAS float* scr, int item, int lane) {
    const int nblk = N / 32, kb = item / nblk, nb = item % nblk, k0 = 64 * kb, n0 = 32 * nb;
#pragma unroll 8
    for (int i = 0; i < 32; ++i) { const int kk = 2 * i + (lane >> 5); float s = 1.f; if (mode) { const float m_ = mu[k0 + kk]; s = mode == 1 ? 1.f - m_ : m_; }
        scr[kk * 33 + (lane & 31)] = W[(size_t)(k0 + kk) * N + n0 + (lane & 31)] * s; }
    LDS_WAIT(); asm volatile("" ::: "memory");
    const int c = lane & 7;
#pragma unroll
    for (int j = 0; j < 4; ++j) { const int n = (lane >> 3) + 8 * j; const LAS float* s = scr + (8 * c) * 33 + n;
        v4u o; o.x = pk2(s[0 * 33], s[1 * 33]); o.y = pk2(s[2 * 33], s[3 * 33]); o.z = pk2(s[4 * 33], s[5 * 33]); o.w = pk2(s[6 * 33], s[7 * 33]);
        *(v4u*)(WT + (size_t)(row_off + n0 + n) * ldo + col_off + k0 + 8 * c) = o; }
    LDS_WAIT(); asm volatile("" ::: "memory");
}
__device__ __forceinline__ void phase0(const Args& A, LAS unsigned char* lds, int tid, int lane, int wave) {
    unsigned char* ws = A.ws;
    const int G = gridDim.x, blk = blockIdx.x;
    {
        LAS float* scond = (LAS float*)lds;
        LAS float* red = scond + 9 * 1024;
        bool filled = false;
        for (int item = blk; item < 96; item += G) {
            if (!filled) {
                for (int idx = tid; idx < 9 * 1024; idx += NTHR) { const int r = idx >> 10, k = idx & 1023; const float c = r == 0 ? A.in[I_CCTX][k] : A.in[I_C][(r - 1) * 1024 + k]; scond[idx] = silu_f(c); }
                filled = true;
            }
            __syncthreads();
            const int l = item / 48, g = item % 48, col = g * 64 + lane;
            float acc[9];
#pragma unroll
            for (int r = 0; r < 9; ++r) acc[r] = 0.f;
            const float* wp = A.in[I_WMOD] + ((size_t)l * 1024 + wave * 128) * 3072 + col;
#pragma unroll 4
            for (int k = 0; k < 128; ++k) { const float wv = wp[(size_t)k * 3072];
#pragma unroll
                for (int r = 0; r < 9; ++r) acc[r] += scond[r * 1024 + wave * 128 + k] * wv; }
#pragma unroll
            for (int r = 0; r < 9; ++r) red[(wave * 9 + r) * 64 + lane] = acc[r];
            __syncthreads();
            for (int idx = tid; idx < 576; idx += NTHR) { const int r = idx >> 6, ln = idx & 63; float s = A.in[I_BMOD][l * 3072 + g * 64 + ln];
#pragma unroll
                for (int w = 0; w < 8; ++w) s += red[(w * 9 + r) * 64 + ln];
                ((float*)(ws + WS_MOD))[(l * 9 + r) * 3072 + g * 64 + ln] = s; }
            __syncthreads();
        }
        __syncthreads();
    }
    LAS float* scr = (LAS float*)(lds + wave * 16384);
    const int gw = blk * NWAVES + wave, NGW = G * NWAVES;
    bf16* WIN = (bf16*)(ws + WS_WIN); bf16* WO0 = (bf16*)(ws + WS_WO0); bf16* W4 = (bf16*)(ws + WS_W4); bf16* WO1 = (bf16*)(ws + WS_WO1);
    constexpr int I_IN = 16 * 96, I_SQ = 16 * 32, I_LR = 16 * 2;
    constexpr int NITEMS = I_IN + I_SQ + 8 * I_SQ + 8 * I_LR + I_SQ;
    for (int it = gw; it < NITEMS; it += NGW) {
        int r = it;
        if (r < I_IN) { tr_item(A.in[I_GWIN], 3072, WIN, 1024, 0, 0, nullptr, 0, scr, r, lane); continue; } r -= I_IN;
        if (r < I_SQ) { tr_item(A.in[I_GWOUT], 1024, WO0, 1024, 0, 0, nullptr, 0, scr, r, lane); continue; } r -= I_SQ;
        if (r < 8 * I_SQ) { const int p = r / (2 * I_SQ), hf = (r / I_SQ) & 1; tr_item(A.in[I_WRKVG] + (size_t)p * 1024 * 1024, 1024, W4, 2048, p * 1024, hf * 1024, A.in[I_MU] + p * 1024, 1 + hf, scr, r % I_SQ, lane); continue; } r -= 8 * I_SQ;
        if (r < 8 * I_LR) { const int q = r / I_LR, which = q >> 2, d = (q >> 1) & 1, hf = q & 1;
            tr_item((which ? A.in[I_A1] : A.in[I_W1]) + (size_t)d * 1024 * 64, 64, W4, 2048, 4096 + which * 128 + d * 64, hf * 1024, A.in[I_MU] + (4 + which) * 1024, 1 + hf, scr, r % I_LR, lane); continue; } r -= 8 * I_LR;
        tr_item(A.in[I_RWOUT], 1024, WO1, 1024, 0, 0, nullptr, 0, scr, r, lane);
    }
    const int gt = blk * NTHR + tid, NGT = G * NTHR;
    for (int idx = gt; idx < 2 * 16 * 1024; idx += NGT) { const int k = idx & 1023, j = (idx >> 10) & 15, d = idx >> 14;
        WIN[(size_t)(3072 + d * 16 + j) * 1024 + k] = (bf16)f2bf(A.in[I_GWA1][((size_t)d * 1024 + k) * 16 + j]); }
    for (int idx = gt; idx < 224 * 1024 / 8; idx += NGT) ((v4u*)(WIN + (size_t)3104 * 1024))[idx] = (v4u){0u, 0u, 0u, 0u};
}

__device__ __forceinline__ const float* xrow_in(const Args& A, int r) { return r < MP ? A.in[I_XP] + (size_t)r * D : A.in[I_XS] + (size_t)(r - MP) * D; }
__device__ __forceinline__ int cond_of(int r) { return r < MP ? 0 : 1 + ((r - MP) >> 10); }
__device__ __forceinline__ void store_bf4(bf16* p, f32x4 v) { *(unsigned long long*)p = (unsigned long long)pk2(v[0], v[1]) | ((unsigned long long)pk2(v[2], v[3]) << 32); }
__device__ __forceinline__ f32x4 load_bf4(const bf16* p) { const unsigned long long w = *(const unsigned long long*)p; const unsigned lo = (unsigned)w, hi = (unsigned)(w >> 32);
    return (f32x4){__uint_as_float(lo << 16), __uint_as_float(lo & 0xffff0000u), __uint_as_float(hi << 16), __uint_as_float(hi & 0xffff0000u)}; }

__device__ __forceinline__ void phase_h0(const Args& A, int lane, int gw, int NGW) {
    const float* MOD = (const float*)(A.ws + WS_MOD); bf16* XN = (bf16*)(A.ws + WS_ABUF); const float* nw = A.in[I_NORMW];
    for (int r = gw; r < M; r += NGW) {
        const f32x4* xr = (const f32x4*)xrow_in(A, r) + lane;
        f32x4 v[4]; float s = 0.f;
#pragma unroll
        for (int j = 0; j < 4; ++j) { v[j] = xr[64 * j]; s += (v[j][0] * v[j][0] + v[j][1] * v[j][1]) + (v[j][2] * v[j][2] + v[j][3] * v[j][3]); }
        const float rstd = 1.f / sqrtf(wave_sum(s) * (1.f / D) + EPS);
        const float* md = MOD + cond_of(r) * 3072;
#pragma unroll
        for (int j = 0; j < 4; ++j) { const int c = 256 * j + 4 * lane; const f32x4 w = *(const f32x4*)(nw + c), sh = *(const f32x4*)(md + c), sc = *(const f32x4*)(md + 1024 + c);
            store_bf4(XN + (size_t)r * D + c, (v[j] * rstd) * w * (sc + 1.f) + sh); }
    }
}
__device__ __forceinline__ void phase_og0(const Args& A, int lane, int gw, int NGW) {
    const bf16* OF = (const bf16*)(A.ws + WS_OF); const bf16* OB = (const bf16*)(A.ws + WS_OB); const bf16* G0 = (const bf16*)(A.ws + WS_G0); bf16* OG = (bf16*)(A.ws + WS_ABUF);
    const f32x4 wn = *(const f32x4*)(A.in[I_GNORM] + 4 * lane);
    for (int r = gw; r < M; r += NGW) {
#pragma unroll
        for (int j = 0; j < 4; ++j) { const size_t o = (size_t)r * D + 256 * j + 4 * lane; const f32x4 v = load_bf4(OF + o) + load_bf4(OB + o);
            const float ms = wave_sum((v[0] * v[0] + v[1] * v[1]) + (v[2] * v[2] + v[3] * v[3])) * (1.f / 256.f); const float rs = 1.f / sqrtf(ms + EPS);
            const f32x4 g = load_bf4(G0 + o); f32x4 y = v * rs * wn;
            y[0] *= silu_f(g[0]); y[1] *= silu_f(g[1]); y[2] *= silu_f(g[2]); y[3] *= silu_f(g[3]);
            store_bf4(OG + o, y); }
    }
}
__device__ __forceinline__ float row_rstd(const float* ssq, int r, int lane) { float s = lane < 16 ? ssq[(size_t)r * 16 + lane] : 0.f; return 1.f / sqrtf(wave_sum(s) * (1.f / D) + EPS); }
__device__ __forceinline__ void phase_hh(const Args& A, int lane, int gw, int NGW) {
    const float* MOD = (const float*)(A.ws + WS_MOD) + 9 * 3072; const float* ssq = (const float*)(A.ws + WS_SSQ1); bf16* HH = (bf16*)(A.ws + WS_HH); const float* nw = A.in[I_NORMW] + 1024; const float* X1 = A.out;
    for (int r = gw; r < M; r += NGW) {
        const float* md = MOD + cond_of(r) * 3072;
        int n0, n1, n2, n3; bool v0, v1, v2, v3; float wgt;
        if (r < MP) { const int t = r & 255; wgt = 0.5f; n0 = r - 1; v0 = t > 0; n1 = r + 1; v1 = t < 255; n2 = r; v2 = false; n3 = r; v3 = false; }
        else { const int t = (r - MP) & 1023, gr = t >> 6, gc = t & 63; wgt = 0.25f; n0 = r - 64; v0 = gr > 0; n1 = r + 64; v1 = gr < 15; n2 = r - 1; v2 = gc > 0; n3 = r + 1; v3 = gc < 63; }
        const int cnt = (int)v0 + (int)v1 + (int)v2 + (int)v3;
        const float rs = row_rstd(ssq, r, lane);
        f32x4 acc[4];
#pragma unroll
        for (int j = 0; j < 4; ++j) acc[j] = (f32x4){0.f, 0.f, 0.f, 0.f};
#pragma unroll
        for (int q = 0; q < 4; ++q) { const int n = q == 0 ? n0 : q == 1 ? n1 : q == 2 ? n2 : n3; const bool vld = q == 0 ? v0 : q == 1 ? v1 : q == 2 ? v2 : v3;
            if (vld) { const float rn = row_rstd(ssq, n, lane); const f32x4* xp = (const f32x4*)(X1 + (size_t)n * D) + lane;
#pragma unroll
                for (int j = 0; j < 4; ++j) acc[j] += xp[64 * j] * rn; } }
        const f32x4* xr = (const f32x4*)(X1 + (size_t)r * D) + lane;
#pragma unroll
        for (int j = 0; j < 4; ++j) { const int c = 256 * j + 4 * lane; const f32x4 w = *(const f32x4*)(nw + c), sh = *(const f32x4*)(md + c), sc = *(const f32x4*)(md + 1024 + c); const f32x4 cc = w * (sc + 1.f);
            store_bf4(HH + (size_t)r * 2048 + c, (xr[64 * j] * rs) * cc + sh);
            store_bf4(HH + (size_t)r * 2048 + 1024 + c, (acc[j] * cc + sh * (float)cnt) * wgt); }
    }
}
__device__ __forceinline__ void phase_og1(const Args& A, int lane, int gw, int NGW) {
    const bf16* YF = (const bf16*)(A.ws + WS_YF); const bf16* YB = (const bf16*)(A.ws + WS_YB); const bf16* V1 = (const bf16*)(A.ws + WS_V1); const bf16* G1 = (const bf16*)(A.ws + WS_G1);
    const float* BON = (const float*)(A.ws + WS_BONUS); bf16* OG = (bf16*)(A.ws + WS_OG1);
    for (int r = gw; r < M; r += NGW) {
#pragma unroll
        for (int j = 0; j < 4; ++j) { const int c = 256 * j + 4 * lane, h = c >> 6; const size_t o = (size_t)r * D + c; const f32x4 y = load_bf4(YF + o) + load_bf4(YB + o);
            float s = (y[0] + y[1]) + (y[2] + y[3]);
            s += __shfl_xor(s, 1); s += __shfl_xor(s, 2); s += __shfl_xor(s, 4); s += __shfl_xor(s, 8);
            const float mean = s * (1.f / 64.f); const f32x4 dv = y - mean; float q = (dv[0] * dv[0] + dv[1] * dv[1]) + (dv[2] * dv[2] + dv[3] * dv[3]);
            q += __shfl_xor(q, 1); q += __shfl_xor(q, 2); q += __shfl_xor(q, 4); q += __shfl_xor(q, 8);
            const float rs = 1.f / sqrtf(q * (1.f / 64.f) + LNX_EPS);
            const f32x4 lw = *(const f32x4*)(A.in[I_LNW] + c), lb = *(const f32x4*)(A.in[I_LNB] + c);
            const float bon = BON[((size_t)r * 16 + h) * 2] + BON[((size_t)r * 16 + h) * 2 + 1];
            const f32x4 v = load_bf4(V1 + o), g = load_bf4(G1 + o);
            f32x4 z = dv * rs * lw + lb + v * bon;
            z[0] *= silu_f(g[0]); z[1] *= silu_f(g[1]); z[2] *= silu_f(g[2]); z[3] *= silu_f(g[3]);
            store_bf4(OG + o, z); }
    }
}
__device__ __forceinline__ void phase_final(const Args& A, int lane, int gw, int NGW) {
    const float* ssq = (const float*)(A.ws + WS_SSQ2); const float* nf = A.in[I_NORMF];
    for (int r = gw; r < M; r += NGW) {
        const float rs = row_rstd(ssq, r, lane); f32x4* xr = (f32x4*)(A.out + (size_t)r * D) + lane;
#pragma unroll
        for (int j = 0; j < 4; ++j) { const f32x4 w = *(const f32x4*)(nf + 256 * j + 4 * lane); xr[64 * j] = xr[64 * j] * rs * w; }
    }
}

__device__ __forceinline__ void phase_gla_naive(const Args& A, LAS unsigned char* lds, int tid) {
    LAS float* sq = (LAS float*)lds; LAS float* sk = sq + 1024; LAS float* sal = sk + 1024; LAS float* so = sal + 1024;
    const bf16* Q0 = (const bf16*)(A.ws + WS_Q0); const bf16* K0 = (const bf16*)(A.ws + WS_K0); const bf16* V0 = (const bf16*)(A.ws + WS_V0); const float* HA = (const float*)(A.ws + WS_HA);
    const int e = tid & 255, half = tid >> 8, j = tid & 127, blk = blockIdx.x;
    for (int slot = 0; slot < 2; ++slot) {
        int item; bool sample;
        if (blk < 64) { if (slot) break; sample = true; item = blk; }
        else { const int q = blk - 64; if (slot == 0) item = q; else { if (q >= 64) break; item = 192 + q; } sample = false; }
        const int b = item >> 3, h = (item >> 1) & 3, d = item & 1, T = sample ? 1024 : 256, row0 = sample ? MP + b * 1024 : b * 256;
        bf16* OUT = (bf16*)(A.ws + (d ? WS_OB : WS_OF));
        float S[64];
        if (sample) { const float* sp = A.in[I_SG] + ((((size_t)b * 2 + d) * 4 + h) * 128 + 64 * half) * 256 + e;
#pragma unroll
            for (int jj = 0; jj < 64; ++jj) S[jj] = sp[(size_t)jj * 256]; }
        else {
#pragma unroll
            for (int jj = 0; jj < 64; ++jj) S[jj] = 0.f; }
        float wa2[16];
#pragma unroll
        for (int m = 0; m < 16; ++m) wa2[m] = A.in[I_GWA2][((size_t)d * 16 + m) * 512 + h * 128 + j];
        const float ba = A.in[I_GBA][d * 512 + h * 128 + j];
        for (int s0 = 0; s0 < T; s0 += 8) {
#pragma unroll
            for (int pp = 0; pp < 2; ++pp) { const int tok = (tid >> 7) + 4 * pp, s = s0 + tok, t = d ? T - 1 - s : s; const size_t row = (size_t)row0 + t;
                const float* ha = HA + row * 32 + d * 16; float z = ba;
#pragma unroll
                for (int m = 0; m < 16; ++m) z += ha[m] * wa2[m];
                const float ls = fminf(z, 0.f) - log1pf(expf(-fabsf(z)));
                sal[tok * 128 + j] = expf(ls * (1.f / 16.f));
                sq[tok * 128 + j] = bf2f(Q0[row * 512 + h * 128 + j]) * 0.08838834764831845f;
                sk[tok * 128 + j] = bf2f(K0[row * 512 + h * 128 + j]); }
            __syncthreads();
            for (int tok = 0; tok < 8; ++tok) { const int s = s0 + tok, t = d ? T - 1 - s : s; const size_t row = (size_t)row0 + t;
                const float v = bf2f(V0[row * 1024 + h * 256 + e]); float o = 0.f;
                const LAS f32x4* a4 = (const LAS f32x4*)(sal + tok * 128 + 64 * half); const LAS f32x4* k4 = (const LAS f32x4*)(sk + tok * 128 + 64 * half); const LAS f32x4* q4 = (const LAS f32x4*)(sq + tok * 128 + 64 * half);
#pragma unroll
                for (int g = 0; g < 16; ++g) { const f32x4 al = a4[g], kk = k4[g], qq = q4[g];
#pragma unroll
                    for (int c = 0; c < 4; ++c) { S[4 * g + c] = al[c] * S[4 * g + c] + kk[c] * v; o += qq[c] * S[4 * g + c]; }
                    if ((g & 3) == 3) asm volatile("" ::: "memory"); }
                so[(tok * 2 + half) * 256 + e] = o; }
            __syncthreads();
            for (int idx = tid; idx < 8 * 256; idx += NTHR) { const int tok = idx >> 8, ee = idx & 255, s = s0 + tok, t = d ? T - 1 - s : s; const size_t row = (size_t)row0 + t;
                OUT[row * 1024 + h * 256 + ee] = (bf16)f2bf(so[(tok * 2) * 256 + ee] + so[(tok * 2 + 1) * 256 + ee]); }
        }
        if (!sample) { float* dst = A.out + OUT_SG + ((((size_t)b * 2 + d) * 4 + h) * 128 + 64 * half) * 256 + e;
#pragma unroll
            for (int jj = 0; jj < 64; ++jj) dst[(size_t)jj * 256] = S[jj]; }
        __syncthreads();
    }
}

__device__ __forceinline__ void phase_rwkv_naive(const Args& A, LAS unsigned char* lds, int lane, int wave) {
    const int blk = blockIdx.x;
    int idx; bool sample;
    if (wave == 0) { sample = true; idx = blk; if (idx >= 256) return; }
    else if (wave <= 4) { sample = false; idx = blk * 4 + (wave - 1); if (idx >= 1024) return; }
    else return;
    const int b = idx >> 5, h = (idx >> 1) & 15, d = idx & 1, T = sample ? 1024 : 256, row0 = sample ? MP + b * 1024 : b * 256, hc = h * 64 + lane;
    LAS float* sl = (LAS float*)(lds + wave * 2048);
    LAS float* a2l = (LAS float*)(lds + 16384 + wave * 16384) + lane;
    const bf16* R1 = (const bf16*)(A.ws + WS_R1); const bf16* K1 = (const bf16*)(A.ws + WS_K1); const bf16* V1 = (const bf16*)(A.ws + WS_V1); const float* LWA = (const float*)(A.ws + WS_LWA);
    float* BON = (float*)(A.ws + WS_BONUS); bf16* YO = (bf16*)(A.ws + (d ? WS_YB : WS_YF));
    float S[64], w2c[64];
#pragma unroll
    for (int m = 0; m < 64; ++m) { w2c[m] = A.in[I_W2][((size_t)d * 64 + m) * 1024 + hc]; a2l[m * 64] = A.in[I_A2][((size_t)d * 64 + m) * 1024 + hc]; }
    const float w0v = A.in[I_W0][d * 1024 + hc], a0v = A.in[I_A0][d * 1024 + hc], kkw = A.in[I_KK][d * 1024 + hc], kaw = A.in[I_KA][d * 1024 + hc], rkw = A.in[I_RK][(d * 16 + h) * 64 + lane];
    if (sample) { const f32x4* sp = (const f32x4*)(A.in[I_SR] + ((((size_t)b * 2 + d) * 16 + h) * 64 + lane) * 64);
#pragma unroll
        for (int g = 0; g < 16; ++g) { const f32x4 v = sp[g]; S[4 * g] = v[0]; S[4 * g + 1] = v[1]; S[4 * g + 2] = v[2]; S[4 * g + 3] = v[3]; } }
    else {
#pragma unroll
        for (int jj = 0; jj < 64; ++jj) S[jj] = 0.f; }
    for (int s = 0; s < T; ++s) {
        const int t = d ? T - 1 - s : s; const size_t row = (size_t)row0 + t;
        sl[lane] = tanhf(LWA[row * 256 + d * 64 + lane]); sl[64 + lane] = LWA[row * 256 + 128 + d * 64 + lane];
        LDS_WAIT();
        float wpre = w0v, apre = a0v;
#pragma unroll
        for (int g = 0; g < 16; ++g) { const f32x4 x = ((const LAS f32x4*)sl)[g], y = ((const LAS f32x4*)(sl + 64))[g];
#pragma unroll
            for (int c = 0; c < 4; ++c) { wpre += x[c] * w2c[4 * g + c]; apre += y[c] * a2l[(4 * g + c) * 64]; } }
        const float sp_ = fmaxf(-wpre, 0.f) + log1pf(expf(-fabsf(wpre)));
        const float dec = expf(-expf(-sp_ - 0.5f));
        const float av = 1.f / (1.f + expf(-apre));
        const float kv = bf2f(K1[row * 1024 + hc]), rv = bf2f(R1[row * 1024 + hc]);
        float kk = kv * kkw; const float nrm = sqrtf(wave_sum(kk * kk)); kk = kk / fmaxf(nrm, 1e-12f);
        const float kd = kv * (1.f + (av - 1.f) * kaw);
        const float bon = wave_sum(rv * kd * rkw);
        if (lane == 0) BON[(row * 16 + h) * 2 + d] = bon;
        sl[128 + lane] = dec; sl[192 + lane] = -kk; sl[256 + lane] = kk * av; sl[320 + lane] = kd; sl[384 + lane] = rv;
        LDS_WAIT();
        const float vv = bf2f(V1[row * 1024 + hc]);
        float sa0 = 0.f, sa1 = 0.f, sa2 = 0.f, sa3 = 0.f;
#pragma unroll
        for (int g = 0; g < 16; ++g) { const f32x4 x = ((const LAS f32x4*)(sl + 192))[g]; sa0 += S[4 * g] * x[0]; sa1 += S[4 * g + 1] * x[1]; sa2 += S[4 * g + 2] * x[2]; sa3 += S[4 * g + 3] * x[3]; }
        const float sa = (sa0 + sa1) + (sa2 + sa3);
        float y0 = 0.f, y1 = 0.f, y2 = 0.f, y3 = 0.f;
#pragma unroll
        for (int g = 0; g < 16; ++g) { const f32x4 dw = ((const LAS f32x4*)(sl + 128))[g], bb = ((const LAS f32x4*)(sl + 256))[g], kx = ((const LAS f32x4*)(sl + 320))[g], rr = ((const LAS f32x4*)(sl + 384))[g];
#pragma unroll
            for (int c = 0; c < 4; ++c) S[4 * g + c] = S[4 * g + c] * dw[c] + sa * bb[c] + vv * kx[c];
            y0 += S[4 * g] * rr[0]; y1 += S[4 * g + 1] * rr[1]; y2 += S[4 * g + 2] * rr[2]; y3 += S[4 * g + 3] * rr[3]; }
        YO[row * 1024 + hc] = (bf16)f2bf((y0 + y1) + (y2 + y3));
        LDS_WAIT();
    }
    if (!sample) { f32x4* dp = (f32x4*)(A.out + OUT_SR + ((((size_t)b * 2 + d) * 16 + h) * 64 + lane) * 64);
#pragma unroll
        for (int g = 0; g < 16; ++g) dp[g] = (f32x4){S[4 * g], S[4 * g + 1], S[4 * g + 2], S[4 * g + 3]}; }
}

__global__ void __launch_bounds__(NTHR, 2) trunk_fwd(Args args) {
    extern __shared__ __attribute__((aligned(16))) unsigned char lds_raw[];
    LAS unsigned char* lds = (LAS unsigned char*)lds_raw;
    const int tid = threadIdx.x, lane = tid & 63, wave = __builtin_amdgcn_readfirstlane(tid >> 6);
    const int G = gridDim.x, gw = blockIdx.x * NWAVES + wave, NGW = G * NWAVES;
    volatile LAS unsigned* MISC = (volatile LAS unsigned*)(lds + MISC_OFF);
    for (int u = tid; u < (LDS_BYTES - LDSCTL_OFF) / 4; u += NTHR) ((LAS unsigned*)(lds + LDSCTL_OFF))[u] = 0u;
    __syncthreads();
    unsigned char* ws = args.ws;
    XcdBarrier bar; bar.bar = (unsigned*)(ws + WS_CTL) + CW_BAR; bar.x = 0; bar.st = nullptr;
    if (N_LAUNCHES == 1) bar = xcd_barrier_post((unsigned*)(ws + WS_CTL) + CW_BAR, MISC + 8);
    const int lo = args.ph_lo, hi = args.ph_hi;
#define IN(k) (lo <= (k) && (k) < hi)
#define SEAM(k) do { if (IN(k) && IN((k) + 1)) xcd_barrier(bar); } while (0)
    if (IN(0)) { phase0(args, lds, tid, lane, wave); } SEAM(0);
    if (IN(1)) { phase_h0(args, lane, gw, NGW); } SEAM(1);
    if (IN(2)) {
        pg8::Gemm g{(const pg8::bf16_t*)(ws + WS_ABUF), (const pg8::bf16_t*)(ws + WS_WIN), M, 3328, 1024}; pg8::StaticOrder S; S.init(M, 3328, G, (int)blockIdx.x);
        pg8::EpiPlanes<0> E{ws};
        pg8::gemm_phase<pg8::EpiPlanes<0>, pg8::StaticOrder, true, true>(lds, g, S, E);
    } SEAM(2);
    #ifdef GLA_NAIVE
    if (IN(3)) { phase_gla_naive(args, lds, tid); } SEAM(3);
#else
    if (IN(3)) { phase_gla_chunk(args, lds, tid, (int)blockIdx.x); } SEAM(3);
#endif
    if (IN(4)) { phase_og0(args, lane, gw, NGW); } SEAM(4);
    if (IN(5)) {
        pg8::Gemm g{(const pg8::bf16_t*)(ws + WS_ABUF), (const pg8::bf16_t*)(ws + WS_WO0), M, 1024, 1024}; pg8::StaticOrder S; S.init(M, 1024, G, (int)blockIdx.x);
        pg8::EpiRes E{args.in[I_XP], args.in[I_XS], args.out, (const float*)(ws + WS_MOD) + 2048, (float*)(ws + WS_SSQ1)};
        pg8::gemm_phase<pg8::EpiRes, pg8::StaticOrder, true, true>(lds, g, S, E);
    } SEAM(5);
    if (IN(6)) { phase_hh(args, lane, gw, NGW); } SEAM(6);
    if (IN(7)) {
        pg8::Gemm g{(const pg8::bf16_t*)(ws + WS_HH), (const pg8::bf16_t*)(ws + WS_W4), M, 4352, 2048}; pg8::StaticOrder S; S.init(M, 4352, G, (int)blockIdx.x);
        pg8::EpiPlanes<1> E{ws};
        pg8::gemm_phase<pg8::EpiPlanes<1>, pg8::StaticOrder, true, true>(lds, g, S, E);
    } SEAM(7);
    #ifdef RWKV_NAIVE
    if (IN(8)) { phase_rwkv_naive(args, lds, lane, wave); } SEAM(8);
#else
    if (IN(8)) { phase_rwkv_chunk(args, lds, tid, (int)blockIdx.x); } SEAM(8);
#endif
    if (IN(9)) { phase_og1(args, lane, gw, NGW); } SEAM(9);
    if (IN(10)) {
        pg8::Gemm g{(const pg8::bf16_t*)(ws + WS_OG1), (const pg8::bf16_t*)(ws + WS_WO1), M, 1024, 1024}; pg8::StaticOrder S; S.init(M, 1024, G, (int)blockIdx.x);
        pg8::EpiRes E{args.out, args.out + OUT_YS, args.out, (const float*)(ws + WS_MOD) + 9 * 3072 + 2048, (float*)(ws + WS_SSQ2)};
        pg8::gemm_phase<pg8::EpiRes, pg8::StaticOrder, true, true>(lds, g, S, E);
    } SEAM(10);
    if (IN(11)) { phase_final(args, lane, gw, NGW); }
#undef IN
#undef SEAM
}

extern "C" void kernel_launch(void* const* d_in, const int* in_sizes, int n_in, void* d_out, int out_size, void* d_ws, size_t ws_size, hipStream_t stream) {
    static int grid = 0;
    if (grid == 0) {
        if (n_in != 30 || ws_size < WS_END) { fprintf(stderr, "kernel_launch: built for 30 inputs and >= %zu bytes of workspace; got n_in %d ws %zu\n", (size_t)WS_END, n_in, ws_size); grid = -1; return; }
        int dev = 0, cus = 0, per_cu = 0;
        if (hipGetDevice(&dev) != hipSuccess || hipDeviceGetAttribute(&cus, hipDeviceAttributeMultiprocessorCount, dev) != hipSuccess) { grid = -1; return; }
        if (hipFuncSetAttribute((const void*)trunk_fwd, hipFuncAttributeMaxDynamicSharedMemorySize, LDS_BYTES) != hipSuccess) { fprintf(stderr, "kernel_launch: hipFuncSetAttribute failed\n"); grid = -1; return; }
        if (hipOccupancyMaxActiveBlocksPerMultiprocessor(&per_cu, (const void*)trunk_fwd, NTHR, LDS_BYTES) != hipSuccess || per_cu < 1) { fprintf(stderr, "kernel_launch: occupancy query reports %d workgroups per CU\n", per_cu); per_cu = 1; }
        (void)hipGetLastError();
        grid = cus;
        if (grid > 256) grid = 256;
    }
    if (grid < 0) return;
    (void)hipMemsetAsync((char*)d_ws + WS_CTL, 0, CTL_ZERO_BYTES, stream);
    Args a{};
    for (int i = 0; i < 30; ++i) a.in[i] = (const float*)d_in[i];
    a.out = (float*)d_out; a.ws = (unsigned char*)d_ws;
    if (N_LAUNCHES == 1) {
        a.ph_lo = 0; a.ph_hi = N_PHASES; a.li = 0;
        void* kargs[] = {&a};
        hipError_t e = hipLaunchCooperativeKernel((const void*)trunk_fwd, dim3(grid), dim3(NTHR), kargs, LDS_BYTES, stream);
        if (e != hipSuccess) fprintf(stderr, "kernel_launch: cooperative launch failed: %s (grid %d)\n", hipGetErrorString(e), grid);
    } else {
        for (int li = 0; li < N_PHASES; ++li) { a.ph_lo = li; a.ph_hi = li + 1; a.li = li;
            hipLaunchKernelGGL(trunk_fwd, dim3(grid), dim3(NTHR), LDS_BYTES, stream, a); }
    }
}
```

```cpp
#include <hip/hip_runtime.h>
#include <cstdio>
#include <cstdint>
constexpr int NWAVES = 8, NTHR = 512;
#ifndef MK_N_LAUNCHES
#define MK_N_LAUNCHES 1
#endif
constexpr int N_PHASES = 12;
constexpr int N_LAUNCHES = MK_N_LAUNCHES;
constexpr int M = 16384, D = 1024, MP = 8192;
constexpr float EPS = 1e-6f, LNX_EPS = 64e-5f;
constexpr size_t OUT_YS = (size_t)MP * D, OUT_SG = (size_t)M * D, OUT_SR = OUT_SG + (size_t)32 * 2 * 4 * 128 * 256;
constexpr size_t MiB = 1u << 20;
constexpr size_t WS_CTL = 0, CTL_ZERO_BYTES = 1 * MiB;
constexpr size_t WS_MOD = 1 * MiB;
constexpr size_t WS_SSQ1 = 2 * MiB, WS_SSQ2 = 3 * MiB;
constexpr size_t WS_BONUS = 4 * MiB;
constexpr size_t WS_HA = 6 * MiB;
constexpr size_t WS_WIN = 8 * MiB;
constexpr size_t WS_WO0 = 15 * MiB;
constexpr size_t WS_W4 = 17 * MiB;
constexpr size_t WS_WO1 = 34 * MiB;
constexpr size_t WS_ABUF = 38 * MiB;
constexpr size_t WS_Q0 = 70 * MiB, WS_K0 = 86 * MiB, WS_V0 = 102 * MiB, WS_G0 = 134 * MiB, WS_OF = 166 * MiB, WS_OB = 198 * MiB;
constexpr size_t WS_HH = 38 * MiB;
constexpr size_t WS_YF = 38 * MiB, WS_YB = 70 * MiB;
constexpr size_t WS_R1 = 102 * MiB, WS_K1 = 134 * MiB, WS_V1 = 166 * MiB, WS_G1 = 198 * MiB;
constexpr size_t WS_LWA = 230 * MiB;
constexpr size_t WS_OG1 = 102 * MiB;
constexpr size_t WS_END = 246 * MiB;
constexpr int CW_BAR = 4096;
constexpr int RING_BYTES = 131072, LDSCTL_OFF = RING_BYTES, MISC_OFF = LDSCTL_OFF + 320, LDS_BYTES = 147456;


struct Args { const float* in[30]; float* out; unsigned char* ws; int ph_lo, ph_hi, li, pad; };
enum { I_XP = 0, I_XS, I_SG, I_SR, I_C, I_CCTX, I_WMOD, I_BMOD, I_NORMW, I_GWIN, I_GWA1, I_GWA2, I_GBA, I_GNORM, I_GWOUT, I_MU, I_WRKVG, I_W0, I_W1, I_W2, I_A0, I_A1, I_A2, I_KK, I_KA, I_RK, I_LNW, I_LNB, I_RWOUT, I_NORMF };

namespace pg8 {
#define PG8_LAS __attribute__((address_space(3)))
typedef unsigned short bf16_t;
typedef short bf16x8 __attribute__((ext_vector_type(8)));
typedef float f32x4 __attribute__((ext_vector_type(4)));
typedef unsigned u32x4 __attribute__((ext_vector_type(4)));
constexpr int BM = 256, BK = 64, HALF = 128, HTB = HALF * BK * 2  , STAGE_BYTES = 8 * HTB, NXCD = 8, WGM = 8;

__host__ __device__ __forceinline__ int lds_byte(int r, int c) { const int st = (r >> 4) * 2 + (c >> 5), rr = r & 15, cc = c & 31, ob = rr * 64 + cc * 2; return st * 1024 + (ob ^ (((ob >> 9) & 1) << 5)); }
__host__ __device__ __forceinline__ void stage_rc(int b, int& R, int& C) { const int st = b / 1024, sb = b % 1024, swz = sb ^ (((sb >> 9) & 1) << 5); R = (st >> 1) * 16 + swz / 64; C = (st & 1) * 32 + (swz % 64) / 2; }
__host__ __device__ __forceinline__ int perm32(int rho) { const int n = rho >> 4, i = rho & 15; return 8 * (i >> 2) + 4 * n + (i & 3); }

struct Unit { int pm, pn; };
struct Gemm { const bf16_t* A; const bf16_t* Bt; int M, N, K; };

struct StaticOrder {
    int nM, nN, nwg, G, c;
    __host__ __device__ void init(int M, int N, int G_, int c_) { nM = M / BM; nN = N / BM; nwg = nM * nN; G = G_; c = c_; }
    __host__ __device__ bool next(int i, Unit& u) const {
        const long L = (long)i * G + c; if (L >= nwg) return false;
        int wgid = (int)L; { const int q = nwg / NXCD, r = nwg % NXCD, xcd = wgid % NXCD, off = wgid / NXCD; wgid = (xcd < r ? xcd * (q + 1) : r * (q + 1) + (xcd - r) * q) + off; }
        const int nig = WGM * nN, gid = wgid / nig, fm = gid * WGM, gsz = (nM - fm) < WGM ? (nM - fm) : WGM;
        u.pm = fm + ((wgid % nig) % gsz); u.pn = (wgid % nig) / gsz; return true;
    }
    __device__ __forceinline__ void a_ready(const Unit&) const {}
    __device__ __forceinline__ void done(const Unit&) const {}
};

__device__ __forceinline__ unsigned cvt_pk_bf16(float lo, float hi) { unsigned r; asm volatile("v_cvt_pk_bf16_f32 %0, %1, %2" : "=v"(r) : "v"(lo), "v"(hi)); return r; }
template <int L> struct EpiPlanes {
    static constexpr bool PERM = true, AFTER_DRAIN = false;
    unsigned char* ws;
    __device__ __forceinline__ void operator()(const f32x4 (&acc)[2][2][4][2], const Unit& u, int wr, int wc, int fr, int fq) const {
        constexpr int T1 = L ? 4 : 2, T2 = L ? 8 : 4, T3 = L ? 12 : 8, T4 = L ? 16 : 12, LRC = L ? 256 : 32, LRLD = L ? 256 : 32;
        constexpr size_t O0 = L ? WS_R1 : WS_Q0, O1 = L ? WS_K1 : WS_K0, O2 = L ? WS_V1 : WS_V0, O3 = L ? WS_G1 : WS_G0, OLR = L ? WS_LWA : WS_HA;
        constexpr int LD01 = L ? 1024 : 512;
        const int row0 = u.pm * BM + wr * 64 + fr;
        if (u.pn >= T4) {
            if constexpr (L == 0) {
                float* lr = (float*)(ws + OLR);
#pragma unroll
                for (int ai = 0; ai < 2; ++ai)
#pragma unroll
                    for (int m = 0; m < 4; ++m) { float* rowp = lr + (size_t)(row0 + ai * HALF + m * 16) * LRLD;
#pragma unroll
                        for (int bj = 0; bj < 2; ++bj)
#pragma unroll
                            for (int n = 0; n < 2; ++n) { const int col = bj * HALF + wc * 32 + 8 * fq + 4 * n; if (col < LRC) *(f32x4*)(rowp + col) = acc[ai][bj][m][n]; } }
            } else {
                bf16_t* lr = (bf16_t*)(ws + OLR);
#pragma unroll
                for (int ai = 0; ai < 2; ++ai)
#pragma unroll
                    for (int m = 0; m < 4; ++m) { bf16_t* rowp = lr + (size_t)(row0 + ai * HALF + m * 16) * 256 + wc * 32 + 8 * fq;
#pragma unroll
                        for (int bj = 0; bj < 2; ++bj) { f32x4 v0 = acc[ai][bj][m][0], v1 = acc[ai][bj][m][1];
                            if (bj == 0) {
#pragma unroll
                                for (int c = 0; c < 4; ++c) { v0[c] = 1.f - 2.f * __builtin_amdgcn_rcpf(1.f + __expf(2.f * v0[c])); v1[c] = 1.f - 2.f * __builtin_amdgcn_rcpf(1.f + __expf(2.f * v1[c])); } }
                            u32x4 w; w.x = cvt_pk_bf16(v0[0], v0[1]); w.y = cvt_pk_bf16(v0[2], v0[3]); w.z = cvt_pk_bf16(v1[0], v1[1]); w.w = cvt_pk_bf16(v1[2], v1[3]);
                            *(u32x4*)(rowp + bj * HALF) = w; } }
            }
            return;
        }
        const int pn = u.pn;
        const size_t off = pn < T1 ? O0 : pn < T2 ? O1 : pn < T3 ? O2 : O3;
        const int ld = pn < T2 ? LD01 : 1024, ts = pn < T1 ? 0 : pn < T2 ? T1 : pn < T3 ? T2 : T3;
        bf16_t* base = (bf16_t*)(ws + off);
        const int col0 = (pn - ts) * BM + wc * 32 + 8 * fq;
#pragma unroll
        for (int ai = 0; ai < 2; ++ai)
#pragma unroll
            for (int m = 0; m < 4; ++m) { bf16_t* rowp = base + (size_t)(row0 + ai * HALF + m * 16) * ld + col0;
#pragma unroll
                for (int bj = 0; bj < 2; ++bj) { const f32x4 v0 = acc[ai][bj][m][0], v1 = acc[ai][bj][m][1];
                    u32x4 w; w.x = cvt_pk_bf16(v0[0], v0[1]); w.y = cvt_pk_bf16(v0[2], v0[3]); w.z = cvt_pk_bf16(v1[0], v1[1]); w.w = cvt_pk_bf16(v1[2], v1[3]);
                    *(u32x4*)(rowp + bj * HALF) = w; } }
    }
};
struct EpiRes {
    static constexpr bool PERM = false, AFTER_DRAIN = false;
    const float* bp; const float* bs;
    float* out;
    const float* gate;
    float* ssq;
    __device__ __forceinline__ void operator()(const f32x4 (&acc)[2][2][4][2], const Unit& u, int wr, int wc, int fr, int fq) const {
#pragma unroll
        for (int ai = 0; ai < 2; ++ai)
#pragma unroll
            for (int m = 0; m < 4; ++m) {
                const int r = u.pm * BM + ai * HALF + wr * 64 + m * 16 + fr;
                const int ci = r < 8192 ? 0 : 1 + ((r - 8192) >> 10);
                const float* brow = r < 8192 ? bp + (size_t)r * 1024 : bs + (size_t)(r - 8192) * 1024;
                float* orow = out + (size_t)r * 1024; const float* grow = gate + ci * 3072;
                float s = 0.f;
#pragma unroll
                for (int bj = 0; bj < 2; ++bj)
#pragma unroll
                    for (int n = 0; n < 2; ++n) { const int c = u.pn * BM + bj * HALF + wc * 32 + n * 16 + 4 * fq;
                        const f32x4 b = *(const f32x4*)(brow + c), g = *(const f32x4*)(grow + c); const f32x4 o = b + g * acc[ai][bj][m][n];
                        *(f32x4*)(orow + c) = o; s += (o[0] * o[0] + o[1] * o[1]) + (o[2] * o[2] + o[3] * o[3]); }
                s += __shfl_xor(s, 16); s += __shfl_xor(s, 32);
                if (fq == 0) ssq[(size_t)r * 16 + u.pn * 4 + wc] = s;
            }
    }
};

template <class Epi, class Sched, bool ALIGN_EPI = false, bool SP2 = false>
__device__ __forceinline__ void gemm_phase(PG8_LAS unsigned char* lds, const Gemm g, const Sched& S, const Epi& E) {
    const int tid = threadIdx.x, wid = __builtin_amdgcn_readfirstlane(tid >> 6), lane = tid & 63, wr = wid >> 2, wc = wid & 3, fr = lane & 15, fq = lane >> 4;
    const int K = g.K, nt = K / BK;
    unsigned voffA[2], voffB[2];
#pragma unroll
    for (int i = 0; i < 2; ++i) { int R, C; stage_rc(tid * 16 + i * 8192, R, C); const int Rb = Epi::PERM ? ((R & ~31) + perm32(R & 31)) : R;
        voffA[i] = (unsigned)(R * K + C) * 2u; voffB[i] = (unsigned)(Rb * K + C) * 2u; }
    const size_t kstep = (size_t)(BK * 2);
    const size_t hstep = (size_t)HALF * K * 2;
    const size_t tstep = 2 * hstep;
    const unsigned ldsw = (unsigned)wid * 1024u;
    const int aoff = lds_byte(wr * 64 + fr, fq * 8), boff = lds_byte(wc * 32 + fr, fq * 8);
#define PG8_SA(b, h) (((b) * 2 + (h)) * HTB)
#define PG8_SB(b, h) ((4 + (b) * 2 + (h)) * HTB)
#define PG8_STAGE(bufoff, gbase, voff) do { _Pragma("unroll") for (int _i = 0; _i < 2; ++_i) \
        __builtin_amdgcn_global_load_lds((const unsigned*)((const char*)(gbase) + (voff)[_i]), (PG8_LAS unsigned*)(lds + (bufoff) + ldsw + _i * 8192), 16, 0, 0); } while (0)
#define PG8_LDA(dst, b, h) do { _Pragma("unroll") for (int m = 0; m < 4; ++m) _Pragma("unroll") for (int k = 0; k < 2; ++k) dst[m][k] = *(const PG8_LAS bf16x8*)(lds + PG8_SA(b, h) + aoff + m * 2048 + k * 1024); } while (0)
#define PG8_LDB(dst, b, h) do { _Pragma("unroll") for (int n = 0; n < 2; ++n) _Pragma("unroll") for (int k = 0; k < 2; ++k) dst[n][k] = *(const PG8_LAS bf16x8*)(lds + PG8_SB(b, h) + boff + n * 2048 + k * 1024); } while (0)
#define PG8_MMA(ai, bj, At, Bt) do { __builtin_amdgcn_s_setprio(1); _Pragma("unroll") for (int m = 0; m < 4; ++m) _Pragma("unroll") for (int n = 0; n < 2; ++n) _Pragma("unroll") for (int k = 0; k < 2; ++k) \
        acc[ai][bj][m][n] = __builtin_amdgcn_mfma_f32_16x16x32_bf16(Bt[n][k], At[m][k], acc[ai][bj][m][n], 0, 0, 0); __builtin_amdgcn_s_setprio(0); } while (0)
#define PG8_WAIT_V(n) asm volatile("s_waitcnt vmcnt(" #n ")" ::: "memory")
#define PG8_WAIT_L(n) asm volatile("s_waitcnt lgkmcnt(" #n ")" ::: "memory")
#define PG8_BAR __builtin_amdgcn_s_barrier()
#define PG8_SCHED __builtin_amdgcn_sched_barrier(0)
    Unit cur, nxt; int ui = 0;
    if (!S.next(0, cur)) return;
    f32x4 acc[2][2][4][2];
#pragma unroll
    for (int a = 0; a < 2; ++a)
#pragma unroll
        for (int b = 0; b < 2; ++b)
#pragma unroll
            for (int m = 0; m < 4; ++m)
#pragma unroll
                for (int n = 0; n < 2; ++n) acc[a][b][m][n] = (f32x4){0.f, 0.f, 0.f, 0.f};
    bf16x8 At[4][2], B0[2][2], B1[2][2];
    const char* cA = (const char*)g.A + (size_t)cur.pm * tstep; const char* cB = (const char*)g.Bt + (size_t)cur.pn * tstep;
    S.a_ready(cur);
    if constexpr (SP2) {
        PG8_STAGE(PG8_SB(0, 0), cB, voffB); PG8_STAGE(PG8_SB(0, 1), cB + hstep, voffB); PG8_STAGE(PG8_SA(0, 0), cA, voffA); PG8_STAGE(PG8_SA(0, 1), cA + hstep, voffA);
        if (wr == 1) PG8_BAR;
        PG8_WAIT_V(2); PG8_BAR;
        PG8_STAGE(PG8_SB(1, 0), cB + kstep, voffB); PG8_STAGE(PG8_SA(1, 0), cA + kstep, voffA); PG8_STAGE(PG8_SB(1, 1), cB + hstep + kstep, voffB);
        PG8_WAIT_V(6); PG8_BAR;
    } else {
        PG8_STAGE(PG8_SB(0, 0), cB, voffB); PG8_STAGE(PG8_SA(0, 0), cA, voffA); PG8_STAGE(PG8_SB(0, 1), cB + hstep, voffB); PG8_STAGE(PG8_SA(0, 1), cA + hstep, voffA);
        if (wr == 1) PG8_BAR;
        PG8_WAIT_V(4); PG8_BAR;
        PG8_STAGE(PG8_SB(1, 0), cB + kstep, voffB); PG8_STAGE(PG8_SA(1, 0), cA + kstep, voffA); PG8_STAGE(PG8_SB(1, 1), cB + hstep + kstep, voffB);
        PG8_WAIT_V(6); PG8_BAR;
    }
    for (;;) {
        const bool has_next = S.next(ui + 1, nxt);
        const char* nA = has_next ? (const char*)g.A + (size_t)nxt.pm * tstep : cA; const char* nB = has_next ? (const char*)g.Bt + (size_t)nxt.pn * tstep : cB;
        for (int t = 0; t < nt; t += 2) {
            const bool last = (t == nt - 2);
            const char* a1 = cA + (size_t)(t + 1) * kstep;
            const char* a2 = last ? nA : cA + (size_t)(t + 2) * kstep; const char* b2 = last ? nB : cB + (size_t)(t + 2) * kstep;
            const char* a3 = a2 + kstep; const char* b3 = b2 + kstep;
            if (last && has_next) S.a_ready(nxt);
            if constexpr (SP2) {
            PG8_LDB(B0, 0, 0); PG8_LDB(B1, 0, 1); PG8_SCHED; PG8_LDA(At, 0, 0); PG8_STAGE(PG8_SA(1, 1), a1 + hstep, voffA);
            PG8_WAIT_V(8); PG8_WAIT_L(0); PG8_BAR; PG8_MMA(0, 0, At, B0); PG8_MMA(0, 1, At, B1); PG8_BAR; PG8_SCHED;
            PG8_LDA(At, 0, 1); PG8_STAGE(PG8_SB(0, 0), b2, voffB); PG8_STAGE(PG8_SB(0, 1), b2 + hstep, voffB); PG8_STAGE(PG8_SA(0, 0), a2, voffA);
            PG8_WAIT_V(8); PG8_WAIT_L(0); PG8_BAR; PG8_MMA(1, 0, At, B0); PG8_MMA(1, 1, At, B1); PG8_BAR; PG8_SCHED;
            PG8_LDB(B0, 1, 0); PG8_LDB(B1, 1, 1); PG8_SCHED; PG8_LDA(At, 1, 0); PG8_STAGE(PG8_SA(0, 1), a2 + hstep, voffA);
            PG8_WAIT_V(8); PG8_WAIT_L(0); PG8_BAR; PG8_MMA(0, 0, At, B0); PG8_MMA(0, 1, At, B1); PG8_BAR; PG8_SCHED;
            PG8_LDA(At, 1, 1); PG8_STAGE(PG8_SB(1, 0), b3, voffB); PG8_STAGE(PG8_SB(1, 1), b3 + hstep, voffB); PG8_STAGE(PG8_SA(1, 0), a3, voffA);
            PG8_WAIT_V(8); PG8_WAIT_L(0); PG8_BAR; PG8_MMA(1, 0, At, B0); PG8_MMA(1, 1, At, B1); PG8_BAR; PG8_SCHED;
            } else {
            PG8_LDB(B0, 0, 0); PG8_SCHED; PG8_LDA(At, 0, 0); PG8_STAGE(PG8_SA(1, 1), a1 + hstep, voffA);
            PG8_WAIT_L(8); PG8_BAR; PG8_WAIT_L(0); PG8_MMA(0, 0, At, B0); PG8_BAR; PG8_SCHED;
            PG8_LDB(B1, 0, 1); PG8_STAGE(PG8_SB(0, 0), b2, voffB);
            PG8_BAR; PG8_WAIT_L(0); PG8_MMA(0, 1, At, B1); PG8_BAR;
            PG8_LDA(At, 0, 1); PG8_STAGE(PG8_SA(0, 0), a2, voffA);
            PG8_BAR; PG8_WAIT_L(0); PG8_MMA(1, 0, At, B0); PG8_BAR; PG8_SCHED;
            PG8_STAGE(PG8_SB(0, 1), b2 + hstep, voffB);
            PG8_WAIT_V(6); PG8_BAR; PG8_MMA(1, 1, At, B1); PG8_BAR;
            PG8_LDB(B0, 1, 0); PG8_SCHED; PG8_LDA(At, 1, 0); PG8_STAGE(PG8_SA(0, 1), a2 + hstep, voffA);
            PG8_WAIT_L(8); PG8_BAR; PG8_WAIT_L(0); PG8_MMA(0, 0, At, B0); PG8_BAR; PG8_SCHED;
            PG8_LDB(B1, 1, 1); PG8_STAGE(PG8_SB(1, 0), b3, voffB);
            PG8_BAR; PG8_WAIT_L(0); PG8_MMA(0, 1, At, B1); PG8_BAR;
            PG8_LDA(At, 1, 1); PG8_STAGE(PG8_SA(1, 0), a3, voffA);
            PG8_BAR; PG8_WAIT_L(0); PG8_MMA(1, 0, At, B0); PG8_BAR; PG8_SCHED;
            PG8_STAGE(PG8_SB(1, 1), b3 + hstep, voffB);
            PG8_WAIT_V(6); PG8_BAR; PG8_MMA(1, 1, At, B1); PG8_BAR;
            }
        }
        if constexpr (ALIGN_EPI) { if (wr == 0) PG8_BAR; }
        if constexpr (!Epi::AFTER_DRAIN) { E(acc, cur, wr, wc, fr, fq); S.done(cur); }
        if (!has_next) break;
#pragma unroll
        for (int a = 0; a < 2; ++a)
#pragma unroll
            for (int b = 0; b < 2; ++b)
#pragma unroll
                for (int m = 0; m < 4; ++m)
#pragma unroll
                    for (int n = 0; n < 2; ++n) acc[a][b][m][n] = (f32x4){0.f, 0.f, 0.f, 0.f};
        cur = nxt; cA = nA; cB = nB; ++ui;
        if constexpr (ALIGN_EPI) { if (wr == 1) PG8_BAR; }
    }
    PG8_WAIT_V(0);
    if constexpr (!ALIGN_EPI) { if (wr == 0) PG8_BAR; }
    PG8_BAR;
    if constexpr (Epi::AFTER_DRAIN) { E.fused(acc, cur, wr, wc, fr, fq, lds, wid, lane); S.done(cur); }
#undef PG8_SA
#undef PG8_SB
#undef PG8_STAGE
#undef PG8_LDA
#undef PG8_LDB
#undef PG8_MMA
#undef PG8_WAIT_V
#undef PG8_WAIT_L
#undef PG8_BAR
#undef PG8_SCHED
}
}
#define GAS __attribute__((address_space(1)))
#define LAS __attribute__((address_space(3)))
typedef unsigned short bf16;
typedef unsigned v4u __attribute__((ext_vector_type(4)));
typedef float f32x4 __attribute__((ext_vector_type(4)));
typedef short bf16x8 __attribute__((ext_vector_type(8)));
typedef GAS unsigned gu32;
typedef GAS unsigned long long gu64;
#define RLX_AGENT __ATOMIC_RELAXED, __HIP_MEMORY_SCOPE_AGENT
#define LDS_WAIT() asm volatile("s_waitcnt lgkmcnt(0)" ::: "memory")
#define VM_WAIT() asm volatile("s_waitcnt vmcnt(0)" ::: "memory")
__device__ __forceinline__ unsigned long long rt() { return __builtin_amdgcn_s_memrealtime(); }
__device__ __forceinline__ unsigned f2bf(float f) { unsigned u = __builtin_bit_cast(unsigned, f); return (u + 0x7fffu + ((u >> 16) & 1u)) >> 16; }
__device__ __forceinline__ unsigned pk2(float lo, float hi) { return f2bf(lo) | (f2bf(hi) << 16); }

#define XB_TMO      128
#define XB_XCNT(j)  (256  + 64 * (j))
#define XB_XSUB(j)  (1280 + 64 * (j))
#define XB_XGEN(j)  (2304 + 64 * (j))
#define XB_TOP      3328
#define XB_TOPGEN   3392
#define XCD_BAR_WORDS 3456
#define XB_SPIN_CAP (1u << 18)

__device__ __forceinline__ unsigned xb_ld(unsigned* p)              { return __hip_atomic_load(p, __ATOMIC_RELAXED, __HIP_MEMORY_SCOPE_AGENT); }
__device__ __forceinline__ unsigned xb_add(unsigned* p, unsigned v) { return __hip_atomic_fetch_add(p, v, __ATOMIC_RELAXED, __HIP_MEMORY_SCOPE_AGENT); }
__device__ __forceinline__ unsigned xb_xcc_id() { return (unsigned)__builtin_amdgcn_s_getreg((3 << 11) | 20) & 0xFu; }
#define XB_SPIN(cond, bar) do { unsigned _sp = 0; while (cond) { __builtin_amdgcn_s_sleep(1); \
    if ((++_sp & 255u) == 0u) { if (xb_ld(&(bar)[XB_TMO])) break; if (_sp > XB_SPIN_CAP) { atomicAdd(&(bar)[XB_TMO], 1u); break; } } } } while (0)

struct XcdBarrier {
    unsigned* bar; unsigned x;
    volatile LAS unsigned* st;
};

__device__ __forceinline__ XcdBarrier xcd_barrier_post(unsigned* bar, volatile LAS unsigned* st) {
    XcdBarrier b; b.bar = bar; b.x = xb_xcc_id(); b.st = st;
    if (threadIdx.x == 0) (void)xb_add(&bar[XB_XCNT(b.x)], 1u);
    return b;
}
__device__ __forceinline__ void xcd_barrier_complete(unsigned* bar, unsigned x, unsigned& nloc, unsigned& nx) {
    const unsigned G = gridDim.x * gridDim.y * gridDim.z;
    unsigned sum, cnt, mine, sp = 0u;
    for (;;) {
        sum = 0u; cnt = 0u; mine = 0u;
#pragma unroll
        for (unsigned j = 0; j < 16; ++j) { const unsigned c = xb_ld(&bar[XB_XCNT(j)]); sum += c; cnt += (c > 0u) ? 1u : 0u; mine = (j == x) ? c : mine; }
        if (sum == G) break;
        __builtin_amdgcn_s_sleep(1);
        if ((++sp & 255u) == 0u) { if (xb_ld(&bar[XB_TMO])) break; if (sp > XB_SPIN_CAP) { atomicAdd(&bar[XB_TMO], 1u); break; } }
    }
    nloc = mine > 0u ? mine : 1u; nx = cnt > 0u ? cnt : 1u;
}

__device__ __forceinline__ void xcd_barrier(const XcdBarrier& b) {
    asm volatile("s_waitcnt vmcnt(0)" ::: "memory");
    __syncthreads();
    if (threadIdx.x == 0) {
        unsigned* bar = b.bar;
        __builtin_amdgcn_s_waitcnt(0);
        unsigned nloc = b.st[0], nx = b.st[1];
        if (nloc == 0u) { xcd_barrier_complete(bar, b.x, nloc, nx); b.st[0] = nloc; b.st[1] = nx; }
        const unsigned old = xb_add(&bar[XB_XSUB(b.x)], 1u);
        const unsigned gen = old / nloc;
        if (old + 1u == (gen + 1u) * nloc) {
            __builtin_amdgcn_fence(__ATOMIC_RELEASE, "agent");
            asm volatile("s_waitcnt vmcnt(0)" ::: "memory");
            const unsigned og = xb_add(&bar[XB_TOP], 1u);
            const unsigned tg = og / nx;
            if (og + 1u == (tg + 1u) * nx) xb_add(&bar[XB_TOPGEN], 1u);
            else XB_SPIN(xb_ld(&bar[XB_TOPGEN]) == tg, bar);
            __builtin_amdgcn_fence(__ATOMIC_ACQUIRE, "agent");
            xb_add(&bar[XB_XGEN(b.x)], 1u);
            asm volatile("s_waitcnt vmcnt(0)" ::: "memory");
        } else {
            XB_SPIN(xb_ld(&bar[XB_XGEN(b.x)]) == gen, bar);
            __builtin_amdgcn_fence(__ATOMIC_ACQUIRE, "agent");
            asm volatile("s_waitcnt vmcnt(0)" ::: "memory");
        }
    }
    __syncthreads();
}

typedef float f32x16 __attribute__((ext_vector_type(16)));
typedef unsigned v2u __attribute__((ext_vector_type(2)));
#define BAR() __syncthreads()
#define MFMA32(a, b, c) __builtin_amdgcn_mfma_f32_32x32x16_bf16(a, b, c, 0, 0, 0)
#define MFMA16(a, b, c) __builtin_amdgcn_mfma_f32_16x16x32_bf16(a, b, c, 0, 0, 0)
#define SHFLX(v, m) __shfl_xor(v, m)
#define RFL(x) __builtin_amdgcn_readfirstlane(x)
#define FORCEINLINE __device__ __forceinline__
template <int CTRL> __device__ __forceinline__ float dppf(float v) { return __builtin_bit_cast(float, __builtin_amdgcn_update_dpp(0, __builtin_bit_cast(int, v), CTRL, 0xF, 0xF, true)); }
#define RED16(x) do { x += dppf<0xB1>(x); x += dppf<0x4E>(x); x += dppf<0x141>(x); x += dppf<0x140>(x); } while (0)
#define BAR_LDS() do { asm volatile("s_waitcnt lgkmcnt(0)" ::: "memory"); __builtin_amdgcn_s_barrier(); asm volatile("" ::: "memory"); } while (0)
#define FEXP(x) __expf(x)
#define FRCP(x) __builtin_amdgcn_rcpf(x)
#define FRSQ(x) __builtin_amdgcn_rsqf(x)
#define FLOG(x) __logf(x)
__device__ __forceinline__ unsigned CVTPK(float lo, float hi) { unsigned r; asm volatile("v_cvt_pk_bf16_f32 %0, %1, %2" : "=v"(r) : "v"(lo), "v"(hi)); return r; }
__device__ __forceinline__ float bf2f(unsigned short b) { return __uint_as_float(((unsigned)b) << 16); }
__device__ __forceinline__ float wave_sum(float v) {
#pragma unroll
    for (int o = 1; o < 64; o <<= 1) v += __shfl_xor(v, o);
    return v;
}
__device__ __forceinline__ float silu_f(float x) { return x / (1.f + __expf(-x)); }

constexpr int GL_QB = 0;
constexpr int GL_KB = GL_QB + 64 * 272;
constexpr int GL_KDT = GL_KB + 64 * 272;
constexpr int GL_VT = GL_KDT + 128 * 144;
constexpr int GL_SC = GL_VT + 256 * 144;
constexpr int GL_DEC = GL_SC + 64 * 144;
constexpr int GL_TOT = GL_DEC + 512;
constexpr int GL_END = GL_TOT + 2048;
static_assert(GL_END <= 131072, "GLA LDS map");

FORCEINLINE void phase_gla_chunk(const Args& A, LAS unsigned char* lds, int tid, int blk) {
    LAS bf16* QB = (LAS bf16*)(lds + GL_QB); LAS bf16* KB = (LAS bf16*)(lds + GL_KB); LAS bf16* KDT = (LAS bf16*)(lds + GL_KDT); LAS bf16* VT = (LAS bf16*)(lds + GL_VT);
    LAS bf16* SC = (LAS bf16*)(lds + GL_SC); LAS float* DEC = (LAS float*)(lds + GL_DEC); LAS float* TOT = (LAS float*)(lds + GL_TOT);
    const bf16* Q0 = (const bf16*)(A.ws + WS_Q0); const bf16* K0 = (const bf16*)(A.ws + WS_K0); const bf16* V0 = (const bf16*)(A.ws + WS_V0); const float* HA = (const float*)(A.ws + WS_HA);
    const int lane = tid & 63, wave = RFL(tid >> 6), l31 = lane & 31, hh = lane >> 5;
    const int j = tid & 127, qtr = RFL(tid >> 7);
    for (int slot = 0; slot < 2; ++slot) {
        int item; bool sample;
        if (blk < 64) { if (slot) break; sample = true; item = blk; }
        else { const int q = blk - 64; if (slot == 0) item = q; else { if (q >= 64) break; item = 192 + q; } sample = false; }
        const int b = item >> 3, h = (item >> 1) & 3, d = item & 1, T = sample ? 1024 : 256, row0 = sample ? MP + b * 1024 : b * 256;
        bf16* OUT = (bf16*)(A.ws + (d ? WS_OB : WS_OF));
        const int ecol = 32 * wave + l31;
        f32x16 S[4];
        if (sample) { const float* sp = A.in[I_SG] + ((((size_t)b * 2 + d) * 4 + h) * 128) * 256 + ecol;
#pragma unroll
            for (int t = 0; t < 4; ++t)
#pragma unroll
                for (int r = 0; r < 16; ++r) S[t][r] = sp[(size_t)(32 * t + (r & 3) + 8 * (r >> 2) + 4 * hh) * 256]; }
        else {
#pragma unroll
            for (int t = 0; t < 4; ++t)
#pragma unroll
                for (int r = 0; r < 16; ++r) S[t][r] = 0.f; }
        float wa2[16];
#pragma unroll
        for (int m = 0; m < 16; ++m) wa2[m] = A.in[I_GWA2][((size_t)d * 16 + m) * 512 + h * 128 + j];
        const float ba = A.in[I_GBA][d * 512 + h * 128 + j];
        for (int ch = 0; ch < T / 64; ++ch) {
            float bl[16]; float run = 0.f;
#pragma unroll
            for (int ii = 0; ii < 16; ++ii) { const int s = 64 * ch + 16 * qtr + ii, t = d ? T - 1 - s : s; const float* ha = HA + ((size_t)row0 + t) * 32 + d * 16; float z = ba;
#pragma unroll
                for (int m = 0; m < 16; ++m) z += ha[m] * wa2[m];
                const float ls = fminf(z, 0.f) - log1pf(expf(-fabsf(z)));
                run += ls * (1.f / 16.f); bl[ii] = run; }
            TOT[qtr * 128 + j] = run;
            BAR();
            float off = 0.f, tot = 0.f;
#pragma unroll
            for (int q = 0; q < 4; ++q) { const float tv = TOT[q * 128 + j]; off += q < qtr ? tv : 0.f; tot += tv; }
            if (qtr == 0) DEC[j] = expf(tot);
            unsigned kdp[8];
#pragma unroll
            for (int ii = 0; ii < 16; ii += 2) { float kdv[2];
#pragma unroll
                for (int u = 0; u < 2; ++u) { const int i = 16 * qtr + ii + u, s = 64 * ch + i, t = d ? T - 1 - s : s; const size_t row = (size_t)row0 + t; const float bb = bl[ii + u] + off;
                    const float qv = bf2f(Q0[row * 512 + h * 128 + j]), kv = bf2f(K0[row * 512 + h * 128 + j]);
                    QB[i * 136 + j] = (bf16)f2bf(qv * expf(bb) * 0.08838834764831845f); KB[i * 136 + j] = (bf16)f2bf(kv * expf(-bb)); kdv[u] = kv * expf(tot - bb); }
                kdp[ii >> 1] = CVTPK(kdv[0], kdv[1]); }
            *(LAS v4u*)(KDT + j * 72 + 16 * qtr) = (v4u){kdp[0], kdp[1], kdp[2], kdp[3]};
            *(LAS v4u*)(KDT + j * 72 + 16 * qtr + 8) = (v4u){kdp[4], kdp[5], kdp[6], kdp[7]};
            { const int sv = tid & 63, cg = tid >> 6, s = 64 * ch + sv, t = d ? T - 1 - s : s; const bf16* vrow = V0 + ((size_t)row0 + t) * 1024 + h * 256;
#pragma unroll
                for (int i4 = 0; i4 < 4; ++i4) { const int e0 = (cg * 4 + i4) * 8; const v4u w = *(const v4u*)(vrow + e0);
#pragma unroll
                    for (int u = 0; u < 4; ++u) { VT[(e0 + 2 * u) * 72 + sv] = (bf16)(w[u] & 0xffffu); VT[(e0 + 2 * u + 1) * 72 + sv] = (bf16)(w[u] >> 16); } } }
            BAR();
            if (wave < 3) { const int ct = wave == 0 ? 0 : 1, st = wave == 2 ? 1 : 0;
                f32x16 sc;
#pragma unroll
                for (int r = 0; r < 16; ++r) sc[r] = 0.f;
#pragma unroll
                for (int ks = 0; ks < 8; ++ks) { const bf16x8 a = *(const LAS bf16x8*)(QB + (32 * ct + l31) * 136 + 16 * ks + 8 * hh), bf = *(const LAS bf16x8*)(KB + (32 * st + l31) * 136 + 16 * ks + 8 * hh); sc = MFMA32(a, bf, sc); }
#pragma unroll
                for (int r = 0; r < 16; ++r) { const int c = 32 * ct + (r & 3) + 8 * (r >> 2) + 4 * hh, s_ = 32 * st + l31; SC[c * 72 + s_] = (bf16)f2bf(c >= s_ ? sc[r] : 0.f); } }
            f32x16 O[2];
#pragma unroll
            for (int ct = 0; ct < 2; ++ct)
#pragma unroll
                for (int r = 0; r < 16; ++r) O[ct][r] = 0.f;
#pragma unroll
            for (int t = 0; t < 4; ++t)
#pragma unroll
                for (int ks = 0; ks < 2; ++ks) {
                    v4u pk; pk[0] = CVTPK(S[t][8 * ks + 0], S[t][8 * ks + 1]); pk[1] = CVTPK(S[t][8 * ks + 2], S[t][8 * ks + 3]); pk[2] = CVTPK(S[t][8 * ks + 4], S[t][8 * ks + 5]); pk[3] = CVTPK(S[t][8 * ks + 6], S[t][8 * ks + 7]);
                    const bf16x8 bfrag = __builtin_bit_cast(bf16x8, pk);
#pragma unroll
                    for (int ct = 0; ct < 2; ++ct) { const LAS bf16* ap = QB + (32 * ct + l31) * 136 + 32 * t + 16 * ks + 4 * hh;
                        const v2u lo = *(const LAS v2u*)ap, hi = *(const LAS v2u*)(ap + 8); const v4u av = (v4u){lo[0], lo[1], hi[0], hi[1]};
                        O[ct] = MFMA32(__builtin_bit_cast(bf16x8, av), bfrag, O[ct]); } }
            bf16x8 vb[4];
#pragma unroll
            for (int ks = 0; ks < 4; ++ks) vb[ks] = *(const LAS bf16x8*)(VT + ecol * 72 + 16 * ks + 8 * hh);
#pragma unroll
            for (int t = 0; t < 4; ++t) {
#pragma unroll
                for (int g = 0; g < 4; ++g) { const f32x4 dc = *(const LAS f32x4*)(DEC + 32 * t + 8 * g + 4 * hh);
#pragma unroll
                    for (int c = 0; c < 4; ++c) S[t][4 * g + c] *= dc[c]; }
#pragma unroll
                for (int ks = 0; ks < 4; ++ks) { const bf16x8 a = *(const LAS bf16x8*)(KDT + (32 * t + l31) * 72 + 16 * ks + 8 * hh); S[t] = MFMA32(a, vb[ks], S[t]); } }
            BAR();
#pragma unroll
            for (int ct = 0; ct < 2; ++ct)
#pragma unroll
                for (int ks = 0; ks < 4; ++ks) if (ks < (ct ? 4 : 2)) { const bf16x8 a = *(const LAS bf16x8*)(SC + (32 * ct + l31) * 72 + 16 * ks + 8 * hh); O[ct] = MFMA32(a, vb[ks], O[ct]); }
#pragma unroll
            for (int ct = 0; ct < 2; ++ct)
#pragma unroll
                for (int r = 0; r < 16; ++r) { const int c = 32 * ct + (r & 3) + 8 * (r >> 2) + 4 * hh, s = 64 * ch + c, t = d ? T - 1 - s : s;
                    OUT[((size_t)row0 + t) * 1024 + h * 256 + ecol] = (bf16)f2bf(O[ct][r]); }
        }
        if (!sample) { float* dst = A.out + OUT_SG + ((((size_t)b * 2 + d) * 4 + h) * 128) * 256 + ecol;
#pragma unroll
            for (int t = 0; t < 4; ++t)
#pragma unroll
                for (int r = 0; r < 16; ++r) dst[(size_t)(32 * t + (r & 3) + 8 * (r >> 2) + 4 * hh) * 256] = S[t][r]; }
        BAR();
    }
}
constexpr int RW_SET = 17664;
constexpr int RW_XS = 0;
constexpr int RW_YS = 4608;
constexpr int RW_YT = 9216;
constexpr int RW_VT = 14336;
constexpr int RW_GC = 17408;
constexpr int RW_LAB = 4 * RW_SET;
constexpr int RW_BONL = RW_LAB + 4096;
constexpr int RW_END = RW_BONL + 512;
static_assert(RW_END <= 131072, "RWKV LDS map");

FORCEINLINE float fast_exp(float x) { return FEXP(x); }
FORCEINLINE float fast_tanh(float x) { return 1.f - 2.f * FRCP(1.f + FEXP(2.f * x)); }

struct RwItem { int b, h, d, T, row0; };
struct RwRaw { v4u aw[2], aa[2]; unsigned short k[4][4], r[4][2], v[2][4]; };
FORCEINLINE void rwkv_prep_load(const Args& A, RwRaw& w, const RwItem it, int ch, int jh, int lane) {
    const int j16 = lane & 15, q = lane >> 4;
    const bf16* R1 = (const bf16*)(A.ws + WS_R1); const bf16* K1 = (const bf16*)(A.ws + WS_K1); const bf16* V1 = (const bf16*)(A.ws + WS_V1); const bf16* LWA = (const bf16*)(A.ws + WS_LWA);
    const int h = it.h, d = it.d, T = it.T, row0 = it.row0;
    { const int s = 16 * ch + j16, t = d ? T - 1 - s : s; const bf16* lrow = LWA + ((size_t)row0 + t) * 256 + d * 64;
#pragma unroll
        for (int ks = 0; ks < 2; ++ks) { w.aw[ks] = *(const v4u*)(lrow + 32 * ks + 8 * q); w.aa[ks] = *(const v4u*)(lrow + 128 + 32 * ks + 8 * q); } }
#pragma unroll
    for (int rr = 0; rr < 4; ++rr) { const int s = 16 * ch + 4 * q + rr, t = d ? T - 1 - s : s; const size_t row = (size_t)row0 + t;
#pragma unroll
        for (int n2 = 0; n2 < 4; ++n2) w.k[rr][n2] = K1[row * 1024 + h * 64 + 16 * n2 + j16];
#pragma unroll
        for (int n = 0; n < 2; ++n) { w.r[rr][n] = R1[row * 1024 + h * 64 + 32 * jh + 16 * n + j16]; w.v[n][rr] = V1[row * 1024 + h * 64 + 32 * jh + 16 * n + j16]; } }
}
FORCEINLINE void rwkv_prep(LAS unsigned char* set, LAS float* bonl, const RwRaw& w, int jh, int lane,
                           const bf16x8 (&Bw)[2][2], const bf16x8 (&Ba)[2][2], const float (&w0v)[2], const float (&a0v)[2], const float (&kav)[2], const float (&rkv)[2], const float (&kkw)[4]) {
    const int j16 = lane & 15, q = lane >> 4;
    LAS bf16* pXS = (LAS bf16*)(set + RW_XS); LAS bf16* pYS = (LAS bf16*)(set + RW_YS); LAS bf16* pYT = (LAS bf16*)(set + RW_YT); LAS bf16* pVT = (LAS bf16*)(set + RW_VT); LAS float* pGC = (LAS float*)(set + RW_GC);
    f32x4 Dw[2], Da[2];
#pragma unroll
    for (int n = 0; n < 2; ++n) { Dw[n] = (f32x4){0.f, 0.f, 0.f, 0.f}; Da[n] = (f32x4){0.f, 0.f, 0.f, 0.f}; }
    {
#pragma unroll
        for (int ks = 0; ks < 2; ++ks) {
#pragma unroll
            for (int n = 0; n < 2; ++n) { Dw[n] = MFMA16(__builtin_bit_cast(bf16x8, w.aw[ks]), Bw[n][ks], Dw[n]); Da[n] = MFMA16(__builtin_bit_cast(bf16x8, w.aa[ks]), Ba[n][ks], Da[n]); } } }
    float lwd[2][4], asg[2][4], kkv[2][4], kdv[2][4], rvv[2][4], bonp[4];
#pragma unroll
    for (int rr = 0; rr < 4; ++rr) {
        float n2s = 0.f; float kx[4];
#pragma unroll
        for (int n2 = 0; n2 < 4; ++n2) { kx[n2] = bf2f(w.k[rr][n2]); const float kq = kx[n2] * kkw[n2]; n2s += kq * kq; }
        RED16(n2s);
        const float inv = FRSQ(fmaxf(n2s, 1e-24f));
        float bp = 0.f;
#pragma unroll
        for (int n = 0; n < 2; ++n) { const float wpre = w0v[n] + Dw[n][rr], apre = a0v[n] + Da[n][rr];
            lwd[n][rr] = -0.6065306597126334f * FRCP(1.f + fast_exp(-wpre));
            asg[n][rr] = FRCP(1.f + fast_exp(-apre));
            const float kraw = jh ? kx[2 + n] : kx[n], kself = jh ? kkw[2 + n] : kkw[n];
            kkv[n][rr] = kraw * kself * inv;
            kdv[n][rr] = kraw * (1.f + (asg[n][rr] - 1.f) * kav[n]);
            rvv[n][rr] = bf2f(w.r[rr][n]);
            bp += rvv[n][rr] * kdv[n][rr] * rkv[n]; }
        RED16(bp);
        bonp[rr] = bp; }
    if (j16 == 0) {
#pragma unroll
        for (int rr = 0; rr < 4; ++rr) bonl[jh * 16 + 4 * q + rr] = bonp[rr]; }
#pragma unroll
    for (int n = 0; n < 2; ++n) { const int jc = 32 * jh + 16 * n + j16;
        const float tot = (lwd[n][0] + lwd[n][1]) + (lwd[n][2] + lwd[n][3]);
        const float bq = SHFLX(tot, 16), pr = tot + bq, cq = SHFLX(pr, 32);
        float cum = ((q & 1) ? bq : 0.f) + ((q & 2) ? cq : 0.f);
        float yb_[4], yk_[4]; float gp = fast_exp(cum);
#pragma unroll
        for (int rr = 0; rr < 4; ++rr) { cum += lwd[n][rr];
            const float g = fast_exp(cum), gi = FRCP(g);
            const float at = -kkv[n][rr] * gp, bt = kkv[n][rr] * asg[n][rr] * gi, kt = kdv[n][rr] * gi, rt = rvv[n][rr] * g;
            gp = g;
            const int rho = rr + 8 * q; const unsigned xar = CVTPK(at, rt), ybk = CVTPK(bt, kt);
            pXS[rho * 72 + jc] = (bf16)(xar & 0xffffu); pXS[(rho + 4) * 72 + jc] = (bf16)(xar >> 16);
            pYS[rho * 72 + jc] = (bf16)(ybk & 0xffffu); pYS[(rho + 4) * 72 + jc] = (bf16)(ybk >> 16);
            yb_[rr] = bt; yk_[rr] = kt; }
        *(LAS v2u*)(pYT + jc * 40 + 4 * q) = (v2u){CVTPK(yb_[0], yb_[1]), CVTPK(yb_[2], yb_[3])};
        *(LAS v2u*)(pYT + jc * 40 + 16 + 4 * q) = (v2u){CVTPK(yk_[0], yk_[1]), CVTPK(yk_[2], yk_[3])};
        if (q == 0) pGC[jc] = fast_exp(pr + cq);
        *(LAS v2u*)(pVT + jc * 24 + 4 * q) = (v2u){(unsigned)w.v[n][0] | ((unsigned)w.v[n][1] << 16), (unsigned)w.v[n][2] | ((unsigned)w.v[n][3] << 16)}; }
}

FORCEINLINE void rwkv_core(const Args& A, const LAS unsigned char* set, LAS float* LAB, const LAS float* bonl, f32x16 (&Z)[2], const RwItem it, int ch, int c_it, int lane) {
    const int l31 = lane & 31, hh = lane >> 5;
    const LAS bf16* cXS = (const LAS bf16*)(set + RW_XS); const LAS bf16* cYS = (const LAS bf16*)(set + RW_YS); const LAS bf16* cYT = (const LAS bf16*)(set + RW_YT); const LAS bf16* cVT = (const LAS bf16*)(set + RW_VT); const LAS float* cGC = (const LAS float*)(set + RW_GC);
    const int h = it.h, d = it.d, T = it.T, row0 = it.row0, icol = 32 * c_it + l31;
    f32x16 Gp;
#pragma unroll
    for (int r = 0; r < 16; ++r) Gp[r] = 0.f;
#pragma unroll
    for (int ks = 0; ks < 4; ++ks) { const bf16x8 a = *(const LAS bf16x8*)(cYS + l31 * 72 + 16 * ks + 8 * hh), bx = *(const LAS bf16x8*)(cXS + l31 * 72 + 16 * ks + 8 * hh); Gp = MFMA32(a, bx, Gp); }
    f32x16 Dm;
#pragma unroll
    for (int r = 0; r < 16; ++r) Dm[r] = 0.f;
#pragma unroll
    for (int jt = 0; jt < 2; ++jt)
#pragma unroll
        for (int ks = 0; ks < 2; ++ks) { const LAS bf16* ap = cXS + l31 * 72 + 32 * jt + 16 * ks + 4 * hh; const v2u lo = *(const LAS v2u*)ap, hi = *(const LAS v2u*)(ap + 8);
            const v4u av = (v4u){lo[0], lo[1], hi[0], hi[1]};
            const v4u zk = (v4u){CVTPK(Z[jt][8 * ks], Z[jt][8 * ks + 1]), CVTPK(Z[jt][8 * ks + 2], Z[jt][8 * ks + 3]), CVTPK(Z[jt][8 * ks + 4], Z[jt][8 * ks + 5]), CVTPK(Z[jt][8 * ks + 6], Z[jt][8 * ks + 7])};
            Dm = MFMA32(__builtin_bit_cast(bf16x8, av), __builtin_bit_cast(bf16x8, zk), Dm); }
    const int hx = (l31 >> 2) & 1, tx = (l31 & 3) + 4 * (l31 >> 3);
#pragma unroll
    for (int r = 0; r < 16; ++r) Gp[r] = r < tx + hx ? Gp[r] : 0.f;
    if (hh == 0 && hx == 0) {
#pragma unroll
        for (int g = 0; g < 4; ++g) *(LAS f32x4*)(LAB + tx * 16 + 4 * g) = (f32x4){Gp[4 * g], Gp[4 * g + 1], Gp[4 * g + 2], Gp[4 * g + 3]}; }
    bf16x8 Ag[2];
#pragma unroll
    for (int ks = 0; ks < 2; ++ks) { const v4u pk = (v4u){CVTPK(Gp[8 * ks], Gp[8 * ks + 1]), CVTPK(Gp[8 * ks + 2], Gp[8 * ks + 3]), CVTPK(Gp[8 * ks + 4], Gp[8 * ks + 5]), CVTPK(Gp[8 * ks + 6], Gp[8 * ks + 7])}; Ag[ks] = __builtin_bit_cast(bf16x8, pk); }
    bf16x8 Vf[2];
#pragma unroll
    for (int ks = 0; ks < 2; ++ks) { const v4u vz = *(const LAS v4u*)(cVT + icol * 24 + 8 * ks); Vf[ks] = __builtin_bit_cast(bf16x8, hh ? vz : (v4u){0u, 0u, 0u, 0u}); }
#pragma unroll
    for (int ks = 0; ks < 2; ++ks) Dm = MFMA32(Ag[ks], Vf[ks], Dm);
    LDS_WAIT();
    float u[16];
#pragma unroll
    for (int t = 0; t < 16; ++t) { float acc_ = Dm[t];
#pragma unroll
        for (int g = 0; g < 4; ++g) if (4 * g < t) { const f32x4 lv = *(const LAS f32x4*)(LAB + t * 16 + 4 * g);
#pragma unroll
            for (int c = 0; c < 4; ++c) if (4 * g + c < t) acc_ += lv[c] * u[4 * g + c]; }
        u[t] = acc_; }
    bf16x8 Uf[2];
#pragma unroll
    for (int ks = 0; ks < 2; ++ks) { const v4u pk = (v4u){CVTPK(u[8 * ks], u[8 * ks + 1]), CVTPK(u[8 * ks + 2], u[8 * ks + 3]), CVTPK(u[8 * ks + 4], u[8 * ks + 5]), CVTPK(u[8 * ks + 6], u[8 * ks + 7])};
        Uf[ks] = __builtin_bit_cast(bf16x8, hh ? (v4u){0u, 0u, 0u, 0u} : pk); }
#pragma unroll
    for (int ks = 0; ks < 2; ++ks) Dm = MFMA32(Ag[ks], Uf[ks], Dm);
    { bf16* YO = (bf16*)(A.ws + (d ? WS_YB : WS_YF));
        if (hh) {
#pragma unroll
            for (int r = 0; r < 16; ++r) { const int s = 16 * ch + r, t = d ? T - 1 - s : s; YO[((size_t)row0 + t) * 1024 + h * 64 + icol] = (bf16)f2bf(Dm[r]); } } }
#pragma unroll
    for (int ks = 0; ks < 2; ++ks) { const v4u uu = __builtin_bit_cast(v4u, Uf[ks]), vv = __builtin_bit_cast(v4u, Vf[ks]); Uf[ks] = __builtin_bit_cast(bf16x8, hh ? vv : uu); }
#pragma unroll
    for (int jt = 0; jt < 2; ++jt) {
#pragma unroll
        for (int ks = 0; ks < 2; ++ks) { const bf16x8 a = *(const LAS bf16x8*)(cYT + (32 * jt + l31) * 40 + 16 * hh + 8 * ks); Z[jt] = MFMA32(a, Uf[ks], Z[jt]); }
#pragma unroll
        for (int g = 0; g < 4; ++g) { const f32x4 dc = *(const LAS f32x4*)(cGC + 32 * jt + 8 * g + 4 * hh);
#pragma unroll
            for (int c = 0; c < 4; ++c) Z[jt][4 * g + c] *= dc[c]; } }
    if (c_it == 0 && lane < 16) { const int s = 16 * ch + lane, t = d ? T - 1 - s : s; float* BON = (float*)(A.ws + WS_BONUS);
        BON[(((size_t)row0 + t) * 16 + h) * 2 + d] = bonl[lane] + bonl[16 + lane]; }
}

FORCEINLINE RwItem rw_item(bool smp, int idx) { RwItem it; it.b = idx >> 5; it.h = (idx >> 1) & 15; it.d = idx & 1; it.T = smp ? 1024 : 256; it.row0 = smp ? MP + it.b * 1024 : it.b * 256; return it; }

FORCEINLINE void rw_consts(const Args& A, const RwItem it, int sub, int lane, bf16x8 (&Bw)[2][2], bf16x8 (&Ba)[2][2], float (&w0v)[2], float (&a0v)[2], float (&kav)[2], float (&rkv)[2], float (&kkw)[4]) {
    const int j16 = lane & 15, q = lane >> 4;
#pragma unroll
    for (int n = 0; n < 2; ++n) { const int jc = 32 * sub + 16 * n + j16, hj = it.h * 64 + jc;
#pragma unroll
        for (int ks = 0; ks < 2; ++ks) { v4u pw_, pa_;
#pragma unroll
            for (int u = 0; u < 4; ++u) { const int m = 32 * ks + 8 * q + 2 * u;
                pw_[u] = CVTPK(A.in[I_W2][((size_t)it.d * 64 + m) * 1024 + hj], A.in[I_W2][((size_t)it.d * 64 + m + 1) * 1024 + hj]);
                pa_[u] = CVTPK(A.in[I_A2][((size_t)it.d * 64 + m) * 1024 + hj], A.in[I_A2][((size_t)it.d * 64 + m + 1) * 1024 + hj]); }
            Bw[n][ks] = __builtin_bit_cast(bf16x8, pw_); Ba[n][ks] = __builtin_bit_cast(bf16x8, pa_); }
        w0v[n] = A.in[I_W0][it.d * 1024 + hj]; a0v[n] = A.in[I_A0][it.d * 1024 + hj]; kav[n] = A.in[I_KA][it.d * 1024 + hj]; rkv[n] = A.in[I_RK][(it.d * 16 + it.h) * 64 + jc]; }
#pragma unroll
    for (int n2 = 0; n2 < 4; ++n2) kkw[n2] = A.in[I_KK][it.d * 1024 + it.h * 64 + 16 * n2 + j16];
}

FORCEINLINE void phase_rwkv_chunk(const Args& A, LAS unsigned char* lds, int tid, int blk) {
    const int lane = tid & 63, wave = RFL(tid >> 6), l31 = lane & 31, hh = lane >> 5, j16 = lane & 15, q = lane >> 4;
    const int sel = (wave >> 1) & 1, sub = wave & 1;
    LAS float* LAB = (LAS float*)(lds + RW_LAB) + (wave & 3) * 256;
    LAS float* BONL = (LAS float*)(lds + RW_BONL);
    BAR();
    if (wave >= 4) {
        bf16x8 Bw[2][2], Ba[2][2]; float w0v[2] = {0.f, 0.f}, a0v[2] = {0.f, 0.f}, kav[2] = {0.f, 0.f}, rkv[2] = {0.f, 0.f}, kkw[4] = {0.f, 0.f, 0.f, 0.f};
        RwRaw rawA, rawB;
        { const bool smp = sel == 0; rwkv_prep_load(A, rawA, rw_item(smp, smp ? blk : blk * 4), 0, sub, lane); }
#define RW_PREP_ROUND(RD, CUR, NXT) do { const int rd = (RD); const bool smp = sel == 0; const RwItem it = rw_item(smp, smp ? blk : blk * 4 + (rd >> 4)); \
            if (smp ? rd == 0 : (rd & 15) == 0) rw_consts(A, it, sub, lane, Bw, Ba, w0v, a0v, kav, rkv, kkw); \
            if (rd + 1 < 64) { const int r1 = rd + 1; rwkv_prep_load(A, NXT, rw_item(smp, smp ? blk : blk * 4 + (r1 >> 4)), smp ? r1 : (r1 & 15), sub, lane); } \
            RW_PREP_TWICE(rd, CUR) \
            rwkv_prep(lds + (sel * 2 + (rd & 1)) * RW_SET, BONL + ((rd & 1) * 2 + sel) * 32, CUR, sub, lane, Bw, Ba, w0v, a0v, kav, rkv, kkw); \
            BAR_LDS(); } while (0)
#if defined(PROBE_RW) && PROBE_RW == 1
#define RW_PREP_TWICE(rd, CUR) rwkv_prep(lds + (sel * 2 + (rd & 1)) * RW_SET, BONL + ((rd & 1) * 2 + sel) * 32, CUR, sub, lane, Bw, Ba, w0v, a0v, kav, rkv, kkw); asm volatile("" ::: "memory");
#else
#define RW_PREP_TWICE(rd, CUR)
#endif
        for (int rd2 = 0; rd2 < 64; rd2 += 2) { RW_PREP_ROUND(rd2, rawA, rawB); RW_PREP_ROUND(rd2 + 1, rawB, rawA); }
        BAR_LDS();
#undef RW_PREP_ROUND
#undef RW_PREP_TWICE
    } else {
        f32x16 Z[2];
#pragma unroll
        for (int r = 0; r < 16; ++r) { Z[0][r] = 0.f; Z[1][r] = 0.f; }
        BAR_LDS();
        for (int rd = 0; rd < 64; ++rd) {
            const bool smp = sel == 0; const RwItem it = rw_item(smp, smp ? blk : blk * 4 + (rd >> 4)); const int ch = smp ? rd : (rd & 15);
            const int icol = 32 * sub + l31;
            if (smp ? rd == 0 : (rd & 15) == 0) {
                if (smp) { const float* sp = A.in[I_SR] + ((((size_t)it.b * 2 + it.d) * 16 + it.h) * 64 + icol) * 64;
#pragma unroll
                    for (int jt = 0; jt < 2; ++jt)
#pragma unroll
                        for (int g = 0; g < 4; ++g) { const f32x4 v = *(const f32x4*)(sp + 32 * jt + 8 * g + 4 * hh); Z[jt][4 * g] = v[0]; Z[jt][4 * g + 1] = v[1]; Z[jt][4 * g + 2] = v[2]; Z[jt][4 * g + 3] = v[3]; } }
                else {
#pragma unroll
                    for (int r = 0; r < 16; ++r) { Z[0][r] = 0.f; Z[1][r] = 0.f; } }
            }
#if defined(PROBE_RW) && PROBE_RW == 2
            { f32x16 Zs[2] = {Z[0], Z[1]}; rwkv_core(A, lds + (sel * 2 + (rd & 1)) * RW_SET, LAB, BONL + ((rd & 1) * 2 + sel) * 32, Z, it, ch, sub, lane); asm volatile("" ::: "memory"); Z[0] = Zs[0]; Z[1] = Zs[1]; }
#endif
            rwkv_core(A, lds + (sel * 2 + (rd & 1)) * RW_SET, LAB, BONL + ((rd & 1) * 2 + sel) * 32, Z, it, ch, sub, lane);
            if (!smp && (rd & 15) == 15) { float* dp = A.out + OUT_SR + ((((size_t)it.b * 2 + it.d) * 16 + it.h) * 64 + icol) * 64;
#pragma unroll
                for (int jt = 0; jt < 2; ++jt)
#pragma unroll
                    for (int g = 0; g < 4; ++g) *(f32x4*)(dp + 32 * jt + 8 * g + 4 * hh) = (f32x4){Z[jt][4 * g], Z[jt][4 * g + 1], Z[jt][4 * g + 2], Z[jt][4 * g + 3]}; }
            BAR_LDS();
        }
    }
}
__device__ __forceinline__ void tr_item(const float* W, int N, bf16* WT, int ldo, int row_off, int col_off, const float* mu, int mode, LAS float* scr, int item, int lane) {
    const int nblk = N / 32, kb = item / nblk, nb = item % nblk, k0 = 64 * kb, n0 = 32 * nb;
#pragma unroll 8
    for (int i = 0; i < 32; ++i) { const int kk = 2 * i + (lane >> 5); float s = 1.f; if (mode) { const float m_ = mu[k0 + kk]; s = mode == 1 ? 1.f - m_ : m_; }
        scr[kk * 33 + (lane & 31)] = W[(size_t)(k0 + kk) * N + n0 + (lane & 31)] * s; }
    LDS_WAIT(); asm volatile("" ::: "memory");
    const int c = lane & 7;
#pragma unroll
    for (int j = 0; j < 4; ++j) { const int n = (lane >> 3) + 8 * j; const LAS float* s = scr + (8 * c) * 33 + n;
        v4u o; o.x = pk2(s[0 * 33], s[1 * 33]); o.y = pk2(s[2 * 33], s[3 * 33]); o.z = pk2(s[4 * 33], s[5 * 33]); o.w = pk2(s[6 * 33], s[7 * 33]);
        *(v4u*)(WT + (size_t)(row_off + n0 + n) * ldo + col_off + k0 + 8 * c) = o; }
    LDS_WAIT(); asm volatile("" ::: "memory");
}
__device__ __forceinline__ void phase0(const Args& A, LAS unsigned char* lds, int tid, int lane, int wave) {
    __syncthreads();
    unsigned char* ws = A.ws;
    const int G = gridDim.x, blk = blockIdx.x;
    {
        LAS float* scond = (LAS float*)lds;
        LAS float* red = scond + 9 * 1024;
        bool filled = false;
        for (int item = blk; item < 96; item += G) {
            if (!filled) {
                for (int idx = tid; idx < 9 * 1024; idx += NTHR) { const int r = idx >> 10, k = idx & 1023; const float c = r == 0 ? A.in[I_CCTX][k] : A.in[I_C][(r - 1) * 1024 + k]; scond[idx] = silu_f(c); }
                filled = true;
            }
            __syncthreads();
            const int l = item / 48, g = item % 48, col = g * 64 + lane;
            float acc[9];
#pragma unroll
            for (int r = 0; r < 9; ++r) acc[r] = 0.f;
            const float* wp = A.in[I_WMOD] + ((size_t)l * 1024 + wave * 128) * 3072 + col;
#pragma unroll 4
            for (int k = 0; k < 128; ++k) { const float wv = wp[(size_t)k * 3072];
#pragma unroll
                for (int r = 0; r < 9; ++r) acc[r] += scond[r * 1024 + wave * 128 + k] * wv; }
#pragma unroll
            for (int r = 0; r < 9; ++r) red[(wave * 9 + r) * 64 + lane] = acc[r];
            __syncthreads();
            for (int idx = tid; idx < 576; idx += NTHR) { const int r = idx >> 6, ln = idx & 63; float s = A.in[I_BMOD][l * 3072 + g * 64 + ln];
#pragma unroll
                for (int w = 0; w < 8; ++w) s += red[(w * 9 + r) * 64 + ln];
                ((float*)(ws + WS_MOD))[(l * 9 + r) * 3072 + g * 64 + ln] = s; }
            __syncthreads();
        }
        __syncthreads();
    }
    LAS float* scr = (LAS float*)(lds + wave * 16384);
    const int gw = blk * NWAVES + wave, NGW = G * NWAVES;
    bf16* WIN = (bf16*)(ws + WS_WIN); bf16* WO0 = (bf16*)(ws + WS_WO0); bf16* W4 = (bf16*)(ws + WS_W4); bf16* WO1 = (bf16*)(ws + WS_WO1);
    constexpr int I_IN = 16 * 96, I_SQ = 16 * 32, I_LR = 16 * 2;
    constexpr int NITEMS = I_IN + I_SQ + 8 * I_SQ + 8 * I_LR + I_SQ;
    for (int it = gw; it < NITEMS; it += NGW) {
        int r = it;
        if (r < I_IN) { tr_item(A.in[I_GWIN], 3072, WIN, 1024, 0, 0, nullptr, 0, scr, r, lane); continue; } r -= I_IN;
        if (r < I_SQ) { tr_item(A.in[I_GWOUT], 1024, WO0, 1024, 0, 0, nullptr, 0, scr, r, lane); continue; } r -= I_SQ;
        if (r < 8 * I_SQ) { const int p = r / (2 * I_SQ), hf = (r / I_SQ) & 1; tr_item(A.in[I_WRKVG] + (size_t)p * 1024 * 1024, 1024, W4, 2048, p * 1024, hf * 1024, A.in[I_MU] + p * 1024, 1 + hf, scr, r % I_SQ, lane); continue; } r -= 8 * I_SQ;
        if (r < 8 * I_LR) { const int q = r / I_LR, which = q >> 2, d = (q >> 1) & 1, hf = q & 1;
            tr_item((which ? A.in[I_A1] : A.in[I_W1]) + (size_t)d * 1024 * 64, 64, W4, 2048, 4096 + which * 128 + d * 64, hf * 1024, A.in[I_MU] + (4 + which) * 1024, 1 + hf, scr, r % I_LR, lane); continue; } r -= 8 * I_LR;
        tr_item(A.in[I_RWOUT], 1024, WO1, 1024, 0, 0, nullptr, 0, scr, r, lane);
    }
    const int gt = blk * NTHR + tid, NGT = G * NTHR;
    for (int idx = gt; idx < 2 * 16 * 1024; idx += NGT) { const int k = idx & 1023, j = (idx >> 10) & 15, d = idx >> 14;
        WIN[(size_t)(3072 + d * 16 + j) * 1024 + k] = (bf16)f2bf(A.in[I_GWA1][((size_t)d * 1024 + k) * 16 + j]); }
    for (int idx = gt; idx < 224 * 1024 / 8; idx += NGT) ((v4u*)(WIN + (size_t)3104 * 1024))[idx] = (v4u){0u, 0u, 0u, 0u};
}

__device__ __forceinline__ const float* xrow_in(const Args& A, int r) { return r < MP ? A.in[I_XP] + (size_t)r * D : A.in[I_XS] + (size_t)(r - MP) * D; }
__device__ __forceinline__ int cond_of(int r) { return r < MP ? 0 : 1 + ((r - MP) >> 10); }
__device__ __forceinline__ void store_bf4(bf16* p, f32x4 v) { *(unsigned long long*)p = (unsigned long long)pk2(v[0], v[1]) | ((unsigned long long)pk2(v[2], v[3]) << 32); }
__device__ __forceinline__ f32x4 load_bf4(const bf16* p) { const unsigned long long w = *(const unsigned long long*)p; const unsigned lo = (unsigned)w, hi = (unsigned)(w >> 32);
    return (f32x4){__uint_as_float(lo << 16), __uint_as_float(lo & 0xffff0000u), __uint_as_float(hi << 16), __uint_as_float(hi & 0xffff0000u)}; }

__device__ __forceinline__ void phase_h0(const Args& A, int lane, int gw, int NGW) {
    const float* MOD = (const float*)(A.ws + WS_MOD); bf16* XN = (bf16*)(A.ws + WS_ABUF); const float* nw = A.in[I_NORMW];
    for (int r = gw; r < M; r += NGW) {
        const f32x4* xr = (const f32x4*)xrow_in(A, r) + lane;
        f32x4 v[4]; float s = 0.f;
#pragma unroll
        for (int j = 0; j < 4; ++j) { v[j] = xr[64 * j]; s += (v[j][0] * v[j][0] + v[j][1] * v[j][1]) + (v[j][2] * v[j][2] + v[j][3] * v[j][3]); }
        const float rstd = 1.f / sqrtf(wave_sum(s) * (1.f / D) + EPS);
        const float* md = MOD + cond_of(r) * 3072;
#pragma unroll
        for (int j = 0; j < 4; ++j) { const int c = 256 * j + 4 * lane; const f32x4 w = *(const f32x4*)(nw + c), sh = *(const f32x4*)(md + c), sc = *(const f32x4*)(md + 1024 + c);
            store_bf4(XN + (size_t)r * D + c, (v[j] * rstd) * w * (sc + 1.f) + sh); }
    }
}
__device__ __forceinline__ void phase_og0(const Args& A, int lane, int gw, int NGW) {
    const bf16* OF = (const bf16*)(A.ws + WS_OF); const bf16* OB = (const bf16*)(A.ws + WS_OB); const bf16* G0 = (const bf16*)(A.ws + WS_G0); bf16* OG = (bf16*)(A.ws + WS_ABUF);
    const f32x4 wn = *(const f32x4*)(A.in[I_GNORM] + 4 * lane);
    for (int r = gw; r < M; r += NGW) {
#pragma unroll
        for (int j = 0; j < 4; ++j) { const size_t o = (size_t)r * D + 256 * j + 4 * lane; const f32x4 v = load_bf4(OF + o) + load_bf4(OB + o);
            const float ms = wave_sum((v[0] * v[0] + v[1] * v[1]) + (v[2] * v[2] + v[3] * v[3])) * (1.f / 256.f); const float rs = 1.f / sqrtf(ms + EPS);
            const f32x4 g = load_bf4(G0 + o); f32x4 y = v * rs * wn;
            y[0] *= silu_f(g[0]); y[1] *= silu_f(g[1]); y[2] *= silu_f(g[2]); y[3] *= silu_f(g[3]);
            store_bf4(OG + o, y); }
    }
}
__device__ __forceinline__ float row_rstd(const float* ssq, int r, int lane) { float s = lane < 16 ? ssq[(size_t)r * 16 + lane] : 0.f; return 1.f / sqrtf(wave_sum(s) * (1.f / D) + EPS); }
__device__ __forceinline__ void phase_hh(const Args& A, int lane, int gw, int NGW) {
    const float* MOD = (const float*)(A.ws + WS_MOD) + 9 * 3072; const float* ssq = (const float*)(A.ws + WS_SSQ1); bf16* HH = (bf16*)(A.ws + WS_HH); const float* nw = A.in[I_NORMW] + 1024; const float* X1 = A.out;
    for (int r = gw; r < M; r += NGW) {
        const float* md = MOD + cond_of(r) * 3072;
        int n0, n1, n2, n3; bool v0, v1, v2, v3; float wgt;
        if (r < MP) { const int t = r & 255; wgt = 0.5f; n0 = r - 1; v0 = t > 0; n1 = r + 1; v1 = t < 255; n2 = r; v2 = false; n3 = r; v3 = false; }
        else { const int t = (r - MP) & 1023, gr = t >> 6, gc = t & 63; wgt = 0.25f; n0 = r - 64; v0 = gr > 0; n1 = r + 64; v1 = gr < 15; n2 = r - 1; v2 = gc > 0; n3 = r + 1; v3 = gc < 63; }
        const int cnt = (int)v0 + (int)v1 + (int)v2 + (int)v3;
        const float rs = row_rstd(ssq, r, lane);
        f32x4 acc[4];
#pragma unroll
        for (int j = 0; j < 4; ++j) acc[j] = (f32x4){0.f, 0.f, 0.f, 0.f};
#pragma unroll
        for (int q = 0; q < 4; ++q) { const int n = q == 0 ? n0 : q == 1 ? n1 : q == 2 ? n2 : n3; const bool vld = q == 0 ? v0 : q == 1 ? v1 : q == 2 ? v2 : v3;
            if (vld) { const float rn = row_rstd(ssq, n, lane); const f32x4* xp = (const f32x4*)(X1 + (size_t)n * D) + lane;
#pragma unroll
                for (int j = 0; j < 4; ++j) acc[j] += xp[64 * j] * rn; } }
        const f32x4* xr = (const f32x4*)(X1 + (size_t)r * D) + lane;
#pragma unroll
        for (int j = 0; j < 4; ++j) { const int c = 256 * j + 4 * lane; const f32x4 w = *(const f32x4*)(nw + c), sh = *(const f32x4*)(md + c), sc = *(const f32x4*)(md + 1024 + c); const f32x4 cc = w * (sc + 1.f);
            store_bf4(HH + (size_t)r * 2048 + c, (xr[64 * j] * rs) * cc + sh);
            store_bf4(HH + (size_t)r * 2048 + 1024 + c, (acc[j] * cc + sh * (float)cnt) * wgt); }
    }
}
__device__ __forceinline__ void phase_og1(const Args& A, int lane, int gw, int NGW) {
    const bf16* YF = (const bf16*)(A.ws + WS_YF); const bf16* YB = (const bf16*)(A.ws + WS_YB); const bf16* V1 = (const bf16*)(A.ws + WS_V1); const bf16* G1 = (const bf16*)(A.ws + WS_G1);
    const float* BON = (const float*)(A.ws + WS_BONUS); bf16* OG = (bf16*)(A.ws + WS_OG1);
    for (int r = gw; r < M; r += NGW) {
#pragma unroll
        for (int j = 0; j < 4; ++j) { const int c = 256 * j + 4 * lane, h = c >> 6; const size_t o = (size_t)r * D + c; const f32x4 y = load_bf4(YF + o) + load_bf4(YB + o);
            float s = (y[0] + y[1]) + (y[2] + y[3]);
            s += __shfl_xor(s, 1); s += __shfl_xor(s, 2); s += __shfl_xor(s, 4); s += __shfl_xor(s, 8);
            const float mean = s * (1.f / 64.f); const f32x4 dv = y - mean; float q = (dv[0] * dv[0] + dv[1] * dv[1]) + (dv[2] * dv[2] + dv[3] * dv[3]);
            q += __shfl_xor(q, 1); q += __shfl_xor(q, 2); q += __shfl_xor(q, 4); q += __shfl_xor(q, 8);
            const float rs = 1.f / sqrtf(q * (1.f / 64.f) + LNX_EPS);
            const f32x4 lw = *(const f32x4*)(A.in[I_LNW] + c), lb = *(const f32x4*)(A.in[I_LNB] + c);
            const float bon = BON[((size_t)r * 16 + h) * 2] + BON[((size_t)r * 16 + h) * 2 + 1];
            const f32x4 v = load_bf4(V1 + o), g = load_bf4(G1 + o);
            f32x4 z = dv * rs * lw + lb + v * bon;
            z[0] *= silu_f(g[0]); z[1] *= silu_f(g[1]); z[2] *= silu_f(g[2]); z[3] *= silu_f(g[3]);
            store_bf4(OG + o, z); }
    }
}
__device__ __forceinline__ void phase_final(const Args& A, int lane, int gw, int NGW) {
    const float* ssq = (const float*)(A.ws + WS_SSQ2); const float* nf = A.in[I_NORMF];
    for (int r = gw; r < M; r += NGW) {
        const float rs = row_rstd(ssq, r, lane); f32x4* xr = (f32x4*)(A.out + (size_t)r * D) + lane;
#pragma unroll
        for (int j = 0; j < 4; ++j) { const f32x4 w = *(const f32x4*)(nf + 256 * j + 4 * lane); xr[64 * j] = xr[64 * j] * rs * w; }
    }
}

__global__ void __launch_bounds__(NTHR, 2) trunk_fwd(Args args) {
    extern __shared__ __attribute__((aligned(16))) unsigned char lds_raw[];
    LAS unsigned char* lds = (LAS unsigned char*)lds_raw;
    const int tid = threadIdx.x, lane = tid & 63, wave = __builtin_amdgcn_readfirstlane(tid >> 6);
    const int G = gridDim.x, gw = blockIdx.x * NWAVES + wave, NGW = G * NWAVES;
    volatile LAS unsigned* MISC = (volatile LAS unsigned*)(lds + MISC_OFF);
    for (int u = tid; u < (LDS_BYTES - LDSCTL_OFF) / 4; u += NTHR) ((LAS unsigned*)(lds + LDSCTL_OFF))[u] = 0u;
    __syncthreads();
    unsigned char* ws = args.ws;
    XcdBarrier bar; bar.bar = (unsigned*)(ws + WS_CTL) + CW_BAR; bar.x = 0; bar.st = nullptr;
    if (N_LAUNCHES == 1) bar = xcd_barrier_post((unsigned*)(ws + WS_CTL) + CW_BAR, MISC + 8);
    const int lo = args.ph_lo, hi = args.ph_hi;
#ifndef PROBE_MASK
#define PROBE_MASK 0
#endif
#define REP(k) for (int rep_ = 0; rep_ < (((PROBE_MASK) >> (k)) & 1) + 1; ++rep_)
#define IN(k) (lo <= (k) && (k) < hi)
#define SEAM(k) do { if (IN(k) && IN((k) + 1)) xcd_barrier(bar); } while (0)
    if (IN(0)) REP(0) { phase0(args, lds, tid, lane, wave); } SEAM(0);
    if (IN(1)) REP(1) { phase_h0(args, lane, gw, NGW); } SEAM(1);
    if (IN(2)) REP(2) {
        pg8::Gemm g{(const pg8::bf16_t*)(ws + WS_ABUF), (const pg8::bf16_t*)(ws + WS_WIN), M, 3328, 1024}; pg8::StaticOrder S; S.init(M, 3328, G, (int)blockIdx.x);
        pg8::EpiPlanes<0> E{ws};
        pg8::gemm_phase<pg8::EpiPlanes<0>, pg8::StaticOrder, true, true>(lds, g, S, E);
    } SEAM(2);
        if (IN(3)) REP(3) { phase_gla_chunk(args, lds, tid, (int)blockIdx.x); } SEAM(3);
    if (IN(4)) REP(4) { phase_og0(args, lane, gw, NGW); } SEAM(4);
    if (IN(5)) REP(5) {
        pg8::Gemm g{(const pg8::bf16_t*)(ws + WS_ABUF), (const pg8::bf16_t*)(ws + WS_WO0), M, 1024, 1024}; pg8::StaticOrder S; S.init(M, 1024, G, (int)blockIdx.x);
        pg8::EpiRes E{args.in[I_XP], args.in[I_XS], args.out, (const float*)(ws + WS_MOD) + 2048, (float*)(ws + WS_SSQ1)};
        pg8::gemm_phase<pg8::EpiRes, pg8::StaticOrder, true, true>(lds, g, S, E);
    } SEAM(5);
    if (IN(6)) REP(6) { phase_hh(args, lane, gw, NGW); } SEAM(6);
    if (IN(7)) REP(7) {
        pg8::Gemm g{(const pg8::bf16_t*)(ws + WS_HH), (const pg8::bf16_t*)(ws + WS_W4), M, 4352, 2048}; pg8::StaticOrder S; S.init(M, 4352, G, (int)blockIdx.x);
        pg8::EpiPlanes<1> E{ws};
        pg8::gemm_phase<pg8::EpiPlanes<1>, pg8::StaticOrder, true, true>(lds, g, S, E);
    } SEAM(7);
        if (IN(8)) REP(8) { phase_rwkv_chunk(args, lds, tid, (int)blockIdx.x); } SEAM(8);
    if (IN(9)) REP(9) { phase_og1(args, lane, gw, NGW); } SEAM(9);
    if (IN(10)) REP(10) {
        pg8::Gemm g{(const pg8::bf16_t*)(ws + WS_OG1), (const pg8::bf16_t*)(ws + WS_WO1), M, 1024, 1024}; pg8::StaticOrder S; S.init(M, 1024, G, (int)blockIdx.x);
        pg8::EpiRes E{args.out, args.out + OUT_YS, args.out, (const float*)(ws + WS_MOD) + 9 * 3072 + 2048, (float*)(ws + WS_SSQ2)};
        pg8::gemm_phase<pg8::EpiRes, pg8::StaticOrder, true, true>(lds, g, S, E);
    } SEAM(10);
    if (IN(11)) REP(11) { phase_final(args, lane, gw, NGW); }
#undef IN
#undef SEAM
}

extern "C" void kernel_launch(void* const* d_in, const int* in_sizes, int n_in, void* d_out, int out_size, void* d_ws, size_t ws_size, hipStream_t stream) {
    static int grid = 0;
    if (grid == 0) {
        if (n_in != 30 || ws_size < WS_END) { fprintf(stderr, "kernel_launch: built for 30 inputs and >= %zu bytes of workspace; got n_in %d ws %zu\n", (size_t)WS_END, n_in, ws_size); grid = -1; return; }
        int dev = 0, cus = 0, per_cu = 0;
        if (hipGetDevice(&dev) != hipSuccess || hipDeviceGetAttribute(&cus, hipDeviceAttributeMultiprocessorCount, dev) != hipSuccess) { grid = -1; return; }
        if (hipFuncSetAttribute((const void*)trunk_fwd, hipFuncAttributeMaxDynamicSharedMemorySize, LDS_BYTES) != hipSuccess) { fprintf(stderr, "kernel_launch: hipFuncSetAttribute failed\n"); grid = -1; return; }
        if (hipOccupancyMaxActiveBlocksPerMultiprocessor(&per_cu, (const void*)trunk_fwd, NTHR, LDS_BYTES) != hipSuccess || per_cu < 1) { fprintf(stderr, "kernel_launch: occupancy query reports %d workgroups per CU\n", per_cu); per_cu = 1; }
        (void)hipGetLastError();
        grid = cus;
        if (grid > 256) grid = 256;
    }
    if (grid < 0) return;
    (void)hipMemsetAsync((char*)d_ws + WS_CTL, 0, CTL_ZERO_BYTES, stream);
    Args a{};
    for (int i = 0; i < 30; ++i) a.in[i] = (const float*)d_in[i];
    a.out = (float*)d_out; a.ws = (unsigned char*)d_ws;
    if (N_LAUNCHES == 1) {
        a.ph_lo = 0; a.ph_hi = N_PHASES; a.li = 0;
        void* kargs[] = {&a};
        hipError_t e = hipLaunchCooperativeKernel((const void*)trunk_fwd, dim3(grid), dim3(NTHR), kargs, LDS_BYTES, stream);
        if (e != hipSuccess) fprintf(stderr, "kernel_launch: cooperative launch failed: %s (grid %d)\n", hipGetErrorString(e), grid);
    } else {
        for (int li = 0; li < N_PHASES; ++li) { a.ph_lo = li; a.ph_hi = li + 1; a.li = li;
            hipLaunchKernelGGL(trunk_fwd, dim3(grid), dim3(NTHR), LDS_BYTES, stream, a); }
    }
}
```

```cpp
#include <hip/hip_runtime.h>
#include <cstdio>
#include <cstdint>
constexpr int NWAVES = 8, NTHR = 512;
#ifndef MK_N_LAUNCHES
#define MK_N_LAUNCHES 1
#endif
constexpr int N_PHASES = 12;
constexpr int N_LAUNCHES = MK_N_LAUNCHES;
constexpr int M = 16384, D = 1024, MP = 8192;
constexpr float EPS = 1e-6f, LNX_EPS = 64e-5f;
constexpr size_t OUT_YS = (size_t)MP * D, OUT_SG = (size_t)M * D, OUT_SR = OUT_SG + (size_t)32 * 2 * 4 * 128 * 256;
constexpr size_t MiB = 1u << 20;
constexpr size_t WS_CTL = 0, CTL_ZERO_BYTES = 1 * MiB;
constexpr size_t WS_MOD = 1 * MiB;
constexpr size_t WS_SSQ1 = 2 * MiB, WS_SSQ2 = 3 * MiB;
constexpr size_t WS_BONUS = 4 * MiB;
constexpr size_t WS_HA = 6 * MiB;
constexpr size_t WS_WIN = 8 * MiB;
constexpr size_t WS_WO0 = 15 * MiB;
constexpr size_t WS_W4 = 17 * MiB;
constexpr size_t WS_WO1 = 34 * MiB;
constexpr size_t WS_ABUF = 38 * MiB;
constexpr size_t WS_Q0 = 70 * MiB, WS_K0 = 86 * MiB, WS_V0 = 102 * MiB, WS_G0 = 134 * MiB, WS_OF = 166 * MiB, WS_OB = 198 * MiB;
constexpr size_t WS_HH = 38 * MiB;
constexpr size_t WS_YF = 38 * MiB, WS_YB = 70 * MiB;
constexpr size_t WS_R1 = 102 * MiB, WS_K1 = 134 * MiB, WS_V1 = 166 * MiB, WS_G1 = 198 * MiB;
constexpr size_t WS_LWA = 230 * MiB;
constexpr size_t WS_OG1 = 102 * MiB;
constexpr size_t WS_END = 246 * MiB;
constexpr int CW_BAR = 4096;
constexpr int RING_BYTES = 131072, LDSCTL_OFF = 146944, MISC_OFF = LDSCTL_OFF + 320, LDS_BYTES = 147456;


struct Args { const float* in[30]; float* out; unsigned char* ws; int ph_lo, ph_hi, li, pad; };
enum { I_XP = 0, I_XS, I_SG, I_SR, I_C, I_CCTX, I_WMOD, I_BMOD, I_NORMW, I_GWIN, I_GWA1, I_GWA2, I_GBA, I_GNORM, I_GWOUT, I_MU, I_WRKVG, I_W0, I_W1, I_W2, I_A0, I_A1, I_A2, I_KK, I_KA, I_RK, I_LNW, I_LNB, I_RWOUT, I_NORMF };

namespace pg8 {
#define PG8_LAS __attribute__((address_space(3)))
typedef unsigned short bf16_t;
typedef short bf16x8 __attribute__((ext_vector_type(8)));
typedef float f32x4 __attribute__((ext_vector_type(4)));
typedef unsigned u32x4 __attribute__((ext_vector_type(4)));
constexpr int BM = 256, BK = 64, HALF = 128, HTB = HALF * BK * 2  , STAGE_BYTES = 8 * HTB, NXCD = 8, WGM = 8;

__host__ __device__ __forceinline__ int lds_byte(int r, int c) { const int st = (r >> 4) * 2 + (c >> 5), rr = r & 15, cc = c & 31, ob = rr * 64 + cc * 2; return st * 1024 + (ob ^ (((ob >> 9) & 1) << 5)); }
__host__ __device__ __forceinline__ void stage_rc(int b, int& R, int& C) { const int st = b / 1024, sb = b % 1024, swz = sb ^ (((sb >> 9) & 1) << 5); R = (st >> 1) * 16 + swz / 64; C = (st & 1) * 32 + (swz % 64) / 2; }
__host__ __device__ __forceinline__ int perm32(int rho) { const int n = rho >> 4, i = rho & 15; return 8 * (i >> 2) + 4 * n + (i & 3); }

struct Unit { int pm, pn; };
struct Gemm { const bf16_t* A; const bf16_t* Bt; int M, N, K; };

struct StaticOrder {
    int nM, nN, nwg, G, c;
    __host__ __device__ void init(int M, int N, int G_, int c_) { nM = M / BM; nN = N / BM; nwg = nM * nN; G = G_; c = c_; }
    __host__ __device__ bool next(int i, Unit& u) const {
        const long L = (long)i * G + c; if (L >= nwg) return false;
        int wgid = (int)L; { const int q = nwg / NXCD, r = nwg % NXCD, xcd = wgid % NXCD, off = wgid / NXCD; wgid = (xcd < r ? xcd * (q + 1) : r * (q + 1) + (xcd - r) * q) + off; }
        const int nig = WGM * nN, gid = wgid / nig, fm = gid * WGM, gsz = (nM - fm) < WGM ? (nM - fm) : WGM;
        u.pm = fm + ((wgid % nig) % gsz); u.pn = (wgid % nig) / gsz; return true;
    }
    __device__ __forceinline__ void a_ready(const Unit&) const {}
    __device__ __forceinline__ void done(const Unit&) const {}
};

__device__ __forceinline__ unsigned cvt_pk_bf16(float lo, float hi) { unsigned r; asm volatile("v_cvt_pk_bf16_f32 %0, %1, %2" : "=v"(r) : "v"(lo), "v"(hi)); return r; }
template <int L> struct EpiPlanes {
    static constexpr bool PERM = true, AFTER_DRAIN = false;
    unsigned char* ws;
    __device__ __forceinline__ void operator()(const f32x4 (&acc)[2][2][4][2], const Unit& u, int wr, int wc, int fr, int fq) const {
        constexpr int T1 = L ? 4 : 2, T2 = L ? 8 : 4, T3 = L ? 12 : 8, T4 = L ? 16 : 12, LRC = L ? 256 : 32, LRLD = L ? 256 : 32;
        constexpr size_t O0 = L ? WS_R1 : WS_Q0, O1 = L ? WS_K1 : WS_K0, O2 = L ? WS_V1 : WS_V0, O3 = L ? WS_G1 : WS_G0, OLR = L ? WS_LWA : WS_HA;
        constexpr int LD01 = L ? 1024 : 512;
        const int row0 = u.pm * BM + wr * 64 + fr;
        if (u.pn >= T4) {
            if constexpr (L == 0) {
                float* lr = (float*)(ws + OLR);
#pragma unroll
                for (int ai = 0; ai < 2; ++ai)
#pragma unroll
                    for (int m = 0; m < 4; ++m) { float* rowp = lr + (size_t)(row0 + ai * HALF + m * 16) * LRLD;
#pragma unroll
                        for (int bj = 0; bj < 2; ++bj)
#pragma unroll
                            for (int n = 0; n < 2; ++n) { const int col = bj * HALF + wc * 32 + 8 * fq + 4 * n; if (col < LRC) *(f32x4*)(rowp + col) = acc[ai][bj][m][n]; } }
            } else {
                bf16_t* lr = (bf16_t*)(ws + OLR);
#pragma unroll
                for (int ai = 0; ai < 2; ++ai)
#pragma unroll
                    for (int m = 0; m < 4; ++m) { bf16_t* rowp = lr + (size_t)(row0 + ai * HALF + m * 16) * 256 + wc * 32 + 8 * fq;
#pragma unroll
                        for (int bj = 0; bj < 2; ++bj) { f32x4 v0 = acc[ai][bj][m][0], v1 = acc[ai][bj][m][1];
                            if (bj == 0) {
#pragma unroll
                                for (int c = 0; c < 4; ++c) { v0[c] = 1.f - 2.f * __builtin_amdgcn_rcpf(1.f + __expf(2.f * v0[c])); v1[c] = 1.f - 2.f * __builtin_amdgcn_rcpf(1.f + __expf(2.f * v1[c])); } }
                            u32x4 w; w.x = cvt_pk_bf16(v0[0], v0[1]); w.y = cvt_pk_bf16(v0[2], v0[3]); w.z = cvt_pk_bf16(v1[0], v1[1]); w.w = cvt_pk_bf16(v1[2], v1[3]);
                            *(u32x4*)(rowp + bj * HALF) = w; } }
            }
            return;
        }
        const int pn = u.pn;
        const size_t off = pn < T1 ? O0 : pn < T2 ? O1 : pn < T3 ? O2 : O3;
        const int ld = pn < T2 ? LD01 : 1024, ts = pn < T1 ? 0 : pn < T2 ? T1 : pn < T3 ? T2 : T3;
        bf16_t* base = (bf16_t*)(ws + off);
        const int col0 = (pn - ts) * BM + wc * 32 + 8 * fq;
#pragma unroll
        for (int ai = 0; ai < 2; ++ai)
#pragma unroll
            for (int m = 0; m < 4; ++m) { bf16_t* rowp = base + (size_t)(row0 + ai * HALF + m * 16) * ld + col0;
#pragma unroll
                for (int bj = 0; bj < 2; ++bj) { const f32x4 v0 = acc[ai][bj][m][0], v1 = acc[ai][bj][m][1];
                    u32x4 w; w.x = cvt_pk_bf16(v0[0], v0[1]); w.y = cvt_pk_bf16(v0[2], v0[3]); w.z = cvt_pk_bf16(v1[0], v1[1]); w.w = cvt_pk_bf16(v1[2], v1[3]);
                    *(u32x4*)(rowp + bj * HALF) = w; } }
    }
};
struct EpiRes {
    static constexpr bool PERM = false, AFTER_DRAIN = false;
    const float* bp; const float* bs;
    float* out;
    const float* gate;
    float* ssq;
    __device__ __forceinline__ void operator()(const f32x4 (&acc)[2][2][4][2], const Unit& u, int wr, int wc, int fr, int fq) const {
#pragma unroll
        for (int ai = 0; ai < 2; ++ai)
#pragma unroll
            for (int m = 0; m < 4; ++m) {
                const int r = u.pm * BM + ai * HALF + wr * 64 + m * 16 + fr;
                const int ci = r < 8192 ? 0 : 1 + ((r - 8192) >> 10);
                const float* brow = r < 8192 ? bp + (size_t)r * 1024 : bs + (size_t)(r - 8192) * 1024;
                float* orow = out + (size_t)r * 1024; const float* grow = gate + ci * 3072;
                float s = 0.f;
#pragma unroll
                for (int bj = 0; bj < 2; ++bj)
#pragma unroll
                    for (int n = 0; n < 2; ++n) { const int c = u.pn * BM + bj * HALF + wc * 32 + n * 16 + 4 * fq;
                        const f32x4 b = *(const f32x4*)(brow + c), g = *(const f32x4*)(grow + c); const f32x4 o = b + g * acc[ai][bj][m][n];
                        *(f32x4*)(orow + c) = o; s += (o[0] * o[0] + o[1] * o[1]) + (o[2] * o[2] + o[3] * o[3]); }
                s += __shfl_xor(s, 16); s += __shfl_xor(s, 32);
                if (fq == 0) ssq[(size_t)r * 16 + u.pn * 4 + wc] = s;
            }
    }
};

template <class Epi, class Sched, bool ALIGN_EPI = false, bool SP2 = false>
__device__ __forceinline__ void gemm_phase(PG8_LAS unsigned char* lds, const Gemm g, const Sched& S, const Epi& E) {
    const int tid = threadIdx.x, wid = __builtin_amdgcn_readfirstlane(tid >> 6), lane = tid & 63, wr = wid >> 2, wc = wid & 3, fr = lane & 15, fq = lane >> 4;
    const int K = g.K, nt = K / BK;
    unsigned voffA[2], voffB[2];
#pragma unroll
    for (int i = 0; i < 2; ++i) { int R, C; stage_rc(tid * 16 + i * 8192, R, C); const int Rb = Epi::PERM ? ((R & ~31) + perm32(R & 31)) : R;
        voffA[i] = (unsigned)(R * K + C) * 2u; voffB[i] = (unsigned)(Rb * K + C) * 2u; }
    const size_t kstep = (size_t)(BK * 2);
    const size_t hstep = (size_t)HALF * K * 2;
    const size_t tstep = 2 * hstep;
    const unsigned ldsw = (unsigned)wid * 1024u;
    const int aoff = lds_byte(wr * 64 + fr, fq * 8), boff = lds_byte(wc * 32 + fr, fq * 8);
#define PG8_SA(b, h) (((b) * 2 + (h)) * HTB)
#define PG8_SB(b, h) ((4 + (b) * 2 + (h)) * HTB)
#define PG8_STAGE(bufoff, gbase, voff) do { _Pragma("unroll") for (int _i = 0; _i < 2; ++_i) \
        __builtin_amdgcn_global_load_lds((const unsigned*)((const char*)(gbase) + (voff)[_i]), (PG8_LAS unsigned*)(lds + (bufoff) + ldsw + _i * 8192), 16, 0, 0); } while (0)
#define PG8_LDA(dst, b, h) do { _Pragma("unroll") for (int m = 0; m < 4; ++m) _Pragma("unroll") for (int k = 0; k < 2; ++k) dst[m][k] = *(const PG8_LAS bf16x8*)(lds + PG8_SA(b, h) + aoff + m * 2048 + k * 1024); } while (0)
#define PG8_LDB(dst, b, h) do { _Pragma("unroll") for (int n = 0; n < 2; ++n) _Pragma("unroll") for (int k = 0; k < 2; ++k) dst[n][k] = *(const PG8_LAS bf16x8*)(lds + PG8_SB(b, h) + boff + n * 2048 + k * 1024); } while (0)
#define PG8_MMA(ai, bj, At, Bt) do { __builtin_amdgcn_s_setprio(1); _Pragma("unroll") for (int m = 0; m < 4; ++m) _Pragma("unroll") for (int n = 0; n < 2; ++n) _Pragma("unroll") for (int k = 0; k < 2; ++k) \
        acc[ai][bj][m][n] = __builtin_amdgcn_mfma_f32_16x16x32_bf16(Bt[n][k], At[m][k], acc[ai][bj][m][n], 0, 0, 0); __builtin_amdgcn_s_setprio(0); } while (0)
#define PG8_WAIT_V(n) asm volatile("s_waitcnt vmcnt(" #n ")" ::: "memory")
#define PG8_WAIT_L(n) asm volatile("s_waitcnt lgkmcnt(" #n ")" ::: "memory")
#define PG8_BAR __builtin_amdgcn_s_barrier()
#define PG8_SCHED __builtin_amdgcn_sched_barrier(0)
    Unit cur, nxt; int ui = 0;
    if (!S.next(0, cur)) return;
    f32x4 acc[2][2][4][2];
#pragma unroll
    for (int a = 0; a < 2; ++a)
#pragma unroll
        for (int b = 0; b < 2; ++b)
#pragma unroll
            for (int m = 0; m < 4; ++m)
#pragma unroll
                for (int n = 0; n < 2; ++n) acc[a][b][m][n] = (f32x4){0.f, 0.f, 0.f, 0.f};
    bf16x8 At[4][2], B0[2][2], B1[2][2];
    const char* cA = (const char*)g.A + (size_t)cur.pm * tstep; const char* cB = (const char*)g.Bt + (size_t)cur.pn * tstep;
    S.a_ready(cur);
    if constexpr (SP2) {
        PG8_STAGE(PG8_SB(0, 0), cB, voffB); PG8_STAGE(PG8_SB(0, 1), cB + hstep, voffB); PG8_STAGE(PG8_SA(0, 0), cA, voffA); PG8_STAGE(PG8_SA(0, 1), cA + hstep, voffA);
        if (wr == 1) PG8_BAR;
        PG8_WAIT_V(2); PG8_BAR;
        PG8_STAGE(PG8_SB(1, 0), cB + kstep, voffB); PG8_STAGE(PG8_SA(1, 0), cA + kstep, voffA); PG8_STAGE(PG8_SB(1, 1), cB + hstep + kstep, voffB);
        PG8_WAIT_V(6); PG8_BAR;
    } else {
        PG8_STAGE(PG8_SB(0, 0), cB, voffB); PG8_STAGE(PG8_SA(0, 0), cA, voffA); PG8_STAGE(PG8_SB(0, 1), cB + hstep, voffB); PG8_STAGE(PG8_SA(0, 1), cA + hstep, voffA);
        if (wr == 1) PG8_BAR;
        PG8_WAIT_V(4); PG8_BAR;
        PG8_STAGE(PG8_SB(1, 0), cB + kstep, voffB); PG8_STAGE(PG8_SA(1, 0), cA + kstep, voffA); PG8_STAGE(PG8_SB(1, 1), cB + hstep + kstep, voffB);
        PG8_WAIT_V(6); PG8_BAR;
    }
    for (;;) {
        const bool has_next = S.next(ui + 1, nxt);
        const char* nA = has_next ? (const char*)g.A + (size_t)nxt.pm * tstep : cA; const char* nB = has_next ? (const char*)g.Bt + (size_t)nxt.pn * tstep : cB;
        for (int t = 0; t < nt; t += 2) {
            const bool last = (t == nt - 2);
            const char* a1 = cA + (size_t)(t + 1) * kstep;
            const char* a2 = last ? nA : cA + (size_t)(t + 2) * kstep; const char* b2 = last ? nB : cB + (size_t)(t + 2) * kstep;
            const char* a3 = a2 + kstep; const char* b3 = b2 + kstep;
            if (last && has_next) S.a_ready(nxt);
            if constexpr (SP2) {
            PG8_LDB(B0, 0, 0); PG8_LDB(B1, 0, 1); PG8_SCHED; PG8_LDA(At, 0, 0); PG8_STAGE(PG8_SA(1, 1), a1 + hstep, voffA);
            PG8_WAIT_V(8); PG8_WAIT_L(0); PG8_BAR; PG8_MMA(0, 0, At, B0); PG8_MMA(0, 1, At, B1); PG8_BAR; PG8_SCHED;
            PG8_LDA(At, 0, 1); PG8_STAGE(PG8_SB(0, 0), b2, voffB); PG8_STAGE(PG8_SB(0, 1), b2 + hstep, voffB); PG8_STAGE(PG8_SA(0, 0), a2, voffA);
            PG8_WAIT_V(8); PG8_WAIT_L(0); PG8_BAR; PG8_MMA(1, 0, At, B0); PG8_MMA(1, 1, At, B1); PG8_BAR; PG8_SCHED;
            PG8_LDB(B0, 1, 0); PG8_LDB(B1, 1, 1); PG8_SCHED; PG8_LDA(At, 1, 0); PG8_STAGE(PG8_SA(0, 1), a2 + hstep, voffA);
            PG8_WAIT_V(8); PG8_WAIT_L(0); PG8_BAR; PG8_MMA(0, 0, At, B0); PG8_MMA(0, 1, At, B1); PG8_BAR; PG8_SCHED;
            PG8_LDA(At, 1, 1); PG8_STAGE(PG8_SB(1, 0), b3, voffB); PG8_STAGE(PG8_SB(1, 1), b3 + hstep, voffB); PG8_STAGE(PG8_SA(1, 0), a3, voffA);
            PG8_WAIT_V(8); PG8_WAIT_L(0); PG8_BAR; PG8_MMA(1, 0, At, B0); PG8_MMA(1, 1, At, B1); PG8_BAR; PG8_SCHED;
            } else {
            PG8_LDB(B0, 0, 0); PG8_SCHED; PG8_LDA(At, 0, 0); PG8_STAGE(PG8_SA(1, 1), a1 + hstep, voffA);
            PG8_WAIT_L(8); PG8_BAR; PG8_WAIT_L(0); PG8_MMA(0, 0, At, B0); PG8_BAR; PG8_SCHED;
            PG8_LDB(B1, 0, 1); PG8_STAGE(PG8_SB(0, 0), b2, voffB);
            PG8_BAR; PG8_WAIT_L(0); PG8_MMA(0, 1, At, B1); PG8_BAR;
            PG8_LDA(At, 0, 1); PG8_STAGE(PG8_SA(0, 0), a2, voffA);
            PG8_BAR; PG8_WAIT_L(0); PG8_MMA(1, 0, At, B0); PG8_BAR; PG8_SCHED;
            PG8_STAGE(PG8_SB(0, 1), b2 + hstep, voffB);
            PG8_WAIT_V(6); PG8_BAR; PG8_MMA(1, 1, At, B1); PG8_BAR;
            PG8_LDB(B0, 1, 0); PG8_SCHED; PG8_LDA(At, 1, 0); PG8_STAGE(PG8_SA(0, 1), a2 + hstep, voffA);
            PG8_WAIT_L(8); PG8_BAR; PG8_WAIT_L(0); PG8_MMA(0, 0, At, B0); PG8_BAR; PG8_SCHED;
            PG8_LDB(B1, 1, 1); PG8_STAGE(PG8_SB(1, 0), b3, voffB);
            PG8_BAR; PG8_WAIT_L(0); PG8_MMA(0, 1, At, B1); PG8_BAR;
            PG8_LDA(At, 1, 1); PG8_STAGE(PG8_SA(1, 0), a3, voffA);
            PG8_BAR; PG8_WAIT_L(0); PG8_MMA(1, 0, At, B0); PG8_BAR; PG8_SCHED;
            PG8_STAGE(PG8_SB(1, 1), b3 + hstep, voffB);
            PG8_WAIT_V(6); PG8_BAR; PG8_MMA(1, 1, At, B1); PG8_BAR;
            }
        }
        if constexpr (ALIGN_EPI) { if (wr == 0) PG8_BAR; }
        if constexpr (!Epi::AFTER_DRAIN) { E(acc, cur, wr, wc, fr, fq); S.done(cur); }
        if (!has_next) break;
#pragma unroll
        for (int a = 0; a < 2; ++a)
#pragma unroll
            for (int b = 0; b < 2; ++b)
#pragma unroll
                for (int m = 0; m < 4; ++m)
#pragma unroll
                    for (int n = 0; n < 2; ++n) acc[a][b][m][n] = (f32x4){0.f, 0.f, 0.f, 0.f};
        cur = nxt; cA = nA; cB = nB; ++ui;
        if constexpr (ALIGN_EPI) { if (wr == 1) PG8_BAR; }
    }
    PG8_WAIT_V(0);
    if constexpr (!ALIGN_EPI) { if (wr == 0) PG8_BAR; }
    PG8_BAR;
    if constexpr (Epi::AFTER_DRAIN) { E.fused(acc, cur, wr, wc, fr, fq, lds, wid, lane); S.done(cur); }
#undef PG8_SA
#undef PG8_SB
#undef PG8_STAGE
#undef PG8_LDA
#undef PG8_LDB
#undef PG8_MMA
#undef PG8_WAIT_V
#undef PG8_WAIT_L
#undef PG8_BAR
#undef PG8_SCHED
}
}
#define GAS __attribute__((address_space(1)))
#define LAS __attribute__((address_space(3)))
typedef unsigned short bf16;
typedef unsigned v4u __attribute__((ext_vector_type(4)));
typedef float f32x4 __attribute__((ext_vector_type(4)));
typedef short bf16x8 __attribute__((ext_vector_type(8)));
typedef GAS unsigned gu32;
typedef GAS unsigned long long gu64;
#define RLX_AGENT __ATOMIC_RELAXED, __HIP_MEMORY_SCOPE_AGENT
#define LDS_WAIT() asm volatile("s_waitcnt lgkmcnt(0)" ::: "memory")
#define VM_WAIT() asm volatile("s_waitcnt vmcnt(0)" ::: "memory")
__device__ __forceinline__ unsigned long long rt() { return __builtin_amdgcn_s_memrealtime(); }
__device__ __forceinline__ unsigned f2bf(float f) { unsigned u = __builtin_bit_cast(unsigned, f); return (u + 0x7fffu + ((u >> 16) & 1u)) >> 16; }
__device__ __forceinline__ unsigned pk2(float lo, float hi) { return f2bf(lo) | (f2bf(hi) << 16); }

#define XB_TMO      128
#define XB_XCNT(j)  (256  + 64 * (j))
#define XB_XSUB(j)  (1280 + 64 * (j))
#define XB_XGEN(j)  (2304 + 64 * (j))
#define XB_TOP      3328
#define XB_TOPGEN   3392
#define XCD_BAR_WORDS 3456
#define XB_SPIN_CAP (1u << 18)

__device__ __forceinline__ unsigned xb_ld(unsigned* p)              { return __hip_atomic_load(p, __ATOMIC_RELAXED, __HIP_MEMORY_SCOPE_AGENT); }
__device__ __forceinline__ unsigned xb_add(unsigned* p, unsigned v) { return __hip_atomic_fetch_add(p, v, __ATOMIC_RELAXED, __HIP_MEMORY_SCOPE_AGENT); }
__device__ __forceinline__ unsigned xb_xcc_id() { return (unsigned)__builtin_amdgcn_s_getreg((3 << 11) | 20) & 0xFu; }
#define XB_SPIN(cond, bar) do { unsigned _sp = 0; while (cond) { __builtin_amdgcn_s_sleep(1); \
    if ((++_sp & 255u) == 0u) { if (xb_ld(&(bar)[XB_TMO])) break; if (_sp > XB_SPIN_CAP) { atomicAdd(&(bar)[XB_TMO], 1u); break; } } } } while (0)

struct XcdBarrier {
    unsigned* bar; unsigned x;
    volatile LAS unsigned* st;
};

__device__ __forceinline__ XcdBarrier xcd_barrier_post(unsigned* bar, volatile LAS unsigned* st) {
    XcdBarrier b; b.bar = bar; b.x = xb_xcc_id(); b.st = st;
    if (threadIdx.x == 0) (void)xb_add(&bar[XB_XCNT(b.x)], 1u);
    return b;
}
__device__ __forceinline__ void xcd_barrier_complete(unsigned* bar, unsigned x, unsigned& nloc, unsigned& nx) {
    const unsigned G = gridDim.x * gridDim.y * gridDim.z;
    unsigned sum, cnt, mine, sp = 0u;
    for (;;) {
        sum = 0u; cnt = 0u; mine = 0u;
#pragma unroll
        for (unsigned j = 0; j < 16; ++j) { const unsigned c = xb_ld(&bar[XB_XCNT(j)]); sum += c; cnt += (c > 0u) ? 1u : 0u; mine = (j == x) ? c : mine; }
        if (sum == G) break;
        __builtin_amdgcn_s_sleep(1);
        if ((++sp & 255u) == 0u) { if (xb_ld(&bar[XB_TMO])) break; if (sp > XB_SPIN_CAP) { atomicAdd(&bar[XB_TMO], 1u); break; } }
    }
    nloc = mine > 0u ? mine : 1u; nx = cnt > 0u ? cnt : 1u;
}

__device__ __forceinline__ void xcd_barrier(const XcdBarrier& b) {
    asm volatile("s_waitcnt vmcnt(0)" ::: "memory");
    __syncthreads();
    if (threadIdx.x == 0) {
        unsigned* bar = b.bar;
        __builtin_amdgcn_s_waitcnt(0);
        unsigned nloc = b.st[0], nx = b.st[1];
        if (nloc == 0u) { xcd_barrier_complete(bar, b.x, nloc, nx); b.st[0] = nloc; b.st[1] = nx; }
        const unsigned old = xb_add(&bar[XB_XSUB(b.x)], 1u);
        const unsigned gen = old / nloc;
        if (old + 1u == (gen + 1u) * nloc) {
            __builtin_amdgcn_fence(__ATOMIC_RELEASE, "agent");
            asm volatile("s_waitcnt vmcnt(0)" ::: "memory");
            const unsigned og = xb_add(&bar[XB_TOP], 1u);
            const unsigned tg = og / nx;
            if (og + 1u == (tg + 1u) * nx) xb_add(&bar[XB_TOPGEN], 1u);
            else XB_SPIN(xb_ld(&bar[XB_TOPGEN]) == tg, bar);
            __builtin_amdgcn_fence(__ATOMIC_ACQUIRE, "agent");
            xb_add(&bar[XB_XGEN(b.x)], 1u);
            asm volatile("s_waitcnt vmcnt(0)" ::: "memory");
        } else {
            XB_SPIN(xb_ld(&bar[XB_XGEN(b.x)]) == gen, bar);
            __builtin_amdgcn_fence(__ATOMIC_ACQUIRE, "agent");
            asm volatile("s_waitcnt vmcnt(0)" ::: "memory");
        }
    }
    __syncthreads();
}

typedef float f32x16 __attribute__((ext_vector_type(16)));
typedef unsigned v2u __attribute__((ext_vector_type(2)));
#define BAR() __syncthreads()
#define MFMA32(a, b, c) __builtin_amdgcn_mfma_f32_32x32x16_bf16(a, b, c, 0, 0, 0)
#define MFMA16(a, b, c) __builtin_amdgcn_mfma_f32_16x16x32_bf16(a, b, c, 0, 0, 0)
#define SHFLX(v, m) __shfl_xor(v, m)
#define RFL(x) __builtin_amdgcn_readfirstlane(x)
#define FORCEINLINE __device__ __forceinline__
template <int CTRL> __device__ __forceinline__ float dppf(float v) { return __builtin_bit_cast(float, __builtin_amdgcn_update_dpp(0, __builtin_bit_cast(int, v), CTRL, 0xF, 0xF, true)); }
#define RED16(x) do { x += dppf<0xB1>(x); x += dppf<0x4E>(x); x += dppf<0x141>(x); x += dppf<0x140>(x); } while (0)
#define BAR_LDS() do { asm volatile("s_waitcnt lgkmcnt(0)" ::: "memory"); __builtin_amdgcn_s_barrier(); asm volatile("" ::: "memory"); } while (0)
#define SETPRIO(x) __builtin_amdgcn_s_setprio(x)
__device__ __forceinline__ float swap32_lo(float a, float b) { const auto r = __builtin_amdgcn_permlane32_swap(__float_as_uint(a), __float_as_uint(b), false, false); return __uint_as_float(r[0]); }
__device__ __forceinline__ unsigned swap32_hi2lo(unsigned x) { const auto r = __builtin_amdgcn_permlane32_swap(x, x, false, false); return r[1]; }
#define SWAP32_LO(a, b) swap32_lo(a, b)
#define SWAP32_HI2LO(x) swap32_hi2lo(x)
#define COMPILER_FENCE() asm volatile("" ::: "memory")
#define FEXP(x) __expf(x)
#define FRCP(x) __builtin_amdgcn_rcpf(x)
#define FRSQ(x) __builtin_amdgcn_rsqf(x)
#define FLOG(x) __logf(x)
typedef float cvt_f2 __attribute__((ext_vector_type(2))); typedef __bf16 cvt_b2 __attribute__((ext_vector_type(2)));
__device__ __forceinline__ unsigned CVTPK(float lo, float hi) { const cvt_f2 v = {lo, hi}; return __builtin_bit_cast(unsigned, __builtin_convertvector(v, cvt_b2)); }
__device__ __forceinline__ float bf2f(unsigned short b) { return __uint_as_float(((unsigned)b) << 16); }
__device__ __forceinline__ float wave_sum(float v) {
#pragma unroll
    for (int o = 1; o < 64; o <<= 1) v += __shfl_xor(v, o);
    return v;
}
__device__ __forceinline__ float silu_f(float x) { return x / (1.f + __expf(-x)); }

constexpr int GL_QB = 0;
constexpr int GL_KB = GL_QB + 64 * 272;
constexpr int GL_KDT = GL_KB + 64 * 272;
constexpr int GL_VT = GL_KDT + 128 * 144;
constexpr int GL_SC = GL_VT + 256 * 144;
constexpr int GL_DEC = GL_SC + 64 * 144;
constexpr int GL_TOT = GL_DEC + 512;
constexpr int GL_BG = GL_TOT + 2048;
constexpr int GL_END = GL_BG + 64 * 132 * 4;
static_assert(GL_END <= 146944, "GLA LDS map");

struct GlRaw { f32x4 h0, h1; v4u q0, q1, k0, k1; v4u v[4]; };
FORCEINLINE void gla_load(const Args& A, GlRaw& w, int ch, int T, int d, int row0, int h, int tid) {
    const bf16* Q0 = (const bf16*)(A.ws + WS_Q0); const bf16* K0 = (const bf16*)(A.ws + WS_K0); const bf16* V0 = (const bf16*)(A.ws + WS_V0); const float* HA = (const float*)(A.ws + WS_HA);
    const int lane = tid & 63, wave = RFL(tid >> 6), l31 = lane & 31, hh = lane >> 5, tt = wave >> 2;
    const int tau = 16 * ((l31 >> 2) & 1) + (l31 & 3) + 4 * (l31 >> 3);
    { const int s = 64 * ch + 32 * tt + tau, t = d ? T - 1 - s : s; const float* ha = HA + ((size_t)row0 + t) * 32 + d * 16 + 8 * hh; w.h0 = *(const f32x4*)ha; w.h1 = *(const f32x4*)(ha + 4); }
    { const int jb = 16 * wave, s = 64 * ch + lane, t = d ? T - 1 - s : s; const size_t row = (size_t)row0 + t;
        w.q0 = *(const v4u*)(Q0 + row * 512 + h * 128 + jb); w.q1 = *(const v4u*)(Q0 + row * 512 + h * 128 + jb + 8); w.k0 = *(const v4u*)(K0 + row * 512 + h * 128 + jb); w.k1 = *(const v4u*)(K0 + row * 512 + h * 128 + jb + 8);
        const bf16* vrow = V0 + row * 1024 + h * 256;
#pragma unroll
        for (int i4 = 0; i4 < 4; ++i4) w.v[i4] = *(const v4u*)(vrow + (wave * 4 + i4) * 8); }
}

FORCEINLINE void phase_gla_chunk(const Args& A, LAS unsigned char* lds, int tid, int blk) {
    LAS bf16* QB = (LAS bf16*)(lds + GL_QB); LAS bf16* KB = (LAS bf16*)(lds + GL_KB); LAS bf16* KDT = (LAS bf16*)(lds + GL_KDT); LAS bf16* VT = (LAS bf16*)(lds + GL_VT);
    LAS bf16* SC = (LAS bf16*)(lds + GL_SC); LAS float* DEC = (LAS float*)(lds + GL_DEC); LAS float* TOT = (LAS float*)(lds + GL_TOT); LAS float* BG = (LAS float*)(lds + GL_BG);
    const bf16* Q0 = (const bf16*)(A.ws + WS_Q0); const bf16* K0 = (const bf16*)(A.ws + WS_K0); const bf16* V0 = (const bf16*)(A.ws + WS_V0); const float* HA = (const float*)(A.ws + WS_HA);
    const int lane = tid & 63, wave = RFL(tid >> 6), l31 = lane & 31, hh = lane >> 5;
    const int j = tid & 127, qtr = RFL(tid >> 7);
    for (int slot = 0; slot < 2; ++slot) {
        int item; bool sample;
        if (blk < 64) { if (slot) break; sample = true; item = blk; }
        else { const int q = blk - 64; if (slot == 0) item = q; else { if (q >= 64) break; item = 192 + q; } sample = false; }
        const int b = item >> 3, h = (item >> 1) & 3, d = item & 1, T = sample ? 1024 : 256, row0 = sample ? MP + b * 1024 : b * 256;
        bf16* OUT = (bf16*)(A.ws + (d ? WS_OB : WS_OF));
        const int ecol = 32 * wave + l31;
        f32x16 S[4];
        if (sample) { const float* sp = A.in[I_SG] + ((((size_t)b * 2 + d) * 4 + h) * 128) * 256 + ecol;
#pragma unroll
            for (int t = 0; t < 4; ++t)
#pragma unroll
                for (int r = 0; r < 16; ++r) S[t][r] = sp[(size_t)(32 * t + (r & 3) + 8 * (r >> 2) + 4 * hh) * 256]; }
        else {
#pragma unroll
            for (int t = 0; t < 4; ++t)
#pragma unroll
                for (int r = 0; r < 16; ++r) S[t][r] = 0.f; }
        const int tt = wave >> 2, ctl = wave & 3, jcol = 32 * ctl + l31;
        bf16x8 wfrag; float bav;
        { v4u pk;
#pragma unroll
            for (int u = 0; u < 4; ++u) pk[u] = CVTPK(A.in[I_GWA2][((size_t)d * 16 + 8 * hh + 2 * u) * 512 + h * 128 + jcol], A.in[I_GWA2][((size_t)d * 16 + 8 * hh + 2 * u + 1) * 512 + h * 128 + jcol]);
            wfrag = __builtin_bit_cast(bf16x8, pk); bav = A.in[I_GBA][d * 512 + h * 128 + jcol]; }
        const int tau = 16 * ((l31 >> 2) & 1) + (l31 & 3) + 4 * (l31 >> 3);
        GlRaw raw; gla_load(A, raw, 0, T, d, row0, h, tid);
        for (int ch = 0; ch < T / 64; ++ch) {
            { const f32x4 h0 = raw.h0, h1 = raw.h1;
                const v4u apk = (v4u){CVTPK(h0[0], h0[1]), CVTPK(h0[2], h0[3]), CVTPK(h1[0], h1[1]), CVTPK(h1[2], h1[3])};
                f32x16 z;
#pragma unroll
                for (int r = 0; r < 16; ++r) z[r] = bav;
                z = MFMA32(__builtin_bit_cast(bf16x8, apk), wfrag, z);
                float run = 0.f;
#pragma unroll
                for (int r = 0; r < 16; ++r) { const float zz = z[r]; const float ls = fminf(zz, 0.f) - FLOG(1.f + FEXP(-fabsf(zz))); run += ls * (1.f / 16.f); z[r] = run; }
                const float other = SHFLX(run, 32);
                const float add = hh ? other : 0.f;
#pragma unroll
                for (int r = 0; r < 16; ++r) BG[(32 * tt + 16 * hh + r) * 132 + jcol] = z[r] + add;
                if (tt == 0 && hh == 1) TOT[jcol] = run + other; }
            BAR_LDS();
            { const int i = lane, jb = 16 * wave;
                const v4u q0 = raw.q0, q1 = raw.q1, k0 = raw.k0, k1 = raw.k1;
                unsigned qo[8], ko[8];
#pragma unroll
                for (int g = 0; g < 4; ++g) { const f32x4 bv = *(const LAS f32x4*)(BG + i * 132 + jb + 4 * g), t0 = *(const LAS f32x4*)(TOT + jb + 4 * g);
                    float qb_[4], kb_[4];
#pragma unroll
                    for (int c = 0; c < 4; ++c) { const int e = 4 * g + c; const unsigned qw = e < 8 ? q0[e >> 1] : q1[(e - 8) >> 1], kw = e < 8 ? k0[e >> 1] : k1[(e - 8) >> 1];
                        const float qv = (e & 1) ? __uint_as_float(qw & 0xffff0000u) : __uint_as_float(qw << 16), kv = (e & 1) ? __uint_as_float(kw & 0xffff0000u) : __uint_as_float(kw << 16);
                        const float bb = bv[c] + (i >= 32 ? t0[c] : 0.f);
                        const float eb = FEXP(bb), ei = FRCP(eb);
                        qb_[c] = qv * eb * 0.08838834764831845f; kb_[c] = kv * ei;
                        if (i == 63) DEC[jb + e] = eb; }
#pragma unroll
                    for (int c = 0; c < 4; c += 2) { const unsigned kp = CVTPK(kb_[c], kb_[c + 1]); KDT[(jb + 4 * g + c) * 72 + i] = (bf16)(kp & 0xffffu); KDT[(jb + 4 * g + c + 1) * 72 + i] = (bf16)(kp >> 16); }
                    qo[2 * g] = CVTPK(qb_[0], qb_[1]); qo[2 * g + 1] = CVTPK(qb_[2], qb_[3]); ko[2 * g] = CVTPK(kb_[0], kb_[1]); ko[2 * g + 1] = CVTPK(kb_[2], kb_[3]); }
                *(LAS v4u*)(QB + i * 136 + jb) = (v4u){qo[0], qo[1], qo[2], qo[3]}; *(LAS v4u*)(QB + i * 136 + jb + 8) = (v4u){qo[4], qo[5], qo[6], qo[7]};
                *(LAS v4u*)(KB + i * 136 + jb) = (v4u){ko[0], ko[1], ko[2], ko[3]}; *(LAS v4u*)(KB + i * 136 + jb + 8) = (v4u){ko[4], ko[5], ko[6], ko[7]}; }
            { const int sv = lane;
#pragma unroll
                for (int i4 = 0; i4 < 4; ++i4) { const int e0 = (wave * 4 + i4) * 8; const v4u w = raw.v[i4];
#pragma unroll
                    for (int u = 0; u < 4; ++u) { VT[(e0 + 2 * u) * 72 + sv] = (bf16)(w[u] & 0xffffu); VT[(e0 + 2 * u + 1) * 72 + sv] = (bf16)(w[u] >> 16); } } }
            gla_load(A, raw, ch + 1 < T / 64 ? ch + 1 : ch, T, d, row0, h, tid);
            BAR_LDS();
            if (wave < 3) { const int ct = wave == 0 ? 0 : 1, st = wave == 2 ? 1 : 0;
                f32x16 sc;
#pragma unroll
                for (int r = 0; r < 16; ++r) sc[r] = 0.f;
#pragma unroll
                for (int ks = 0; ks < 8; ++ks) { const bf16x8 a = *(const LAS bf16x8*)(QB + (32 * ct + l31) * 136 + 16 * ks + 8 * hh), bf = *(const LAS bf16x8*)(KB + (32 * st + l31) * 136 + 16 * ks + 8 * hh); sc = MFMA32(a, bf, sc); }
#pragma unroll
                for (int r = 0; r < 16; r += 2) { const int c = 32 * ct + (r & 3) + 8 * (r >> 2) + 4 * hh, s_ = 32 * st + l31; const unsigned pk = CVTPK(c >= s_ ? sc[r] : 0.f, c + 1 >= s_ ? sc[r + 1] : 0.f);
                    SC[c * 72 + s_] = (bf16)(pk & 0xffffu); SC[(c + 1) * 72 + s_] = (bf16)(pk >> 16); } }
            f32x16 O[2];
#pragma unroll
            for (int ct = 0; ct < 2; ++ct)
#pragma unroll
                for (int r = 0; r < 16; ++r) O[ct][r] = 0.f;
#pragma unroll
            for (int t = 0; t < 4; ++t)
#pragma unroll
                for (int ks = 0; ks < 2; ++ks) {
                    v4u pk; pk[0] = CVTPK(S[t][8 * ks + 0], S[t][8 * ks + 1]); pk[1] = CVTPK(S[t][8 * ks + 2], S[t][8 * ks + 3]); pk[2] = CVTPK(S[t][8 * ks + 4], S[t][8 * ks + 5]); pk[3] = CVTPK(S[t][8 * ks + 6], S[t][8 * ks + 7]);
                    const bf16x8 bfrag = __builtin_bit_cast(bf16x8, pk);
#pragma unroll
                    for (int ct = 0; ct < 2; ++ct) { const LAS bf16* ap = QB + (32 * ct + l31) * 136 + 32 * t + 16 * ks + 4 * hh;
                        const v2u lo = *(const LAS v2u*)ap, hi = *(const LAS v2u*)(ap + 8); const v4u av = (v4u){lo[0], lo[1], hi[0], hi[1]};
                        O[ct] = MFMA32(__builtin_bit_cast(bf16x8, av), bfrag, O[ct]); } }
            bf16x8 vb[4];
#pragma unroll
            for (int ks = 0; ks < 4; ++ks) vb[ks] = *(const LAS bf16x8*)(VT + ecol * 72 + 16 * ks + 8 * hh);
#pragma unroll
            for (int t = 0; t < 4; ++t) {
#pragma unroll
                for (int ks = 0; ks < 4; ++ks) { const bf16x8 a = *(const LAS bf16x8*)(KDT + (32 * t + l31) * 72 + 16 * ks + 8 * hh); S[t] = MFMA32(a, vb[ks], S[t]); }
#pragma unroll
                for (int g = 0; g < 4; ++g) { const f32x4 dc = *(const LAS f32x4*)(DEC + 32 * t + 8 * g + 4 * hh);
#pragma unroll
                    for (int c = 0; c < 4; ++c) S[t][4 * g + c] *= dc[c]; } }
            BAR_LDS();
#pragma unroll
            for (int ct = 0; ct < 2; ++ct)
#pragma unroll
                for (int ks = 0; ks < 4; ++ks) if (ks < (ct ? 4 : 2)) { const bf16x8 a = *(const LAS bf16x8*)(SC + (32 * ct + l31) * 72 + 16 * ks + 8 * hh); O[ct] = MFMA32(a, vb[ks], O[ct]); }
            { LAS bf16* OST = (LAS bf16*)(lds + GL_QB) + wave * 2048;
#pragma unroll
                for (int ct = 0; ct < 2; ++ct)
#pragma unroll
                    for (int r = 0; r < 16; r += 2) { const int c = 32 * ct + (r & 3) + 8 * (r >> 2) + 4 * hh; const unsigned pk = CVTPK(O[ct][r], O[ct][r + 1]);
                        OST[c * 32 + l31] = (bf16)(pk & 0xffffu); OST[(c + 1) * 32 + l31] = (bf16)(pk >> 16); }
                LDS_WAIT();
#pragma unroll
                for (int k = 0; k < 4; ++k) { const int c = 16 * k + (lane >> 2), s = 64 * ch + c, t = d ? T - 1 - s : s; const v4u w = *(const LAS v4u*)(OST + c * 32 + 8 * (lane & 3));
                    *(v4u*)(OUT + ((size_t)row0 + t) * 1024 + h * 256 + 32 * wave + 8 * (lane & 3)) = w; } }
        }
        if (!sample) { float* dst = A.out + OUT_SG + ((((size_t)b * 2 + d) * 4 + h) * 128) * 256 + ecol;
#pragma unroll
            for (int t = 0; t < 4; ++t)
#pragma unroll
                for (int r = 0; r < 16; ++r) dst[(size_t)(32 * t + (r & 3) + 8 * (r >> 2) + 4 * hh) * 256] = S[t][r]; }
        BAR();
    }
}
constexpr int RW_SET = 17664;
constexpr int RW_XS = 0;
constexpr int RW_YS = 4608;
constexpr int RW_YT = 9216;
constexpr int RW_VT = 14336;
constexpr int RW_GC = 17408;
constexpr int RW_LAB = 4 * RW_SET;
constexpr int RW_BONL = RW_LAB + 4096;
constexpr int RW_END = RW_BONL + 512;
static_assert(RW_END <= 131072, "RWKV LDS map");

FORCEINLINE float fast_exp(float x) { return FEXP(x); }
FORCEINLINE float fast_tanh(float x) { return 1.f - 2.f * FRCP(1.f + FEXP(2.f * x)); }

struct RwItem { int b, h, d, T, row0; };
struct RwRaw { v4u aw[2], aa[2]; v2u k[4]; unsigned r[4], v[4]; };
FORCEINLINE void rwkv_prep_load(const Args& A, RwRaw& w, const RwItem it, int ch, int jh, int lane) {
    const int j16 = lane & 15, q = lane >> 4;
    const bf16* R1 = (const bf16*)(A.ws + WS_R1); const bf16* K1 = (const bf16*)(A.ws + WS_K1); const bf16* V1 = (const bf16*)(A.ws + WS_V1); const bf16* LWA = (const bf16*)(A.ws + WS_LWA);
    const int h = it.h, d = it.d, T = it.T, row0 = it.row0;
    { const int s = 16 * ch + j16, t = d ? T - 1 - s : s; const bf16* lrow = LWA + ((size_t)row0 + t) * 256 + d * 64;
#pragma unroll
        for (int ks = 0; ks < 2; ++ks) { w.aw[ks] = *(const v4u*)(lrow + 32 * ks + 8 * q); w.aa[ks] = *(const v4u*)(lrow + 128 + 32 * ks + 8 * q); } }
#pragma unroll
    for (int rr = 0; rr < 4; ++rr) { const int s = 16 * ch + 4 * q + rr, t = d ? T - 1 - s : s; const size_t off = ((size_t)row0 + t) * 1024 + h * 64 + 4 * j16;
        w.k[rr] = *(const v2u*)(K1 + off); w.r[rr] = *(const unsigned*)(R1 + off + 2 * jh); w.v[rr] = *(const unsigned*)(V1 + off + 2 * jh); }
}
FORCEINLINE void rwkv_prep(LAS unsigned char* set, LAS float* bonl, const RwRaw& w, int jh, int lane,
                           const bf16x8 (&Bw)[2][2], const bf16x8 (&Ba)[2][2], const float (&w0v)[2], const float (&a0v)[2], const float (&kav)[2], const float (&rkv)[2], const float (&kkw)[4]) {
    const int j16 = lane & 15, q = lane >> 4, jc0 = 4 * j16 + 2 * jh;
    LAS bf16* pXS = (LAS bf16*)(set + RW_XS); LAS bf16* pYS = (LAS bf16*)(set + RW_YS); LAS bf16* pYT = (LAS bf16*)(set + RW_YT); LAS bf16* pVT = (LAS bf16*)(set + RW_VT); LAS float* pGC = (LAS float*)(set + RW_GC);
    f32x4 Dw[2], Da[2];
#pragma unroll
    for (int n = 0; n < 2; ++n) { Dw[n] = (f32x4){0.f, 0.f, 0.f, 0.f}; Da[n] = (f32x4){0.f, 0.f, 0.f, 0.f}; }
#pragma unroll
    for (int ks = 0; ks < 2; ++ks)
#pragma unroll
        for (int n = 0; n < 2; ++n) { Dw[n] = MFMA16(__builtin_bit_cast(bf16x8, w.aw[ks]), Bw[n][ks], Dw[n]); Da[n] = MFMA16(__builtin_bit_cast(bf16x8, w.aa[ks]), Ba[n][ks], Da[n]); }
    float lwd[2][4], asg[2][4], kkv[2][4], kdv[2][4], rvv[2][4], bonp[4];
#pragma unroll
    for (int rr = 0; rr < 4; ++rr) {
        float kx[4]; kx[0] = __uint_as_float(w.k[rr][0] << 16); kx[1] = __uint_as_float(w.k[rr][0] & 0xffff0000u); kx[2] = __uint_as_float(w.k[rr][1] << 16); kx[3] = __uint_as_float(w.k[rr][1] & 0xffff0000u);
        float n2s = 0.f;
#pragma unroll
        for (int c = 0; c < 4; ++c) { const float kq = kx[c] * kkw[c]; n2s += kq * kq; }
        RED16(n2s);
        const float inv = FRSQ(fmaxf(n2s, 1e-24f));
        rvv[0][rr] = __uint_as_float(w.r[rr] << 16); rvv[1][rr] = __uint_as_float(w.r[rr] & 0xffff0000u);
        float bp = 0.f;
#pragma unroll
        for (int n = 0; n < 2; ++n) { const float wpre = w0v[n] + Dw[n][rr], apre = a0v[n] + Da[n][rr];
            lwd[n][rr] = -0.6065306597126334f * FRCP(1.f + fast_exp(-wpre));
            asg[n][rr] = FRCP(1.f + fast_exp(-apre));
            const float kraw = jh ? kx[2 + n] : kx[n], kself = jh ? kkw[2 + n] : kkw[n];
            kkv[n][rr] = kraw * kself * inv;
            kdv[n][rr] = kraw * (1.f + (asg[n][rr] - 1.f) * kav[n]);
            bp += rvv[n][rr] * kdv[n][rr] * rkv[n]; }
        RED16(bp);
        bonp[rr] = bp; }
    if (j16 == 0) {
#pragma unroll
        for (int rr = 0; rr < 4; ++rr) bonl[jh * 16 + 4 * q + rr] = bonp[rr]; }
    float at_[2][4], rt_[2][4], bt_[2][4], kt_[2][4];
#pragma unroll
    for (int n = 0; n < 2; ++n) {
        const float tot = (lwd[n][0] + lwd[n][1]) + (lwd[n][2] + lwd[n][3]);
        const float bq = SHFLX(tot, 16), pr = tot + bq, cq = SHFLX(pr, 32);
        float cum = ((q & 1) ? bq : 0.f) + ((q & 2) ? cq : 0.f);
        float gp = fast_exp(cum);
#pragma unroll
        for (int rr = 0; rr < 4; ++rr) { cum += lwd[n][rr];
            const float g = fast_exp(cum), gi = FRCP(g);
            at_[n][rr] = -kkv[n][rr] * gp; bt_[n][rr] = kkv[n][rr] * asg[n][rr] * gi; kt_[n][rr] = kdv[n][rr] * gi; rt_[n][rr] = rvv[n][rr] * g;
            gp = g; }
        *(LAS v2u*)(pYT + (jc0 + n) * 40 + 4 * q) = (v2u){CVTPK(bt_[n][0], bt_[n][1]), CVTPK(bt_[n][2], bt_[n][3])};
        *(LAS v2u*)(pYT + (jc0 + n) * 40 + 16 + 4 * q) = (v2u){CVTPK(kt_[n][0], kt_[n][1]), CVTPK(kt_[n][2], kt_[n][3])};
        if (q == 0) pGC[jc0 + n] = fast_exp(pr + cq); }
#pragma unroll
    for (int rr = 0; rr < 4; ++rr) { const int rho = rr + 8 * q;
        *(LAS unsigned*)(pXS + rho * 72 + jc0) = CVTPK(at_[0][rr], at_[1][rr]); *(LAS unsigned*)(pXS + (rho + 4) * 72 + jc0) = CVTPK(rt_[0][rr], rt_[1][rr]);
        *(LAS unsigned*)(pYS + rho * 72 + jc0) = CVTPK(bt_[0][rr], bt_[1][rr]); *(LAS unsigned*)(pYS + (rho + 4) * 72 + jc0) = CVTPK(kt_[0][rr], kt_[1][rr]); }
    *(LAS v2u*)(pVT + jc0 * 24 + 4 * q) = (v2u){(w.v[0] & 0xffffu) | (w.v[1] << 16), (w.v[2] & 0xffffu) | (w.v[3] << 16)};
    *(LAS v2u*)(pVT + (jc0 + 1) * 24 + 4 * q) = (v2u){(w.v[0] >> 16) | (w.v[1] & 0xffff0000u), (w.v[2] >> 16) | (w.v[3] & 0xffff0000u)};
}

FORCEINLINE void rwkv_core2(const Args& A, const LAS unsigned char* set, LAS float* LAB, const LAS float* bonl, f32x16 (&Z)[2][2], const RwItem it, int ch, int lane) {
    const int l31 = lane & 31, hh = lane >> 5;
    const LAS bf16* cXS = (const LAS bf16*)(set + RW_XS); const LAS bf16* cYS = (const LAS bf16*)(set + RW_YS); const LAS bf16* cYT = (const LAS bf16*)(set + RW_YT); const LAS bf16* cVT = (const LAS bf16*)(set + RW_VT); const LAS float* cGC = (const LAS float*)(set + RW_GC);
    const int h = it.h, d = it.d, T = it.T, row0 = it.row0;
    f32x16 Gp;
#pragma unroll
    for (int r = 0; r < 16; ++r) Gp[r] = 0.f;
#pragma unroll
    for (int ks = 0; ks < 4; ++ks) { const bf16x8 a = *(const LAS bf16x8*)(cYS + l31 * 72 + 16 * ks + 8 * hh), bx = *(const LAS bf16x8*)(cXS + l31 * 72 + 16 * ks + 8 * hh); Gp = MFMA32(a, bx, Gp); }
    f32x16 Dm[2];
#pragma unroll
    for (int ti = 0; ti < 2; ++ti) {
#pragma unroll
        for (int r = 0; r < 16; ++r) Dm[ti][r] = 0.f; }
#pragma unroll
    for (int jt = 0; jt < 2; ++jt)
#pragma unroll
        for (int ks = 0; ks < 2; ++ks) { const LAS bf16* ap = cXS + l31 * 72 + 32 * jt + 16 * ks + 4 * hh; const v2u lo = *(const LAS v2u*)ap, hi = *(const LAS v2u*)(ap + 8);
            const bf16x8 av = __builtin_bit_cast(bf16x8, (v4u){lo[0], lo[1], hi[0], hi[1]});
#pragma unroll
            for (int ti = 0; ti < 2; ++ti) { const v4u zk = (v4u){CVTPK(Z[ti][jt][8 * ks], Z[ti][jt][8 * ks + 1]), CVTPK(Z[ti][jt][8 * ks + 2], Z[ti][jt][8 * ks + 3]), CVTPK(Z[ti][jt][8 * ks + 4], Z[ti][jt][8 * ks + 5]), CVTPK(Z[ti][jt][8 * ks + 6], Z[ti][jt][8 * ks + 7])};
                Dm[ti] = MFMA32(av, __builtin_bit_cast(bf16x8, zk), Dm[ti]); } }
    const int hx = (l31 >> 2) & 1, tx = (l31 & 3) + 4 * (l31 >> 3);
#pragma unroll
    for (int r = 0; r < 16; ++r) Gp[r] = r < tx + hx ? Gp[r] : 0.f;
    if (hh == 0 && hx == 0) {
#pragma unroll
        for (int g = 0; g < 4; ++g) *(LAS f32x4*)(LAB + tx * 16 + 4 * g) = (f32x4){Gp[4 * g], Gp[4 * g + 1], Gp[4 * g + 2], Gp[4 * g + 3]}; }
    bf16x8 Ag[2];
#pragma unroll
    for (int ks = 0; ks < 2; ++ks) { const v4u pk = (v4u){CVTPK(Gp[8 * ks], Gp[8 * ks + 1]), CVTPK(Gp[8 * ks + 2], Gp[8 * ks + 3]), CVTPK(Gp[8 * ks + 4], Gp[8 * ks + 5]), CVTPK(Gp[8 * ks + 6], Gp[8 * ks + 7])}; Ag[ks] = __builtin_bit_cast(bf16x8, pk); }
#pragma unroll
    for (int ti = 0; ti < 2; ++ti)
#pragma unroll
        for (int ks = 0; ks < 2; ++ks) { const v4u vz = *(const LAS v4u*)(cVT + (32 * ti + l31) * 24 + 8 * ks); const v4u vf = hh ? vz : (v4u){0u, 0u, 0u, 0u};
            Dm[ti] = MFMA32(Ag[ks], __builtin_bit_cast(bf16x8, vf), Dm[ti]); }
    float u[16];
#pragma unroll
    for (int r = 0; r < 16; ++r) u[r] = SWAP32_LO(Dm[0][r], Dm[1][r]);
    LDS_WAIT();
#pragma unroll
    for (int t = 0; t < 16; ++t) { float acc_ = u[t];
#pragma unroll
        for (int g = 0; g < 4; ++g) if (4 * g < t) { const f32x4 lv = *(const LAS f32x4*)(LAB + t * 16 + 4 * g);
#pragma unroll
            for (int c = 0; c < 4; ++c) if (4 * g + c < t) acc_ += lv[c] * u[4 * g + c]; }
        u[t] = acc_;
        if ((t & 3) == 3) COMPILER_FENCE(); }
    v4u Uf[2][2];
#pragma unroll
    for (int ks = 0; ks < 2; ++ks) {
#pragma unroll
        for (int c = 0; c < 4; ++c) { const unsigned pk = CVTPK(u[8 * ks + 2 * c], u[8 * ks + 2 * c + 1]); const unsigned up = SWAP32_HI2LO(pk);
            Uf[0][ks][c] = hh ? 0u : pk; Uf[1][ks][c] = hh ? 0u : up; } }
    bf16* YO = (bf16*)(A.ws + (d ? WS_YB : WS_YF));
#pragma unroll
    for (int ti = 0; ti < 2; ++ti) {
#pragma unroll
        for (int ks = 0; ks < 2; ++ks) Dm[ti] = MFMA32(Ag[ks], __builtin_bit_cast(bf16x8, Uf[ti][ks]), Dm[ti]);
        if (hh) {
#pragma unroll
            for (int r = 0; r < 16; r += 2) { const unsigned pk = CVTPK(Dm[ti][r], Dm[ti][r + 1]); const int s0 = 16 * ch + r, t0 = d ? T - 1 - s0 : s0, t1 = d ? t0 - 1 : t0 + 1;
                YO[((size_t)row0 + t0) * 1024 + h * 64 + 32 * ti + l31] = (bf16)(pk & 0xffffu); YO[((size_t)row0 + t1) * 1024 + h * 64 + 32 * ti + l31] = (bf16)(pk >> 16); } } }
#pragma unroll
    for (int jt = 0; jt < 2; ++jt) {
        f32x4 dc[4];
#pragma unroll
        for (int g = 0; g < 4; ++g) dc[g] = *(const LAS f32x4*)(cGC + 32 * jt + 8 * g + 4 * hh);
#pragma unroll
        for (int ks = 0; ks < 2; ++ks) { const bf16x8 a = *(const LAS bf16x8*)(cYT + (32 * jt + l31) * 40 + 16 * hh + 8 * ks);
#pragma unroll
            for (int ti = 0; ti < 2; ++ti) { const v4u vz = *(const LAS v4u*)(cVT + (32 * ti + l31) * 24 + 8 * ks); const v4u bv = hh ? vz : Uf[ti][ks]; Z[ti][jt] = MFMA32(a, __builtin_bit_cast(bf16x8, bv), Z[ti][jt]); } }
#pragma unroll
        for (int ti = 0; ti < 2; ++ti)
#pragma unroll
            for (int g = 0; g < 4; ++g)
#pragma unroll
                for (int c = 0; c < 4; ++c) Z[ti][jt][4 * g + c] *= dc[g][c]; }
    if (lane < 16) { const int s = 16 * ch + lane, t = d ? T - 1 - s : s; float* BON = (float*)(A.ws + WS_BONUS);
        BON[(((size_t)row0 + t) * 16 + h) * 2 + d] = bonl[lane] + bonl[16 + lane]; }
}

FORCEINLINE RwItem rw_item(bool smp, int idx) { RwItem it; it.b = idx >> 5; it.h = (idx >> 1) & 15; it.d = idx & 1; it.T = smp ? 1024 : 256; it.row0 = smp ? MP + it.b * 1024 : it.b * 256; return it; }

FORCEINLINE void rw_consts(const Args& A, const RwItem it, int sub, int lane, bf16x8 (&Bw)[2][2], bf16x8 (&Ba)[2][2], float (&w0v)[2], float (&a0v)[2], float (&kav)[2], float (&rkv)[2], float (&kkw)[4]) {
    const int j16 = lane & 15, q = lane >> 4;
#pragma unroll
    for (int n = 0; n < 2; ++n) { const int jc = 4 * j16 + 2 * sub + n, hj = it.h * 64 + jc;
        float tw[16], ta[16];
#pragma unroll
        for (int ks = 0; ks < 2; ++ks)
#pragma unroll
            for (int u = 0; u < 8; ++u) { const int m = 32 * ks + 8 * q + u; tw[8 * ks + u] = A.in[I_W2][((size_t)it.d * 64 + m) * 1024 + hj]; ta[8 * ks + u] = A.in[I_A2][((size_t)it.d * 64 + m) * 1024 + hj]; }
        w0v[n] = A.in[I_W0][it.d * 1024 + hj]; a0v[n] = A.in[I_A0][it.d * 1024 + hj]; kav[n] = A.in[I_KA][it.d * 1024 + hj]; rkv[n] = A.in[I_RK][(it.d * 16 + it.h) * 64 + jc];
#pragma unroll
        for (int ks = 0; ks < 2; ++ks) { v4u pw_, pa_;
#pragma unroll
            for (int u = 0; u < 4; ++u) { pw_[u] = CVTPK(tw[8 * ks + 2 * u], tw[8 * ks + 2 * u + 1]); pa_[u] = CVTPK(ta[8 * ks + 2 * u], ta[8 * ks + 2 * u + 1]); }
            Bw[n][ks] = __builtin_bit_cast(bf16x8, pw_); Ba[n][ks] = __builtin_bit_cast(bf16x8, pa_); } }
#pragma unroll
    for (int c = 0; c < 4; ++c) kkw[c] = A.in[I_KK][it.d * 1024 + it.h * 64 + 4 * j16 + c];
}

FORCEINLINE void phase_rwkv_chunk(const Args& A, LAS unsigned char* lds, int tid, int blk, int mode = 0) {
    const int lane = tid & 63, wave = RFL(tid >> 6), l31 = lane & 31, hh = lane >> 5;
    LAS float* BONL = (LAS float*)(lds + RW_BONL);
    BAR();
    if (wave == 2 || wave == 3 || wave >= 6) {
        const int sel = wave >> 2, sub = wave & 1;
        bf16x8 Bw[2][2], Ba[2][2]; float w0v[2] = {0.f, 0.f}, a0v[2] = {0.f, 0.f}, kav[2] = {0.f, 0.f}, rkv[2] = {0.f, 0.f}, kkw[4] = {0.f, 0.f, 0.f, 0.f};
        RwRaw rawA, rawB;
        { const bool smp = sel == 0; rwkv_prep_load(A, rawA, rw_item(smp, smp ? blk : blk * 4), 0, sub, lane); }
#define RW_PREP_ROUND(RD, CUR, NXT) do { const int rd = (RD); const bool smp = sel == 0; const RwItem it = rw_item(smp, smp ? blk : blk * 4 + (rd >> 4)); \
            if (smp ? rd == 0 : (rd & 15) == 0) rw_consts(A, it, sub, lane, Bw, Ba, w0v, a0v, kav, rkv, kkw); \
            { const int r1 = rd + 1 < 64 ? rd + 1 : 63; rwkv_prep_load(A, NXT, rw_item(smp, smp ? blk : blk * 4 + (r1 >> 4)), smp ? r1 : (r1 & 15), sub, lane); }     \
            if (mode != 2) rwkv_prep(lds + (sel * 2 + (rd & 1)) * RW_SET, BONL + ((rd & 1) * 2 + sel) * 32, CUR, sub, lane, Bw, Ba, w0v, a0v, kav, rkv, kkw); \
            BAR_LDS(); } while (0)
        for (int rd2 = 0; rd2 < 64; rd2 += 2) { RW_PREP_ROUND(rd2, rawA, rawB); RW_PREP_ROUND(rd2 + 1, rawB, rawA); }
        BAR_LDS();
#undef RW_PREP_ROUND
    } else if (wave < 2 && mode == 0) {
        const int sel = wave;
        LAS float* LAB = (LAS float*)(lds + RW_LAB) + wave * 256;
        SETPRIO(2);
        f32x16 Z[2][2];
#pragma unroll
        for (int r = 0; r < 16; ++r) { Z[0][0][r] = 0.f; Z[0][1][r] = 0.f; Z[1][0][r] = 0.f; Z[1][1][r] = 0.f; }
        BAR_LDS();
        for (int rd = 0; rd < 64; ++rd) {
            const bool smp = sel == 0; const RwItem it = rw_item(smp, smp ? blk : blk * 4 + (rd >> 4)); const int ch = smp ? rd : (rd & 15);
            if (smp ? rd == 0 : (rd & 15) == 0) {
#pragma unroll
                for (int ti = 0; ti < 2; ++ti) {
                    if (smp) { const float* sp = A.in[I_SR] + ((((size_t)it.b * 2 + it.d) * 16 + it.h) * 64 + 32 * ti + l31) * 64;
#pragma unroll
                        for (int jt = 0; jt < 2; ++jt)
#pragma unroll
                            for (int g = 0; g < 4; ++g) { const f32x4 v = *(const f32x4*)(sp + 32 * jt + 8 * g + 4 * hh); Z[ti][jt][4 * g] = v[0]; Z[ti][jt][4 * g + 1] = v[1]; Z[ti][jt][4 * g + 2] = v[2]; Z[ti][jt][4 * g + 3] = v[3]; } }
                    else {
#pragma unroll
                        for (int r = 0; r < 16; ++r) { Z[ti][0][r] = 0.f; Z[ti][1][r] = 0.f; } } }
            }
            rwkv_core2(A, lds + (sel * 2 + (rd & 1)) * RW_SET, LAB, BONL + ((rd & 1) * 2 + sel) * 32, Z, it, ch, lane);
            if (!smp && (rd & 15) == 15) {
#pragma unroll
                for (int ti = 0; ti < 2; ++ti) { float* dp = A.out + OUT_SR + ((((size_t)it.b * 2 + it.d) * 16 + it.h) * 64 + 32 * ti + l31) * 64;
#pragma unroll
                    for (int jt = 0; jt < 2; ++jt)
#pragma unroll
                        for (int g = 0; g < 4; ++g) *(f32x4*)(dp + 32 * jt + 8 * g + 4 * hh) = (f32x4){Z[ti][jt][4 * g], Z[ti][jt][4 * g + 1], Z[ti][jt][4 * g + 2], Z[ti][jt][4 * g + 3]}; } }
            BAR_LDS();
        }
        SETPRIO(0);
    } else {
        for (int rd = 0; rd < 65; ++rd) BAR_LDS();
    }
}
constexpr int RH_LD = 1032;
FORCEINLINE int cond_of_row(int r) { return r < MP ? 0 : 1 + ((r - MP) >> 10); }
FORCEINLINE float row_rstd16(const float* ssq, int r, int lane) { float s = lane < 16 ? ssq[(size_t)r * 16 + lane] : 0.f; return FRSQ(wave_sum(s) * (1.f / D) + EPS); }

FORCEINLINE void phase_h0_ha(const Args& A, LAS unsigned char* lds, int tid, int blk) {
    LAS bf16* HL = (LAS bf16*)lds; LAS float* RED = (LAS float*)lds;
    const int lane = tid & 63, wave = RFL(tid >> 6), l31 = lane & 31, hh = lane >> 5;
    const float* MOD = (const float*)(A.ws + WS_MOD); bf16* XN = (bf16*)(A.ws + WS_ABUF); const float* nw = A.in[I_NORMW];
    const bf16* WA1 = (const bf16*)(A.ws + WS_WIN) + (size_t)3072 * 1024; float* HA = (float*)(A.ws + WS_HA);
    const int rbase = blk * 64;
    BAR();
    for (int k = 0; k < 8; ++k) { const int rl = wave * 8 + k, r = rbase + rl;
        const f32x4* xr = (const f32x4*)(r < MP ? A.in[I_XP] + (size_t)r * D : A.in[I_XS] + (size_t)(r - MP) * D) + lane;
        f32x4 v[4]; float s = 0.f;
#pragma unroll
        for (int j = 0; j < 4; ++j) { v[j] = xr[64 * j]; s += (v[j][0] * v[j][0] + v[j][1] * v[j][1]) + (v[j][2] * v[j][2] + v[j][3] * v[j][3]); }
        const float rstd = FRSQ(wave_sum(s) * (1.f / D) + EPS);
        const float* md = MOD + cond_of_row(r) * 3072;
#pragma unroll
        for (int j = 0; j < 4; ++j) { const int c = 256 * j + 4 * lane; const f32x4 w = *(const f32x4*)(nw + c), sh = *(const f32x4*)(md + c), sc = *(const f32x4*)(md + 1024 + c);
            const f32x4 hv = (v[j] * rstd) * w * (sc + 1.f) + sh; const v2u pk = (v2u){CVTPK(hv[0], hv[1]), CVTPK(hv[2], hv[3])};
            *(v2u*)(XN + (size_t)r * D + c) = pk; *(LAS v2u*)(HL + rl * RH_LD + c) = pk; }
    }
    BAR();
    f32x16 acc[2];
#pragma unroll
    for (int r = 0; r < 16; ++r) { acc[0][r] = 0.f; acc[1][r] = 0.f; }
#pragma unroll
    for (int ks = 0; ks < 8; ++ks) { const int kk = 128 * wave + 16 * ks + 8 * hh; const bf16x8 bfr = *(const bf16x8*)(WA1 + (size_t)l31 * 1024 + kk);
#pragma unroll
        for (int rt = 0; rt < 2; ++rt) { const bf16x8 a = *(const LAS bf16x8*)(HL + (32 * rt + l31) * RH_LD + kk); acc[rt] = MFMA32(a, bfr, acc[rt]); } }
    BAR();
#pragma unroll
    for (int rt = 0; rt < 2; ++rt)
#pragma unroll
        for (int r = 0; r < 16; ++r) RED[(wave * 64 + 32 * rt + (r & 3) + 8 * (r >> 2) + 4 * hh) * 32 + l31] = acc[rt][r];
    BAR();
    for (int idx = tid; idx < 2048; idx += 512) { float s = 0.f;
#pragma unroll
        for (int w = 0; w < 8; ++w) s += RED[w * 2048 + idx];
        HA[(size_t)rbase * 32 + idx] = s; }
    BAR();
}

FORCEINLINE void lr_pass(const LAS bf16* HL, const bf16* W, f32x16 (&acc)[2], int l31, int hh, int rot) {
    bf16x8 b0[8], b1[8];
#pragma unroll
    for (int u = 0; u < 8; ++u) b0[u] = *(const bf16x8*)(W + 16 * ((u + rot) & 63) + 8 * hh);
    for (int g = 0; g < 8; g += 2) {
#pragma unroll
        for (int u = 0; u < 8; ++u) b1[u] = *(const bf16x8*)(W + 16 * ((8 * (g + 1) + u + rot) & 63) + 8 * hh);
#pragma unroll
        for (int u = 0; u < 8; ++u) { const int kk = 16 * ((8 * g + u + rot) & 63) + 8 * hh;
#pragma unroll
            for (int rt = 0; rt < 2; ++rt) { const bf16x8 a = *(const LAS bf16x8*)(HL + (32 * rt + l31) * RH_LD + kk); acc[rt] = MFMA32(a, b0[u], acc[rt]); } }
        if (g + 2 < 8) {
#pragma unroll
            for (int u = 0; u < 8; ++u) b0[u] = *(const bf16x8*)(W + 16 * ((8 * (g + 2) + u + rot) & 63) + 8 * hh); }
#pragma unroll
        for (int u = 0; u < 8; ++u) { const int kk = 16 * ((8 * (g + 1) + u + rot) & 63) + 8 * hh;
#pragma unroll
            for (int rt = 0; rt < 2; ++rt) { const bf16x8 a = *(const LAS bf16x8*)(HL + (32 * rt + l31) * RH_LD + kk); acc[rt] = MFMA32(a, b1[u], acc[rt]); } }
    }
}

FORCEINLINE void phase_hh_lr(const Args& A, LAS unsigned char* lds, int tid, int blk) {
    LAS bf16* HL = (LAS bf16*)lds;
    const int lane = tid & 63, wave = RFL(tid >> 6), l31 = lane & 31, hh = lane >> 5;
    const float* MOD = (const float*)(A.ws + WS_MOD) + 9 * 3072; const float* ssq = (const float*)(A.ws + WS_SSQ1); bf16* HH = (bf16*)(A.ws + WS_HH); const float* nw = A.in[I_NORMW] + 1024; const float* X1 = A.out;
    const bf16* WL = (const bf16*)(A.ws + WS_W4) + (size_t)(4096 + 32 * wave + l31) * 2048; bf16* LWA = (bf16*)(A.ws + WS_LWA);
    const int rbase = blk * 64;
    v2u hsp[8][4];
    BAR();
#pragma unroll
    for (int k = 0; k < 8; ++k) { const int rl = wave * 8 + k, r = rbase + rl;
        const float* md = MOD + cond_of_row(r) * 3072;
        int n0, n1, n2, n3; bool v0, v1, v2, v3; float wgt;
        if (r < MP) { const int t = r & 255; wgt = 0.5f; n0 = r - 1; v0 = t > 0; n1 = r + 1; v1 = t < 255; n2 = r; v2 = false; n3 = r; v3 = false; }
        else { const int t = (r - MP) & 1023, gr = t >> 6, gc = t & 63; wgt = 0.25f; n0 = r - 64; v0 = gr > 0; n1 = r + 64; v1 = gr < 15; n2 = r - 1; v2 = gc > 0; n3 = r + 1; v3 = gc < 63; }
        const int cnt = (int)v0 + (int)v1 + (int)v2 + (int)v3;
        const float rs = row_rstd16(ssq, r, lane);
        f32x4 acc[4];
#pragma unroll
        for (int j = 0; j < 4; ++j) acc[j] = (f32x4){0.f, 0.f, 0.f, 0.f};
#pragma unroll
        for (int q = 0; q < 4; ++q) { const int n = q == 0 ? n0 : q == 1 ? n1 : q == 2 ? n2 : n3; const bool vld = q == 0 ? v0 : q == 1 ? v1 : q == 2 ? v2 : v3;
            if (vld) { const float rn = row_rstd16(ssq, n, lane); const f32x4* xp = (const f32x4*)(X1 + (size_t)n * D) + lane;
#pragma unroll
                for (int j = 0; j < 4; ++j) acc[j] += xp[64 * j] * rn; } }
        const f32x4* xr = (const f32x4*)(X1 + (size_t)r * D) + lane;
#pragma unroll
        for (int j = 0; j < 4; ++j) { const int c = 256 * j + 4 * lane; const f32x4 w = *(const f32x4*)(nw + c), sh = *(const f32x4*)(md + c), sc = *(const f32x4*)(md + 1024 + c); const f32x4 cc = w * (sc + 1.f);
            const f32x4 h1 = (xr[64 * j] * rs) * cc + sh, hs = (acc[j] * cc + sh * (float)cnt) * wgt;
            const v2u p1 = (v2u){CVTPK(h1[0], h1[1]), CVTPK(h1[2], h1[3])}; hsp[k][j] = (v2u){CVTPK(hs[0], hs[1]), CVTPK(hs[2], hs[3])};
            *(v2u*)(HH + (size_t)r * 2048 + c) = p1; *(v2u*)(HH + (size_t)r * 2048 + 1024 + c) = hsp[k][j];
            *(LAS v2u*)(HL + rl * RH_LD + c) = p1; }
    }
    BAR();
    f32x16 acc2[2];
#pragma unroll
    for (int r = 0; r < 16; ++r) { acc2[0][r] = 0.f; acc2[1][r] = 0.f; }
    lr_pass(HL, WL, acc2, l31, hh, (blk * 8) & 63);
    BAR();
#pragma unroll
    for (int k = 0; k < 8; ++k)
#pragma unroll
        for (int j = 0; j < 4; ++j) *(LAS v2u*)(HL + (wave * 8 + k) * RH_LD + 256 * j + 4 * lane) = hsp[k][j];
    BAR();
    lr_pass(HL, WL + 1024, acc2, l31, hh, (blk * 8 + 32) & 63);
#pragma unroll
    for (int rt = 0; rt < 2; ++rt)
#pragma unroll
        for (int r = 0; r < 16; r += 2) { float a0 = acc2[rt][r], a1 = acc2[rt][r + 1];
            if (wave < 4) { a0 = 1.f - 2.f * FRCP(1.f + FEXP(2.f * a0)); a1 = 1.f - 2.f * FRCP(1.f + FEXP(2.f * a1)); }
            const unsigned pk = CVTPK(a0, a1); const int rho = 32 * rt + (r & 3) + 8 * (r >> 2) + 4 * hh;
            LWA[(size_t)(rbase + rho) * 256 + 32 * wave + l31] = (bf16)(pk & 0xffffu); LWA[(size_t)(rbase + rho + 1) * 256 + 32 * wave + l31] = (bf16)(pk >> 16); }
    BAR();
}
__device__ __forceinline__ void tr_item(const float* W, int N, bf16* WT, int ldo, int row_off, int col_off, const float* mu, int mode, LAS float* scr, int item, int lane) {
    const int nblk = N / 32, kb = item / nblk, nb = item % nblk, k0 = 64 * kb, n0 = 32 * nb;
#pragma unroll 8
    for (int i = 0; i < 32; ++i) { const int kk = 2 * i + (lane >> 5); float s = 1.f; if (mode) { const float m_ = mu[k0 + kk]; s = mode == 1 ? 1.f - m_ : m_; }
        scr[kk * 33 + (lane & 31)] = W[(size_t)(k0 + kk) * N + n0 + (lane & 31)] * s; }
    LDS_WAIT(); asm volatile("" ::: "memory");
    const int c = lane & 7;
#pragma unroll
    for (int j = 0; j < 4; ++j) { const int n = (lane >> 3) + 8 * j; const LAS float* s = scr + (8 * c) * 33 + n;
        v4u o; o.x = pk2(s[0 * 33], s[1 * 33]); o.y = pk2(s[2 * 33], s[3 * 33]); o.z = pk2(s[4 * 33], s[5 * 33]); o.w = pk2(s[6 * 33], s[7 * 33]);
        *(v4u*)(WT + (size_t)(row_off + n0 + n) * ldo + col_off + k0 + 8 * c) = o; }
    LDS_WAIT(); asm volatile("" ::: "memory");
}
__device__ __forceinline__ void phase0(const Args& A, LAS unsigned char* lds, int tid, int lane, int wave) {
    __syncthreads();
    unsigned char* ws = A.ws;
    const int G = gridDim.x, blk = blockIdx.x;
    {
        LAS float* scond = (LAS float*)lds;
        LAS float* red = scond + 9 * 1024;
        bool filled = false;
        for (int item = blk; item < 96; item += G) {
            if (!filled) {
                for (int idx = tid; idx < 9 * 1024; idx += NTHR) { const int r = idx >> 10, k = idx & 1023; const float c = r == 0 ? A.in[I_CCTX][k] : A.in[I_C][(r - 1) * 1024 + k]; scond[idx] = silu_f(c); }
                filled = true;
            }
            __syncthreads();
            const int l = item / 48, g = item % 48, col = g * 64 + lane;
            float acc[9];
#pragma unroll
            for (int r = 0; r < 9; ++r) acc[r] = 0.f;
            const float* wp = A.in[I_WMOD] + ((size_t)l * 1024 + wave * 128) * 3072 + col;
#pragma unroll 4
            for (int k = 0; k < 128; ++k) { const float wv = wp[(size_t)k * 3072];
#pragma unroll
                for (int r = 0; r < 9; ++r) acc[r] += scond[r * 1024 + wave * 128 + k] * wv; }
#pragma unroll
            for (int r = 0; r < 9; ++r) red[(wave * 9 + r) * 64 + lane] = acc[r];
            __syncthreads();
            for (int idx = tid; idx < 576; idx += NTHR) { const int r = idx >> 6, ln = idx & 63; float s = A.in[I_BMOD][l * 3072 + g * 64 + ln];
#pragma unroll
                for (int w = 0; w < 8; ++w) s += red[(w * 9 + r) * 64 + ln];
                ((float*)(ws + WS_MOD))[(l * 9 + r) * 3072 + g * 64 + ln] = s; }
            __syncthreads();
        }
        __syncthreads();
    }
    LAS float* scr = (LAS float*)(lds + wave * 16384);
    const int gw = blk * NWAVES + wave, NGW = G * NWAVES;
    bf16* WIN = (bf16*)(ws + WS_WIN); bf16* WO0 = (bf16*)(ws + WS_WO0);
    constexpr int I_IN = 16 * 96, I_SQ = 16 * 32;
    constexpr int NITEMS = I_IN + I_SQ;
    for (int it = gw; it < NITEMS; it += NGW) {
        int r = it;
        if (r < I_IN) { tr_item(A.in[I_GWIN], 3072, WIN, 1024, 0, 0, nullptr, 0, scr, r, lane); continue; } r -= I_IN;
        tr_item(A.in[I_GWOUT], 1024, WO0, 1024, 0, 0, nullptr, 0, scr, r, lane);
    }
    const int gt = blk * NTHR + tid, NGT = G * NTHR;
    for (int idx = gt; idx < 2 * 16 * 1024; idx += NGT) { const int k = idx & 1023, j = (idx >> 10) & 15, d = idx >> 14;
        WIN[(size_t)(3072 + d * 16 + j) * 1024 + k] = (bf16)f2bf(A.in[I_GWA1][((size_t)d * 1024 + k) * 16 + j]); }
}

__device__ __forceinline__ void transposes_l1(const Args& A, LAS unsigned char* lds, int lane, int wave, int widx, int nw) {
    LAS float* scr = (LAS float*)(lds + wave * 16384);
    bf16* W4 = (bf16*)(A.ws + WS_W4); bf16* WO1 = (bf16*)(A.ws + WS_WO1);
    constexpr int I_SQ = 16 * 32, I_LR = 16 * 2;
    constexpr int NITEMS = 8 * I_SQ + 8 * I_LR + I_SQ;
    for (int it = widx; it < NITEMS; it += nw) {
        int r = it;
        if (r < 8 * I_SQ) { const int p = r / (2 * I_SQ), hf = (r / I_SQ) & 1; tr_item(A.in[I_WRKVG] + (size_t)p * 1024 * 1024, 1024, W4, 2048, p * 1024, hf * 1024, A.in[I_MU] + p * 1024, 1 + hf, scr, r % I_SQ, lane); continue; } r -= 8 * I_SQ;
        if (r < 8 * I_LR) { const int q = r / I_LR, which = q >> 2, d = (q >> 1) & 1, hf = q & 1;
            tr_item((which ? A.in[I_A1] : A.in[I_W1]) + (size_t)d * 1024 * 64, 64, W4, 2048, 4096 + which * 128 + d * 64, hf * 1024, A.in[I_MU] + (4 + which) * 1024, 1 + hf, scr, r % I_LR, lane); continue; } r -= 8 * I_LR;
        tr_item(A.in[I_RWOUT], 1024, WO1, 1024, 0, 0, nullptr, 0, scr, r, lane);
    }
}

__device__ __forceinline__ const float* xrow_in(const Args& A, int r) { return r < MP ? A.in[I_XP] + (size_t)r * D : A.in[I_XS] + (size_t)(r - MP) * D; }
__device__ __forceinline__ int cond_of(int r) { return r < MP ? 0 : 1 + ((r - MP) >> 10); }
__device__ __forceinline__ void store_bf4(bf16* p, f32x4 v) { *(unsigned long long*)p = (unsigned long long)pk2(v[0], v[1]) | ((unsigned long long)pk2(v[2], v[3]) << 32); }
__device__ __forceinline__ f32x4 load_bf4(const bf16* p) { const unsigned long long w = *(const unsigned long long*)p; const unsigned lo = (unsigned)w, hi = (unsigned)(w >> 32);
    return (f32x4){__uint_as_float(lo << 16), __uint_as_float(lo & 0xffff0000u), __uint_as_float(hi << 16), __uint_as_float(hi & 0xffff0000u)}; }

__device__ __forceinline__ void phase_og0(const Args& A, int lane, int gw, int NGW) {
    const bf16* OF = (const bf16*)(A.ws + WS_OF); const bf16* OB = (const bf16*)(A.ws + WS_OB); const bf16* G0 = (const bf16*)(A.ws + WS_G0); bf16* OG = (bf16*)(A.ws + WS_ABUF);
    const f32x4 wn = *(const f32x4*)(A.in[I_GNORM] + 4 * lane);
    for (int r = gw; r < M; r += NGW) {
#pragma unroll
        for (int j = 0; j < 4; ++j) { const size_t o = (size_t)r * D + 256 * j + 4 * lane; const f32x4 v = load_bf4(OF + o) + load_bf4(OB + o);
            const float ms = wave_sum((v[0] * v[0] + v[1] * v[1]) + (v[2] * v[2] + v[3] * v[3])) * (1.f / 256.f); const float rs = 1.f / sqrtf(ms + EPS);
            const f32x4 g = load_bf4(G0 + o); f32x4 y = v * rs * wn;
            y[0] *= silu_f(g[0]); y[1] *= silu_f(g[1]); y[2] *= silu_f(g[2]); y[3] *= silu_f(g[3]);
            store_bf4(OG + o, y); }
    }
}
__device__ __forceinline__ float row_rstd(const float* ssq, int r, int lane) { float s = lane < 16 ? ssq[(size_t)r * 16 + lane] : 0.f; return 1.f / sqrtf(wave_sum(s) * (1.f / D) + EPS); }
__device__ __forceinline__ void phase_og1(const Args& A, int lane, int gw, int NGW) {
    const bf16* YF = (const bf16*)(A.ws + WS_YF); const bf16* YB = (const bf16*)(A.ws + WS_YB); const bf16* V1 = (const bf16*)(A.ws + WS_V1); const bf16* G1 = (const bf16*)(A.ws + WS_G1);
    const float* BON = (const float*)(A.ws + WS_BONUS); bf16* OG = (bf16*)(A.ws + WS_OG1);
    for (int r = gw; r < M; r += NGW) {
#pragma unroll
        for (int j = 0; j < 4; ++j) { const int c = 256 * j + 4 * lane, h = c >> 6; const size_t o = (size_t)r * D + c; const f32x4 y = load_bf4(YF + o) + load_bf4(YB + o);
            float s = (y[0] + y[1]) + (y[2] + y[3]);
            s += __shfl_xor(s, 1); s += __shfl_xor(s, 2); s += __shfl_xor(s, 4); s += __shfl_xor(s, 8);
            const float mean = s * (1.f / 64.f); const f32x4 dv = y - mean; float q = (dv[0] * dv[0] + dv[1] * dv[1]) + (dv[2] * dv[2] + dv[3] * dv[3]);
            q += __shfl_xor(q, 1); q += __shfl_xor(q, 2); q += __shfl_xor(q, 4); q += __shfl_xor(q, 8);
            const float rs = 1.f / sqrtf(q * (1.f / 64.f) + LNX_EPS);
            const f32x4 lw = *(const f32x4*)(A.in[I_LNW] + c), lb = *(const f32x4*)(A.in[I_LNB] + c);
            const float bon = BON[((size_t)r * 16 + h) * 2] + BON[((size_t)r * 16 + h) * 2 + 1];
            const f32x4 v = load_bf4(V1 + o), g = load_bf4(G1 + o);
            f32x4 z = dv * rs * lw + lb + v * bon;
            z[0] *= silu_f(g[0]); z[1] *= silu_f(g[1]); z[2] *= silu_f(g[2]); z[3] *= silu_f(g[3]);
            store_bf4(OG + o, z); }
    }
}
__device__ __forceinline__ void phase_final(const Args& A, int lane, int gw, int NGW) {
    const float* ssq = (const float*)(A.ws + WS_SSQ2); const float* nf = A.in[I_NORMF];
    for (int r = gw; r < M; r += NGW) {
        const float rs = row_rstd(ssq, r, lane); f32x4* xr = (f32x4*)(A.out + (size_t)r * D) + lane;
#pragma unroll
        for (int j = 0; j < 4; ++j) { const f32x4 w = *(const f32x4*)(nf + 256 * j + 4 * lane); xr[64 * j] = xr[64 * j] * rs * w; }
    }
}

__global__ void __launch_bounds__(NTHR, 2) trunk_fwd(Args args) {
    extern __shared__ __attribute__((aligned(16))) unsigned char lds_raw[];
    LAS unsigned char* lds = (LAS unsigned char*)lds_raw;
    const int tid = threadIdx.x, lane = tid & 63, wave = __builtin_amdgcn_readfirstlane(tid >> 6);
    const int G = gridDim.x, gw = blockIdx.x * NWAVES + wave, NGW = G * NWAVES;
    volatile LAS unsigned* MISC = (volatile LAS unsigned*)(lds + MISC_OFF);
    for (int u = tid; u < (LDS_BYTES - LDSCTL_OFF) / 4; u += NTHR) ((LAS unsigned*)(lds + LDSCTL_OFF))[u] = 0u;
    __syncthreads();
    unsigned char* ws = args.ws;
    XcdBarrier bar; bar.bar = (unsigned*)(ws + WS_CTL) + CW_BAR; bar.x = 0; bar.st = nullptr;
    if (N_LAUNCHES == 1) bar = xcd_barrier_post((unsigned*)(ws + WS_CTL) + CW_BAR, MISC + 8);
    const int lo = args.ph_lo, hi = args.ph_hi;
#ifndef PROBE_MASK
#define PROBE_MASK 0
#endif
#define REP(k) for (int rep_ = 0; rep_ < (((PROBE_MASK) >> (k)) & 1) + 1; ++rep_)
#define IN(k) (lo <= (k) && (k) < hi)
#ifdef PROBE_EXTRA_BAR
#define SEAM(k) do { if (IN(k) && IN((k) + 1)) { xcd_barrier(bar); xcd_barrier(bar); } } while (0)
#else
#define SEAM(k) do { if (IN(k) && IN((k) + 1)) xcd_barrier(bar); } while (0)
#endif
    if (IN(0)) REP(0) { phase0(args, lds, tid, lane, wave); } SEAM(0);
    if (IN(1)) REP(1) { phase_h0_ha(args, lds, tid, (int)blockIdx.x); } SEAM(1);
    if (IN(2)) REP(2) {
        pg8::Gemm g{(const pg8::bf16_t*)(ws + WS_ABUF), (const pg8::bf16_t*)(ws + WS_WIN), M, 3072, 1024}; pg8::StaticOrder S; S.init(M, 3072, G, (int)blockIdx.x);
        pg8::EpiPlanes<0> E{ws};
        pg8::gemm_phase<pg8::EpiPlanes<0>, pg8::StaticOrder, true, true>(lds, g, S, E);
    } SEAM(2);
        if (IN(3)) REP(3) { phase_gla_chunk(args, lds, tid, (int)blockIdx.x); if (blockIdx.x >= 64) transposes_l1(args, lds, lane, wave, ((int)blockIdx.x - 64) * NWAVES + wave, (G - 64) * NWAVES); } SEAM(3);
    if (IN(4)) REP(4) { phase_og0(args, lane, gw, NGW); } SEAM(4);
    if (IN(5)) REP(5) {
        pg8::Gemm g{(const pg8::bf16_t*)(ws + WS_ABUF), (const pg8::bf16_t*)(ws + WS_WO0), M, 1024, 1024}; pg8::StaticOrder S; S.init(M, 1024, G, (int)blockIdx.x);
        pg8::EpiRes E{args.in[I_XP], args.in[I_XS], args.out, (const float*)(ws + WS_MOD) + 2048, (float*)(ws + WS_SSQ1)};
        pg8::gemm_phase<pg8::EpiRes, pg8::StaticOrder, true, true>(lds, g, S, E);
    } SEAM(5);
    if (IN(6)) REP(6) { phase_hh_lr(args, lds, tid, (int)blockIdx.x); } SEAM(6);
    if (IN(7)) REP(7) {
        pg8::Gemm g{(const pg8::bf16_t*)(ws + WS_HH), (const pg8::bf16_t*)(ws + WS_W4), M, 4096, 2048}; pg8::StaticOrder S; S.init(M, 4096, G, (int)blockIdx.x);
        pg8::EpiPlanes<1> E{ws};
        pg8::gemm_phase<pg8::EpiPlanes<1>, pg8::StaticOrder, true, true>(lds, g, S, E);
    } SEAM(7);
        if (IN(8)) REP(8) { phase_rwkv_chunk(args, lds, tid, (int)blockIdx.x, args.li >= 100 ? args.li - 100 : 0); } SEAM(8);
    if (IN(9)) REP(9) { phase_og1(args, lane, gw, NGW); } SEAM(9);
    if (IN(10)) REP(10) {
        pg8::Gemm g{(const pg8::bf16_t*)(ws + WS_OG1), (const pg8::bf16_t*)(ws + WS_WO1), M, 1024, 1024}; pg8::StaticOrder S; S.init(M, 1024, G, (int)blockIdx.x);
        pg8::EpiRes E{args.out, args.out + OUT_YS, args.out, (const float*)(ws + WS_MOD) + 9 * 3072 + 2048, (float*)(ws + WS_SSQ2)};
        pg8::gemm_phase<pg8::EpiRes, pg8::StaticOrder, true, true>(lds, g, S, E);
    } SEAM(10);
    if (IN(11)) REP(11) { phase_final(args, lane, gw, NGW); }
#undef IN
#undef SEAM
}

extern "C" void kernel_launch(void* const* d_in, const int* in_sizes, int n_in, void* d_out, int out_size, void* d_ws, size_t ws_size, hipStream_t stream) {
    static int grid = 0;
    if (grid == 0) {
        if (n_in != 30 || ws_size < WS_END) { fprintf(stderr, "kernel_launch: built for 30 inputs and >= %zu bytes of workspace; got n_in %d ws %zu\n", (size_t)WS_END, n_in, ws_size); grid = -1; return; }
        int dev = 0, cus = 0, per_cu = 0;
        if (hipGetDevice(&dev) != hipSuccess || hipDeviceGetAttribute(&cus, hipDeviceAttributeMultiprocessorCount, dev) != hipSuccess) { grid = -1; return; }
        if (hipFuncSetAttribute((const void*)trunk_fwd, hipFuncAttributeMaxDynamicSharedMemorySize, LDS_BYTES) != hipSuccess) { fprintf(stderr, "kernel_launch: hipFuncSetAttribute failed\n"); grid = -1; return; }
        if (hipOccupancyMaxActiveBlocksPerMultiprocessor(&per_cu, (const void*)trunk_fwd, NTHR, LDS_BYTES) != hipSuccess || per_cu < 1) { fprintf(stderr, "kernel_launch: occupancy query reports %d workgroups per CU\n", per_cu); per_cu = 1; }
        (void)hipGetLastError();
        grid = cus;
        if (grid > 256) grid = 256;
    }
    if (grid < 0) return;
    (void)hipMemsetAsync((char*)d_ws + WS_CTL, 0, CTL_ZERO_BYTES, stream);
    Args a{};
    for (int i = 0; i < 30; ++i) a.in[i] = (const float*)d_in[i];
    a.out = (float*)d_out; a.ws = (unsigned char*)d_ws;
    if (N_LAUNCHES == 1) {
        a.ph_lo = 0; a.ph_hi = N_PHASES; a.li = 0;
        void* kargs[] = {&a};
        hipError_t e = hipLaunchCooperativeKernel((const void*)trunk_fwd, dim3(grid), dim3(NTHR), kargs, LDS_BYTES, stream);
        if (e != hipSuccess) fprintf(stderr, "kernel_launch: cooperative launch failed: %s (grid %d)\n", hipGetErrorString(e), grid);
    } else {
        for (int li = 0; li < N_PHASES; ++li) { a.ph_lo = li; a.ph_hi = li + 1; a.li = li;
            hipLaunchKernelGGL(trunk_fwd, dim3(grid), dim3(NTHR), LDS_BYTES, stream, a);
#ifdef PROBE_LAUNCH_REPEAT
            if (li == PROBE_LAUNCH_REPEAT) hipLaunchKernelGGL(trunk_fwd, dim3(grid), dim3(NTHR), LDS_BYTES, stream, a);
#endif
#ifdef PROBE_RW_MODE
            if (li == 8) { a.li = 100 + PROBE_RW_MODE; hipLaunchKernelGGL(trunk_fwd, dim3(grid), dim3(NTHR), LDS_BYTES, stream, a); }
#endif
        }
    }
}
```

```cpp
#include <hip/hip_runtime.h>
#include <cstdio>
#include <cstdint>
constexpr int NWAVES = 8, NTHR = 512;
#ifndef MK_N_LAUNCHES
#define MK_N_LAUNCHES 1
#endif
constexpr int N_PHASES = 12;
constexpr int N_LAUNCHES = MK_N_LAUNCHES;
constexpr int M = 16384, D = 1024, MP = 8192;
constexpr float EPS = 1e-6f, LNX_EPS = 64e-5f;
constexpr size_t OUT_YS = (size_t)MP * D, OUT_SG = (size_t)M * D, OUT_SR = OUT_SG + (size_t)32 * 2 * 4 * 128 * 256;
constexpr size_t MiB = 1u << 20;
constexpr size_t WS_CTL = 0, CTL_ZERO_BYTES = 1 * MiB;
constexpr size_t WS_MOD = 1 * MiB;
constexpr size_t WS_SSQ1 = 2 * MiB, WS_SSQ2 = 3 * MiB;
constexpr size_t WS_BONUS = 4 * MiB;
constexpr size_t WS_HA = 6 * MiB;
constexpr size_t WS_WIN = 8 * MiB;
constexpr size_t WS_WO0 = 15 * MiB;
constexpr size_t WS_W4 = 17 * MiB;
constexpr size_t WS_WO1 = 34 * MiB;
constexpr size_t WS_ABUF = 38 * MiB;
constexpr size_t WS_Q0 = 70 * MiB, WS_K0 = 86 * MiB, WS_V0 = 102 * MiB, WS_G0 = 134 * MiB, WS_OF = 166 * MiB, WS_OB = 198 * MiB;
constexpr size_t WS_HH = 38 * MiB;
constexpr size_t WS_YF = 38 * MiB, WS_YB = 70 * MiB;
constexpr size_t WS_R1 = 102 * MiB, WS_K1 = 134 * MiB, WS_V1 = 166 * MiB, WS_G1 = 198 * MiB;
constexpr size_t WS_LWA = 230 * MiB;
constexpr size_t WS_OG1 = 102 * MiB;
constexpr size_t WS_END = 246 * MiB;
constexpr int CW_BAR = 4096;
constexpr int RING_BYTES = 131072, LDSCTL_OFF = 146944, MISC_OFF = LDSCTL_OFF + 320, LDS_BYTES = 147456;


struct Args { const float* in[30]; float* out; unsigned char* ws; int ph_lo, ph_hi, li, pad; };
enum { I_XP = 0, I_XS, I_SG, I_SR, I_C, I_CCTX, I_WMOD, I_BMOD, I_NORMW, I_GWIN, I_GWA1, I_GWA2, I_GBA, I_GNORM, I_GWOUT, I_MU, I_WRKVG, I_W0, I_W1, I_W2, I_A0, I_A1, I_A2, I_KK, I_KA, I_RK, I_LNW, I_LNB, I_RWOUT, I_NORMF };

namespace pg8 {
#define PG8_LAS __attribute__((address_space(3)))
typedef unsigned short bf16_t;
typedef short bf16x8 __attribute__((ext_vector_type(8)));
typedef float f32x4 __attribute__((ext_vector_type(4)));
typedef unsigned u32x4 __attribute__((ext_vector_type(4)));
constexpr int BM = 256, BK = 64, HALF = 128, HTB = HALF * BK * 2  , STAGE_BYTES = 8 * HTB, NXCD = 8, WGM = 8;

__host__ __device__ __forceinline__ int lds_byte(int r, int c) { const int st = (r >> 4) * 2 + (c >> 5), rr = r & 15, cc = c & 31, ob = rr * 64 + cc * 2; return st * 1024 + (ob ^ (((ob >> 9) & 1) << 5)); }
__host__ __device__ __forceinline__ void stage_rc(int b, int& R, int& C) { const int st = b / 1024, sb = b % 1024, swz = sb ^ (((sb >> 9) & 1) << 5); R = (st >> 1) * 16 + swz / 64; C = (st & 1) * 32 + (swz % 64) / 2; }
__host__ __device__ __forceinline__ int perm32(int rho) { const int n = rho >> 4, i = rho & 15; return 8 * (i >> 2) + 4 * n + (i & 3); }

struct Unit { int pm, pn; };
struct Gemm { const bf16_t* A; const bf16_t* Bt; int M, N, K; };

struct StaticOrder {
    int nM, nN, nwg, G, c;
    __host__ __device__ void init(int M, int N, int G_, int c_) { nM = M / BM; nN = N / BM; nwg = nM * nN; G = G_; c = c_; }
    __host__ __device__ bool next(int i, Unit& u) const {
        const long L = (long)i * G + c; if (L >= nwg) return false;
        int wgid = (int)L; { const int q = nwg / NXCD, r = nwg % NXCD, xcd = wgid % NXCD, off = wgid / NXCD; wgid = (xcd < r ? xcd * (q + 1) : r * (q + 1) + (xcd - r) * q) + off; }
        const int nig = WGM * nN, gid = wgid / nig, fm = gid * WGM, gsz = (nM - fm) < WGM ? (nM - fm) : WGM;
        u.pm = fm + ((wgid % nig) % gsz); u.pn = (wgid % nig) / gsz; return true;
    }
    __device__ __forceinline__ void a_ready(const Unit&) const {}
    __device__ __forceinline__ void done(const Unit&) const {}
};

__device__ __forceinline__ unsigned cvt_pk_bf16(float lo, float hi) { unsigned r; asm volatile("v_cvt_pk_bf16_f32 %0, %1, %2" : "=v"(r) : "v"(lo), "v"(hi)); return r; }
template <int L> struct EpiPlanes {
    static constexpr bool PERM = true, AFTER_DRAIN = false;
    unsigned char* ws;
    __device__ __forceinline__ void operator()(const f32x4 (&acc)[2][2][4][2], const Unit& u, int wr, int wc, int fr, int fq) const {
        constexpr int T1 = L ? 4 : 2, T2 = L ? 8 : 4, T3 = L ? 12 : 8, T4 = L ? 16 : 12, LRC = L ? 256 : 32, LRLD = L ? 256 : 32;
        constexpr size_t O0 = L ? WS_R1 : WS_Q0, O1 = L ? WS_K1 : WS_K0, O2 = L ? WS_V1 : WS_V0, O3 = L ? WS_G1 : WS_G0, OLR = L ? WS_LWA : WS_HA;
        constexpr int LD01 = L ? 1024 : 512;
        const int row0 = u.pm * BM + wr * 64 + fr;
        if (u.pn >= T4) {
            if constexpr (L == 0) {
                float* lr = (float*)(ws + OLR);
#pragma unroll
                for (int ai = 0; ai < 2; ++ai)
#pragma unroll
                    for (int m = 0; m < 4; ++m) { float* rowp = lr + (size_t)(row0 + ai * HALF + m * 16) * LRLD;
#pragma unroll
                        for (int bj = 0; bj < 2; ++bj)
#pragma unroll
                            for (int n = 0; n < 2; ++n) { const int col = bj * HALF + wc * 32 + 8 * fq + 4 * n; if (col < LRC) *(f32x4*)(rowp + col) = acc[ai][bj][m][n]; } }
            } else {
                bf16_t* lr = (bf16_t*)(ws + OLR);
#pragma unroll
                for (int ai = 0; ai < 2; ++ai)
#pragma unroll
                    for (int m = 0; m < 4; ++m) { bf16_t* rowp = lr + (size_t)(row0 + ai * HALF + m * 16) * 256 + wc * 32 + 8 * fq;
#pragma unroll
                        for (int bj = 0; bj < 2; ++bj) { f32x4 v0 = acc[ai][bj][m][0], v1 = acc[ai][bj][m][1];
                            if (bj == 0) {
#pragma unroll
                                for (int c = 0; c < 4; ++c) { v0[c] = 1.f - 2.f * __builtin_amdgcn_rcpf(1.f + __expf(2.f * v0[c])); v1[c] = 1.f - 2.f * __builtin_amdgcn_rcpf(1.f + __expf(2.f * v1[c])); } }
                            u32x4 w; w.x = cvt_pk_bf16(v0[0], v0[1]); w.y = cvt_pk_bf16(v0[2], v0[3]); w.z = cvt_pk_bf16(v1[0], v1[1]); w.w = cvt_pk_bf16(v1[2], v1[3]);
                            *(u32x4*)(rowp + bj * HALF) = w; } }
            }
            return;
        }
        const int pn = u.pn;
        const size_t off = pn < T1 ? O0 : pn < T2 ? O1 : pn < T3 ? O2 : O3;
        const int ld = pn < T2 ? LD01 : 1024, ts = pn < T1 ? 0 : pn < T2 ? T1 : pn < T3 ? T2 : T3;
        bf16_t* base = (bf16_t*)(ws + off);
        const int col0 = (pn - ts) * BM + wc * 32 + 8 * fq;
#pragma unroll
        for (int ai = 0; ai < 2; ++ai)
#pragma unroll
            for (int m = 0; m < 4; ++m) { bf16_t* rowp = base + (size_t)(row0 + ai * HALF + m * 16) * ld + col0;
#pragma unroll
                for (int bj = 0; bj < 2; ++bj) { const f32x4 v0 = acc[ai][bj][m][0], v1 = acc[ai][bj][m][1];
                    u32x4 w; w.x = cvt_pk_bf16(v0[0], v0[1]); w.y = cvt_pk_bf16(v0[2], v0[3]); w.z = cvt_pk_bf16(v1[0], v1[1]); w.w = cvt_pk_bf16(v1[2], v1[3]);
                    *(u32x4*)(rowp + bj * HALF) = w; } }
    }
};
struct EpiRes {
    static constexpr bool PERM = false, AFTER_DRAIN = false;
    const float* bp; const float* bs;
    float* out;
    const float* gate;
    float* ssq;
    __device__ __forceinline__ void operator()(const f32x4 (&acc)[2][2][4][2], const Unit& u, int wr, int wc, int fr, int fq) const {
#pragma unroll
        for (int ai = 0; ai < 2; ++ai)
#pragma unroll
            for (int m = 0; m < 4; ++m) {
                const int r = u.pm * BM + ai * HALF + wr * 64 + m * 16 + fr;
                const int ci = r < 8192 ? 0 : 1 + ((r - 8192) >> 10);
                const float* brow = r < 8192 ? bp + (size_t)r * 1024 : bs + (size_t)(r - 8192) * 1024;
                float* orow = out + (size_t)r * 1024; const float* grow = gate + ci * 3072;
                float s = 0.f;
#pragma unroll
                for (int bj = 0; bj < 2; ++bj)
#pragma unroll
                    for (int n = 0; n < 2; ++n) { const int c = u.pn * BM + bj * HALF + wc * 32 + n * 16 + 4 * fq;
                        const f32x4 b = *(const f32x4*)(brow + c), g = *(const f32x4*)(grow + c); const f32x4 o = b + g * acc[ai][bj][m][n];
                        *(f32x4*)(orow + c) = o; s += (o[0] * o[0] + o[1] * o[1]) + (o[2] * o[2] + o[3] * o[3]); }
                s += __shfl_xor(s, 16); s += __shfl_xor(s, 32);
                if (fq == 0) ssq[(size_t)r * 16 + u.pn * 4 + wc] = s;
            }
    }
};

template <class Epi, class Sched, bool ALIGN_EPI = false, bool SP2 = false>
__device__ __forceinline__ void gemm_phase(PG8_LAS unsigned char* lds, const Gemm g, const Sched& S, const Epi& E) {
    const int tid = threadIdx.x, wid = __builtin_amdgcn_readfirstlane(tid >> 6), lane = tid & 63, wr = wid >> 2, wc = wid & 3, fr = lane & 15, fq = lane >> 4;
    const int K = g.K, nt = K / BK;
    unsigned voffA[2], voffB[2];
#pragma unroll
    for (int i = 0; i < 2; ++i) { int R, C; stage_rc(tid * 16 + i * 8192, R, C); const int Rb = Epi::PERM ? ((R & ~31) + perm32(R & 31)) : R;
        voffA[i] = (unsigned)(R * K + C) * 2u; voffB[i] = (unsigned)(Rb * K + C) * 2u; }
    const size_t kstep = (size_t)(BK * 2);
    const size_t hstep = (size_t)HALF * K * 2;
    const size_t tstep = 2 * hstep;
    const unsigned ldsw = (unsigned)wid * 1024u;
    const int aoff = lds_byte(wr * 64 + fr, fq * 8), boff = lds_byte(wc * 32 + fr, fq * 8);
#define PG8_SA(b, h) (((b) * 2 + (h)) * HTB)
#define PG8_SB(b, h) ((4 + (b) * 2 + (h)) * HTB)
#define PG8_STAGE(bufoff, gbase, voff) do { _Pragma("unroll") for (int _i = 0; _i < 2; ++_i) \
        __builtin_amdgcn_global_load_lds((const unsigned*)((const char*)(gbase) + (voff)[_i]), (PG8_LAS unsigned*)(lds + (bufoff) + ldsw + _i * 8192), 16, 0, 0); } while (0)
#define PG8_LDA(dst, b, h) do { _Pragma("unroll") for (int m = 0; m < 4; ++m) _Pragma("unroll") for (int k = 0; k < 2; ++k) dst[m][k] = *(const PG8_LAS bf16x8*)(lds + PG8_SA(b, h) + aoff + m * 2048 + k * 1024); } while (0)
#define PG8_LDB(dst, b, h) do { _Pragma("unroll") for (int n = 0; n < 2; ++n) _Pragma("unroll") for (int k = 0; k < 2; ++k) dst[n][k] = *(const PG8_LAS bf16x8*)(lds + PG8_SB(b, h) + boff + n * 2048 + k * 1024); } while (0)
#define PG8_MMA(ai, bj, At, Bt) do { __builtin_amdgcn_s_setprio(1); _Pragma("unroll") for (int m = 0; m < 4; ++m) _Pragma("unroll") for (int n = 0; n < 2; ++n) _Pragma("unroll") for (int k = 0; k < 2; ++k) \
        acc[ai][bj][m][n] = __builtin_amdgcn_mfma_f32_16x16x32_bf16(Bt[n][k], At[m][k], acc[ai][bj][m][n], 0, 0, 0); __builtin_amdgcn_s_setprio(0); } while (0)
#define PG8_WAIT_V(n) asm volatile("s_waitcnt vmcnt(" #n ")" ::: "memory")
#define PG8_WAIT_L(n) asm volatile("s_waitcnt lgkmcnt(" #n ")" ::: "memory")
#define PG8_BAR __builtin_amdgcn_s_barrier()
#define PG8_SCHED __builtin_amdgcn_sched_barrier(0)
    Unit cur, nxt; int ui = 0;
    if (!S.next(0, cur)) return;
    f32x4 acc[2][2][4][2];
#pragma unroll
    for (int a = 0; a < 2; ++a)
#pragma unroll
        for (int b = 0; b < 2; ++b)
#pragma unroll
            for (int m = 0; m < 4; ++m)
#pragma unroll
                for (int n = 0; n < 2; ++n) acc[a][b][m][n] = (f32x4){0.f, 0.f, 0.f, 0.f};
    bf16x8 At[4][2], B0[2][2], B1[2][2];
    const char* cA = (const char*)g.A + (size_t)cur.pm * tstep; const char* cB = (const char*)g.Bt + (size_t)cur.pn * tstep;
    S.a_ready(cur);
    if constexpr (SP2) {
        PG8_STAGE(PG8_SB(0, 0), cB, voffB); PG8_STAGE(PG8_SB(0, 1), cB + hstep, voffB); PG8_STAGE(PG8_SA(0, 0), cA, voffA); PG8_STAGE(PG8_SA(0, 1), cA + hstep, voffA);
        if (wr == 1) PG8_BAR;
        PG8_WAIT_V(2); PG8_BAR;
        PG8_STAGE(PG8_SB(1, 0), cB + kstep, voffB); PG8_STAGE(PG8_SA(1, 0), cA + kstep, voffA); PG8_STAGE(PG8_SB(1, 1), cB + hstep + kstep, voffB);
        PG8_WAIT_V(6); PG8_BAR;
    } else {
        PG8_STAGE(PG8_SB(0, 0), cB, voffB); PG8_STAGE(PG8_SA(0, 0), cA, voffA); PG8_STAGE(PG8_SB(0, 1), cB + hstep, voffB); PG8_STAGE(PG8_SA(0, 1), cA + hstep, voffA);
        if (wr == 1) PG8_BAR;
        PG8_WAIT_V(4); PG8_BAR;
        PG8_STAGE(PG8_SB(1, 0), cB + kstep, voffB); PG8_STAGE(PG8_SA(1, 0), cA + kstep, voffA); PG8_STAGE(PG8_SB(1, 1), cB + hstep + kstep, voffB);
        PG8_WAIT_V(6); PG8_BAR;
    }
    for (;;) {
        const bool has_next = S.next(ui + 1, nxt);
        const char* nA = has_next ? (const char*)g.A + (size_t)nxt.pm * tstep : cA; const char* nB = has_next ? (const char*)g.Bt + (size_t)nxt.pn * tstep : cB;
        for (int t = 0; t < nt; t += 2) {
            const bool last = (t == nt - 2);
            const char* a1 = cA + (size_t)(t + 1) * kstep;
            const char* a2 = last ? nA : cA + (size_t)(t + 2) * kstep; const char* b2 = last ? nB : cB + (size_t)(t + 2) * kstep;
            const char* a3 = a2 + kstep; const char* b3 = b2 + kstep;
            if (last && has_next) S.a_ready(nxt);
            if constexpr (SP2) {
            PG8_LDB(B0, 0, 0); PG8_LDB(B1, 0, 1); PG8_SCHED; PG8_LDA(At, 0, 0); PG8_STAGE(PG8_SA(1, 1), a1 + hstep, voffA);
            PG8_WAIT_V(8); PG8_WAIT_L(0); PG8_BAR; PG8_MMA(0, 0, At, B0); PG8_MMA(0, 1, At, B1); PG8_BAR; PG8_SCHED;
            PG8_LDA(At, 0, 1); PG8_STAGE(PG8_SB(0, 0), b2, voffB); PG8_STAGE(PG8_SB(0, 1), b2 + hstep, voffB); PG8_STAGE(PG8_SA(0, 0), a2, voffA);
            PG8_WAIT_V(8); PG8_WAIT_L(0); PG8_BAR; PG8_MMA(1, 0, At, B0); PG8_MMA(1, 1, At, B1); PG8_BAR; PG8_SCHED;
            PG8_LDB(B0, 1, 0); PG8_LDB(B1, 1, 1); PG8_SCHED; PG8_LDA(At, 1, 0); PG8_STAGE(PG8_SA(0, 1), a2 + hstep, voffA);
            PG8_WAIT_V(8); PG8_WAIT_L(0); PG8_BAR; PG8_MMA(0, 0, At, B0); PG8_MMA(0, 1, At, B1); PG8_BAR; PG8_SCHED;
            PG8_LDA(At, 1, 1); PG8_STAGE(PG8_SB(1, 0), b3, voffB); PG8_STAGE(PG8_SB(1, 1), b3 + hstep, voffB); PG8_STAGE(PG8_SA(1, 0), a3, voffA);
            PG8_WAIT_V(8); PG8_WAIT_L(0); PG8_BAR; PG8_MMA(1, 0, At, B0); PG8_MMA(1, 1, At, B1); PG8_BAR; PG8_SCHED;
            } else {
            PG8_LDB(B0, 0, 0); PG8_SCHED; PG8_LDA(At, 0, 0); PG8_STAGE(PG8_SA(1, 1), a1 + hstep, voffA);
            PG8_WAIT_L(8); PG8_BAR; PG8_WAIT_L(0); PG8_MMA(0, 0, At, B0); PG8_BAR; PG8_SCHED;
            PG8_LDB(B1, 0, 1); PG8_STAGE(PG8_SB(0, 0), b2, voffB);
            PG8_BAR; PG8_WAIT_L(0); PG8_MMA(0, 1, At, B1); PG8_BAR;
            PG8_LDA(At, 0, 1); PG8_STAGE(PG8_SA(0, 0), a2, voffA);
            PG8_BAR; PG8_WAIT_L(0); PG8_MMA(1, 0, At, B0); PG8_BAR; PG8_SCHED;
            PG8_STAGE(PG8_SB(0, 1), b2 + hstep, voffB);
            PG8_WAIT_V(6); PG8_BAR; PG8_MMA(1, 1, At, B1); PG8_BAR;
            PG8_LDB(B0, 1, 0); PG8_SCHED; PG8_LDA(At, 1, 0); PG8_STAGE(PG8_SA(0, 1), a2 + hstep, voffA);
            PG8_WAIT_L(8); PG8_BAR; PG8_WAIT_L(0); PG8_MMA(0, 0, At, B0); PG8_BAR; PG8_SCHED;
            PG8_LDB(B1, 1, 1); PG8_STAGE(PG8_SB(1, 0), b3, voffB);
            PG8_BAR; PG8_WAIT_L(0); PG8_MMA(0, 1, At, B1); PG8_BAR;
            PG8_LDA(At, 1, 1); PG8_STAGE(PG8_SA(1, 0), a3, voffA);
            PG8_BAR; PG8_WAIT_L(0); PG8_MMA(1, 0, At, B0); PG8_BAR; PG8_SCHED;
            PG8_STAGE(PG8_SB(1, 1), b3 + hstep, voffB);
            PG8_WAIT_V(6); PG8_BAR; PG8_MMA(1, 1, At, B1); PG8_BAR;
            }
        }
        if constexpr (ALIGN_EPI) { if (wr == 0) PG8_BAR; }
        if constexpr (!Epi::AFTER_DRAIN) { E(acc, cur, wr, wc, fr, fq); S.done(cur); }
        if (!has_next) break;
#pragma unroll
        for (int a = 0; a < 2; ++a)
#pragma unroll
            for (int b = 0; b < 2; ++b)
#pragma unroll
                for (int m = 0; m < 4; ++m)
#pragma unroll
                    for (int n = 0; n < 2; ++n) acc[a][b][m][n] = (f32x4){0.f, 0.f, 0.f, 0.f};
        cur = nxt; cA = nA; cB = nB; ++ui;
        if constexpr (ALIGN_EPI) { if (wr == 1) PG8_BAR; }
    }
    PG8_WAIT_V(0);
    if constexpr (!ALIGN_EPI) { if (wr == 0) PG8_BAR; }
    PG8_BAR;
    if constexpr (Epi::AFTER_DRAIN) { E.fused(acc, cur, wr, wc, fr, fq, lds, wid, lane); S.done(cur); }
#undef PG8_SA
#undef PG8_SB
#undef PG8_STAGE
#undef PG8_LDA
#undef PG8_LDB
#undef PG8_MMA
#undef PG8_WAIT_V
#undef PG8_WAIT_L
#undef PG8_BAR
#undef PG8_SCHED
}
}
#define GAS __attribute__((address_space(1)))
#define LAS __attribute__((address_space(3)))
typedef unsigned short bf16;
typedef unsigned v4u __attribute__((ext_vector_type(4)));
typedef float f32x4 __attribute__((ext_vector_type(4)));
typedef short bf16x8 __attribute__((ext_vector_type(8)));
typedef GAS unsigned gu32;
typedef GAS unsigned long long gu64;
#define RLX_AGENT __ATOMIC_RELAXED, __HIP_MEMORY_SCOPE_AGENT
#define LDS_WAIT() asm volatile("s_waitcnt lgkmcnt(0)" ::: "memory")
#define VM_WAIT() asm volatile("s_waitcnt vmcnt(0)" ::: "memory")
__device__ __forceinline__ unsigned long long rt() { return __builtin_amdgcn_s_memrealtime(); }
__device__ __forceinline__ unsigned f2bf(float f) { unsigned u = __builtin_bit_cast(unsigned, f); return (u + 0x7fffu + ((u >> 16) & 1u)) >> 16; }
__device__ __forceinline__ unsigned pk2(float lo, float hi) { return f2bf(lo) | (f2bf(hi) << 16); }

#define XB_TMO      128
#define XB_XCNT(j)  (256  + 64 * (j))
#define XB_XSUB(j)  (1280 + 64 * (j))
#define XB_XGEN(j)  (2304 + 64 * (j))
#define XB_TOP      3328
#define XB_TOPGEN   3392
#define XCD_BAR_WORDS 3456
#define XB_SPIN_CAP (1u << 18)

__device__ __forceinline__ unsigned xb_ld(unsigned* p)              { return __hip_atomic_load(p, __ATOMIC_RELAXED, __HIP_MEMORY_SCOPE_AGENT); }
__device__ __forceinline__ unsigned xb_add(unsigned* p, unsigned v) { return __hip_atomic_fetch_add(p, v, __ATOMIC_RELAXED, __HIP_MEMORY_SCOPE_AGENT); }
__device__ __forceinline__ unsigned xb_xcc_id() { return (unsigned)__builtin_amdgcn_s_getreg((3 << 11) | 20) & 0xFu; }
#define XB_SPIN(cond, bar) do { unsigned _sp = 0; while (cond) { __builtin_amdgcn_s_sleep(1); \
    if ((++_sp & 255u) == 0u) { if (xb_ld(&(bar)[XB_TMO])) break; if (_sp > XB_SPIN_CAP) { atomicAdd(&(bar)[XB_TMO], 1u); break; } } } } while (0)

struct XcdBarrier {
    unsigned* bar; unsigned x;
    volatile LAS unsigned* st;
};

__device__ __forceinline__ XcdBarrier xcd_barrier_post(unsigned* bar, volatile LAS unsigned* st) {
    XcdBarrier b; b.bar = bar; b.x = xb_xcc_id(); b.st = st;
    if (threadIdx.x == 0) (void)xb_add(&bar[XB_XCNT(b.x)], 1u);
    return b;
}
__device__ __forceinline__ void xcd_barrier_complete(unsigned* bar, unsigned x, unsigned& nloc, unsigned& nx) {
    const unsigned G = gridDim.x * gridDim.y * gridDim.z;
    unsigned sum, cnt, mine, sp = 0u;
    for (;;) {
        sum = 0u; cnt = 0u; mine = 0u;
#pragma unroll
        for (unsigned j = 0; j < 16; ++j) { const unsigned c = xb_ld(&bar[XB_XCNT(j)]); sum += c; cnt += (c > 0u) ? 1u : 0u; mine = (j == x) ? c : mine; }
        if (sum == G) break;
        __builtin_amdgcn_s_sleep(1);
        if ((++sp & 255u) == 0u) { if (xb_ld(&bar[XB_TMO])) break; if (sp > XB_SPIN_CAP) { atomicAdd(&bar[XB_TMO], 1u); break; } }
    }
    nloc = mine > 0u ? mine : 1u; nx = cnt > 0u ? cnt : 1u;
}

__device__ __forceinline__ void xcd_barrier(const XcdBarrier& b) {
    asm volatile("s_waitcnt vmcnt(0)" ::: "memory");
    __syncthreads();
    if (threadIdx.x == 0) {
        unsigned* bar = b.bar;
        __builtin_amdgcn_s_waitcnt(0);
        unsigned nloc = b.st[0], nx = b.st[1];
        if (nloc == 0u) { xcd_barrier_complete(bar, b.x, nloc, nx); b.st[0] = nloc; b.st[1] = nx; }
        const unsigned old = xb_add(&bar[XB_XSUB(b.x)], 1u);
        const unsigned gen = old / nloc;
        if (old + 1u == (gen + 1u) * nloc) {
            __builtin_amdgcn_fence(__ATOMIC_RELEASE, "agent");
            asm volatile("s_waitcnt vmcnt(0)" ::: "memory");
            const unsigned og = xb_add(&bar[XB_TOP], 1u);
            const unsigned tg = og / nx;
            if (og + 1u == (tg + 1u) * nx) xb_add(&bar[XB_TOPGEN], 1u);
            else XB_SPIN(xb_ld(&bar[XB_TOPGEN]) == tg, bar);
            __builtin_amdgcn_fence(__ATOMIC_ACQUIRE, "agent");
            xb_add(&bar[XB_XGEN(b.x)], 1u);
            asm volatile("s_waitcnt vmcnt(0)" ::: "memory");
        } else {
            XB_SPIN(xb_ld(&bar[XB_XGEN(b.x)]) == gen, bar);
            __builtin_amdgcn_fence(__ATOMIC_ACQUIRE, "agent");
            asm volatile("s_waitcnt vmcnt(0)" ::: "memory");
        }
    }
    __syncthreads();
}

typedef float f32x16 __attribute__((ext_vector_type(16)));
typedef unsigned v2u __attribute__((ext_vector_type(2)));
#define BAR() __syncthreads()
#define MFMA32(a, b, c) __builtin_amdgcn_mfma_f32_32x32x16_bf16(a, b, c, 0, 0, 0)
#define MFMA16(a, b, c) __builtin_amdgcn_mfma_f32_16x16x32_bf16(a, b, c, 0, 0, 0)
#define SHFLX(v, m) __shfl_xor(v, m)
#define RFL(x) __builtin_amdgcn_readfirstlane(x)
#define FORCEINLINE __device__ __forceinline__
template <int CTRL> __device__ __forceinline__ float dppf(float v) { return __builtin_bit_cast(float, __builtin_amdgcn_update_dpp(0, __builtin_bit_cast(int, v), CTRL, 0xF, 0xF, true)); }
#define RED16(x) do { x += dppf<0xB1>(x); x += dppf<0x4E>(x); x += dppf<0x141>(x); x += dppf<0x140>(x); } while (0)
#define BAR_LDS() do { asm volatile("s_waitcnt lgkmcnt(0)" ::: "memory"); __builtin_amdgcn_s_barrier(); asm volatile("" ::: "memory"); } while (0)
#define SETPRIO(x) __builtin_amdgcn_s_setprio(x)
__device__ __forceinline__ float swap32_lo(float a, float b) { const auto r = __builtin_amdgcn_permlane32_swap(__float_as_uint(a), __float_as_uint(b), false, false); return __uint_as_float(r[0]); }
__device__ __forceinline__ unsigned swap32_hi2lo(unsigned x) { const auto r = __builtin_amdgcn_permlane32_swap(x, x, false, false); return r[1]; }
#define SWAP32_LO(a, b) swap32_lo(a, b)
#define SWAP32_HI2LO(x) swap32_hi2lo(x)
#define COMPILER_FENCE() asm volatile("" ::: "memory")
#define SPIN_UNTIL_GE(ptr, target) do { while (*(volatile LAS unsigned*)(ptr) < (target)) __builtin_amdgcn_s_sleep(1); asm volatile("" ::: "memory"); } while (0)
#define FEXP(x) __expf(x)
#define FRCP(x) __builtin_amdgcn_rcpf(x)
#define FRSQ(x) __builtin_amdgcn_rsqf(x)
#define FLOG(x) __logf(x)
typedef float cvt_f2 __attribute__((ext_vector_type(2))); typedef __bf16 cvt_b2 __attribute__((ext_vector_type(2)));
__device__ __forceinline__ unsigned CVTPK(float lo, float hi) { const cvt_f2 v = {lo, hi}; return __builtin_bit_cast(unsigned, __builtin_convertvector(v, cvt_b2)); }
__device__ __forceinline__ float bf2f(unsigned short b) { return __uint_as_float(((unsigned)b) << 16); }
__device__ __forceinline__ float wave_sum(float v) {
#pragma unroll
    for (int o = 1; o < 64; o <<= 1) v += __shfl_xor(v, o);
    return v;
}
__device__ __forceinline__ float silu_f(float x) { return x / (1.f + __expf(-x)); }

constexpr int GL_QB = 0;
constexpr int GL_KB = GL_QB + 64 * 272;
constexpr int GL_KDT = GL_KB + 64 * 272;
constexpr int GL_VT = GL_KDT + 128 * 144;
constexpr int GL_SC = GL_VT + 256 * 144;
constexpr int GL_DEC = GL_SC + 64 * 144;
constexpr int GL_TOT = GL_DEC + 512;
constexpr int GL_BG = GL_TOT + 2048;
constexpr int GL_END = GL_BG + 64 * 132 * 4;
static_assert(GL_END <= 146944, "GLA LDS map");

struct GlRaw { f32x4 h0, h1; v4u q0, q1, k0, k1; v4u v[4]; };
FORCEINLINE void gla_load(const Args& A, GlRaw& w, int ch, int T, int d, int row0, int h, int tid) {
    const bf16* Q0 = (const bf16*)(A.ws + WS_Q0); const bf16* K0 = (const bf16*)(A.ws + WS_K0); const bf16* V0 = (const bf16*)(A.ws + WS_V0); const float* HA = (const float*)(A.ws + WS_HA);
    const int lane = tid & 63, wave = RFL(tid >> 6), l31 = lane & 31, hh = lane >> 5, tt = wave >> 2;
    const int tau = 16 * ((l31 >> 2) & 1) + (l31 & 3) + 4 * (l31 >> 3);
    { const int s = 64 * ch + 32 * tt + tau, t = d ? T - 1 - s : s; const float* ha = HA + ((size_t)row0 + t) * 32 + d * 16 + 8 * hh; w.h0 = *(const f32x4*)ha; w.h1 = *(const f32x4*)(ha + 4); }
    { const int jb = 16 * wave, s = 64 * ch + lane, t = d ? T - 1 - s : s; const size_t row = (size_t)row0 + t;
        w.q0 = *(const v4u*)(Q0 + row * 512 + h * 128 + jb); w.q1 = *(const v4u*)(Q0 + row * 512 + h * 128 + jb + 8); w.k0 = *(const v4u*)(K0 + row * 512 + h * 128 + jb); w.k1 = *(const v4u*)(K0 + row * 512 + h * 128 + jb + 8);
        const bf16* vrow = V0 + row * 1024 + h * 256;
#pragma unroll
        for (int i4 = 0; i4 < 4; ++i4) w.v[i4] = *(const v4u*)(vrow + (wave * 4 + i4) * 8); }
}

FORCEINLINE void phase_gla_chunk(const Args& A, LAS unsigned char* lds, int tid, int blk) {
    LAS bf16* QB = (LAS bf16*)(lds + GL_QB); LAS bf16* KB = (LAS bf16*)(lds + GL_KB); LAS bf16* KDT = (LAS bf16*)(lds + GL_KDT); LAS bf16* VT = (LAS bf16*)(lds + GL_VT);
    LAS bf16* SC = (LAS bf16*)(lds + GL_SC); LAS float* DEC = (LAS float*)(lds + GL_DEC); LAS float* TOT = (LAS float*)(lds + GL_TOT); LAS float* BG = (LAS float*)(lds + GL_BG);
    const bf16* Q0 = (const bf16*)(A.ws + WS_Q0); const bf16* K0 = (const bf16*)(A.ws + WS_K0); const bf16* V0 = (const bf16*)(A.ws + WS_V0); const float* HA = (const float*)(A.ws + WS_HA);
    const int lane = tid & 63, wave = RFL(tid >> 6), l31 = lane & 31, hh = lane >> 5;
    const int j = tid & 127, qtr = RFL(tid >> 7);
    for (int slot = 0; slot < 2; ++slot) {
        int item; bool sample;
        if (blk < 64) { if (slot) break; sample = true; item = blk; }
        else { const int q = blk - 64; if (slot == 0) item = q; else { if (q >= 64) break; item = 192 + q; } sample = false; }
        const int b = item >> 3, h = (item >> 1) & 3, d = item & 1, T = sample ? 1024 : 256, row0 = sample ? MP + b * 1024 : b * 256;
        bf16* OUT = (bf16*)(A.ws + (d ? WS_OB : WS_OF));
        const int ecol = 32 * wave + l31;
        f32x16 S[4];
        if (sample) { const float* sp = A.in[I_SG] + ((((size_t)b * 2 + d) * 4 + h) * 128) * 256 + ecol;
#pragma unroll
            for (int t = 0; t < 4; ++t)
#pragma unroll
                for (int r = 0; r < 16; ++r) S[t][r] = sp[(size_t)(32 * t + (r & 3) + 8 * (r >> 2) + 4 * hh) * 256]; }
        else {
#pragma unroll
            for (int t = 0; t < 4; ++t)
#pragma unroll
                for (int r = 0; r < 16; ++r) S[t][r] = 0.f; }
        const int tt = wave >> 2, ctl = wave & 3, jcol = 32 * ctl + l31;
        bf16x8 wfrag; float bav;
        { v4u pk;
#pragma unroll
            for (int u = 0; u < 4; ++u) pk[u] = CVTPK(A.in[I_GWA2][((size_t)d * 16 + 8 * hh + 2 * u) * 512 + h * 128 + jcol], A.in[I_GWA2][((size_t)d * 16 + 8 * hh + 2 * u + 1) * 512 + h * 128 + jcol]);
            wfrag = __builtin_bit_cast(bf16x8, pk); bav = A.in[I_GBA][d * 512 + h * 128 + jcol]; }
        const int tau = 16 * ((l31 >> 2) & 1) + (l31 & 3) + 4 * (l31 >> 3);
        GlRaw raw; gla_load(A, raw, 0, T, d, row0, h, tid);
        for (int ch = 0; ch < T / 64; ++ch) {
            { const f32x4 h0 = raw.h0, h1 = raw.h1;
                const v4u apk = (v4u){CVTPK(h0[0], h0[1]), CVTPK(h0[2], h0[3]), CVTPK(h1[0], h1[1]), CVTPK(h1[2], h1[3])};
                f32x16 z;
#pragma unroll
                for (int r = 0; r < 16; ++r) z[r] = bav;
                z = MFMA32(__builtin_bit_cast(bf16x8, apk), wfrag, z);
                float run = 0.f;
#pragma unroll
                for (int r = 0; r < 16; ++r) { const float zz = z[r]; const float ls = fminf(zz, 0.f) - FLOG(1.f + FEXP(-fabsf(zz))); run += ls * (1.f / 16.f); z[r] = run; }
                const float other = SHFLX(run, 32);
                const float add = hh ? other : 0.f;
#pragma unroll
                for (int r = 0; r < 16; ++r) BG[(32 * tt + 16 * hh + r) * 132 + jcol] = z[r] + add;
                if (tt == 0 && hh == 1) TOT[jcol] = run + other; }
            BAR_LDS();
            { const int i = lane, jb = 16 * wave;
                const v4u q0 = raw.q0, q1 = raw.q1, k0 = raw.k0, k1 = raw.k1;
                unsigned qo[8], ko[8];
#pragma unroll
                for (int g = 0; g < 4; ++g) { const f32x4 bv = *(const LAS f32x4*)(BG + i * 132 + jb + 4 * g), t0 = *(const LAS f32x4*)(TOT + jb + 4 * g);
                    float qb_[4], kb_[4];
#pragma unroll
                    for (int c = 0; c < 4; ++c) { const int e = 4 * g + c; const unsigned qw = e < 8 ? q0[e >> 1] : q1[(e - 8) >> 1], kw = e < 8 ? k0[e >> 1] : k1[(e - 8) >> 1];
                        const float qv = (e & 1) ? __uint_as_float(qw & 0xffff0000u) : __uint_as_float(qw << 16), kv = (e & 1) ? __uint_as_float(kw & 0xffff0000u) : __uint_as_float(kw << 16);
                        const float bb = bv[c] + (i >= 32 ? t0[c] : 0.f);
                        const float eb = FEXP(bb), ei = FRCP(eb);
                        qb_[c] = qv * eb * 0.08838834764831845f; kb_[c] = kv * ei;
                        if (i == 63) DEC[jb + e] = eb; }
#pragma unroll
                    for (int c = 0; c < 4; c += 2) { const unsigned kp = CVTPK(kb_[c], kb_[c + 1]); KDT[(jb + 4 * g + c) * 72 + i] = (bf16)(kp & 0xffffu); KDT[(jb + 4 * g + c + 1) * 72 + i] = (bf16)(kp >> 16); }
                    qo[2 * g] = CVTPK(qb_[0], qb_[1]); qo[2 * g + 1] = CVTPK(qb_[2], qb_[3]); ko[2 * g] = CVTPK(kb_[0], kb_[1]); ko[2 * g + 1] = CVTPK(kb_[2], kb_[3]); }
                *(LAS v4u*)(QB + i * 136 + jb) = (v4u){qo[0], qo[1], qo[2], qo[3]}; *(LAS v4u*)(QB + i * 136 + jb + 8) = (v4u){qo[4], qo[5], qo[6], qo[7]};
                *(LAS v4u*)(KB + i * 136 + jb) = (v4u){ko[0], ko[1], ko[2], ko[3]}; *(LAS v4u*)(KB + i * 136 + jb + 8) = (v4u){ko[4], ko[5], ko[6], ko[7]}; }
            { const int sv = lane;
#pragma unroll
                for (int i4 = 0; i4 < 4; ++i4) { const int e0 = (wave * 4 + i4) * 8; const v4u w = raw.v[i4];
#pragma unroll
                    for (int u = 0; u < 4; ++u) { VT[(e0 + 2 * u) * 72 + sv] = (bf16)(w[u] & 0xffffu); VT[(e0 + 2 * u + 1) * 72 + sv] = (bf16)(w[u] >> 16); } } }
            gla_load(A, raw, ch + 1 < T / 64 ? ch + 1 : ch, T, d, row0, h, tid);
            BAR_LDS();
            if (wave < 3) { const int ct = wave == 0 ? 0 : 1, st = wave == 2 ? 1 : 0;
                f32x16 sc;
#pragma unroll
                for (int r = 0; r < 16; ++r) sc[r] = 0.f;
#pragma unroll
                for (int ks = 0; ks < 8; ++ks) { const bf16x8 a = *(const LAS bf16x8*)(QB + (32 * ct + l31) * 136 + 16 * ks + 8 * hh), bf = *(const LAS bf16x8*)(KB + (32 * st + l31) * 136 + 16 * ks + 8 * hh); sc = MFMA32(a, bf, sc); }
#pragma unroll
                for (int r = 0; r < 16; r += 2) { const int c = 32 * ct + (r & 3) + 8 * (r >> 2) + 4 * hh, s_ = 32 * st + l31; const unsigned pk = CVTPK(c >= s_ ? sc[r] : 0.f, c + 1 >= s_ ? sc[r + 1] : 0.f);
                    SC[c * 72 + s_] = (bf16)(pk & 0xffffu); SC[(c + 1) * 72 + s_] = (bf16)(pk >> 16); } }
            f32x16 O[2];
#pragma unroll
            for (int ct = 0; ct < 2; ++ct)
#pragma unroll
                for (int r = 0; r < 16; ++r) O[ct][r] = 0.f;
#pragma unroll
            for (int t = 0; t < 4; ++t)
#pragma unroll
                for (int ks = 0; ks < 2; ++ks) {
                    v4u pk; pk[0] = CVTPK(S[t][8 * ks + 0], S[t][8 * ks + 1]); pk[1] = CVTPK(S[t][8 * ks + 2], S[t][8 * ks + 3]); pk[2] = CVTPK(S[t][8 * ks + 4], S[t][8 * ks + 5]); pk[3] = CVTPK(S[t][8 * ks + 6], S[t][8 * ks + 7]);
                    const bf16x8 bfrag = __builtin_bit_cast(bf16x8, pk);
#pragma unroll
                    for (int ct = 0; ct < 2; ++ct) { const LAS bf16* ap = QB + (32 * ct + l31) * 136 + 32 * t + 16 * ks + 4 * hh;
                        const v2u lo = *(const LAS v2u*)ap, hi = *(const LAS v2u*)(ap + 8); const v4u av = (v4u){lo[0], lo[1], hi[0], hi[1]};
                        O[ct] = MFMA32(__builtin_bit_cast(bf16x8, av), bfrag, O[ct]); } }
            bf16x8 vb[4];
#pragma unroll
            for (int ks = 0; ks < 4; ++ks) vb[ks] = *(const LAS bf16x8*)(VT + ecol * 72 + 16 * ks + 8 * hh);
#pragma unroll
            for (int t = 0; t < 4; ++t) {
#pragma unroll
                for (int ks = 0; ks < 4; ++ks) { const bf16x8 a = *(const LAS bf16x8*)(KDT + (32 * t + l31) * 72 + 16 * ks + 8 * hh); S[t] = MFMA32(a, vb[ks], S[t]); }
#pragma unroll
                for (int g = 0; g < 4; ++g) { const f32x4 dc = *(const LAS f32x4*)(DEC + 32 * t + 8 * g + 4 * hh);
#pragma unroll
                    for (int c = 0; c < 4; ++c) S[t][4 * g + c] *= dc[c]; } }
            BAR_LDS();
#pragma unroll
            for (int ct = 0; ct < 2; ++ct)
#pragma unroll
                for (int ks = 0; ks < 4; ++ks) if (ks < (ct ? 4 : 2)) { const bf16x8 a = *(const LAS bf16x8*)(SC + (32 * ct + l31) * 72 + 16 * ks + 8 * hh); O[ct] = MFMA32(a, vb[ks], O[ct]); }
            { LAS bf16* OST = (LAS bf16*)(lds + GL_QB) + wave * 2048;
#pragma unroll
                for (int ct = 0; ct < 2; ++ct)
#pragma unroll
                    for (int r = 0; r < 16; r += 2) { const int c = 32 * ct + (r & 3) + 8 * (r >> 2) + 4 * hh; const unsigned pk = CVTPK(O[ct][r], O[ct][r + 1]);
                        OST[c * 32 + l31] = (bf16)(pk & 0xffffu); OST[(c + 1) * 32 + l31] = (bf16)(pk >> 16); }
                LDS_WAIT();
#pragma unroll
                for (int k = 0; k < 4; ++k) { const int c = 16 * k + (lane >> 2), s = 64 * ch + c, t = d ? T - 1 - s : s; const v4u w = *(const LAS v4u*)(OST + c * 32 + 8 * (lane & 3));
                    *(v4u*)(OUT + ((size_t)row0 + t) * 1024 + h * 256 + 32 * wave + 8 * (lane & 3)) = w; } }
        }
        if (!sample) { float* dst = A.out + OUT_SG + ((((size_t)b * 2 + d) * 4 + h) * 128) * 256 + ecol;
#pragma unroll
            for (int t = 0; t < 4; ++t)
#pragma unroll
                for (int r = 0; r < 16; ++r) dst[(size_t)(32 * t + (r & 3) + 8 * (r >> 2) + 4 * hh) * 256] = S[t][r]; }
        BAR();
    }
}
constexpr int RW_XS = 0;
constexpr int RW_YS = 4608;
constexpr int RW_YT = 9216;
constexpr int RW_VT = 14336;
constexpr int RW_GC = 17408;
constexpr int RW_BL = 17664;
constexpr int RW_SET = 17728;
constexpr int RW_LAB = 6 * RW_SET;
constexpr int RW_FLAGS = RW_LAB + 8192;
constexpr int RW_END = RW_FLAGS + 1024;
static_assert(RW_END <= 146944, "RWKV LDS map");

FORCEINLINE float fast_exp(float x) { return FEXP(x); }
FORCEINLINE float fast_tanh(float x) { return 1.f - 2.f * FRCP(1.f + FEXP(2.f * x)); }

struct RwItem { int b, h, d, T, row0; };
struct RwRaw { v4u aw[2], aa[2]; v2u k[4], r[4], v[4]; };
FORCEINLINE void rwkv_prep_load(const Args& A, RwRaw& w, const RwItem it, int ch, int lane) {
    const int j16 = lane & 15, q = lane >> 4;
    const bf16* R1 = (const bf16*)(A.ws + WS_R1); const bf16* K1 = (const bf16*)(A.ws + WS_K1); const bf16* V1 = (const bf16*)(A.ws + WS_V1); const bf16* LWA = (const bf16*)(A.ws + WS_LWA);
    const int h = it.h, d = it.d, T = it.T, row0 = it.row0;
    { const int s = 16 * ch + j16, t = d ? T - 1 - s : s; const bf16* lrow = LWA + ((size_t)row0 + t) * 256 + d * 64;
#pragma unroll
        for (int ks = 0; ks < 2; ++ks) { w.aw[ks] = *(const v4u*)(lrow + 32 * ks + 8 * q); w.aa[ks] = *(const v4u*)(lrow + 128 + 32 * ks + 8 * q); } }
#pragma unroll
    for (int rr = 0; rr < 4; ++rr) { const int s = 16 * ch + 4 * q + rr, t = d ? T - 1 - s : s; const size_t off = ((size_t)row0 + t) * 1024 + h * 64 + 4 * j16;
        w.k[rr] = *(const v2u*)(K1 + off); w.r[rr] = *(const v2u*)(R1 + off); w.v[rr] = *(const v2u*)(V1 + off); }
}
FORCEINLINE void rwkv_prep(LAS unsigned char* set, float (&bonp)[4], const RwRaw& w, const int jh, int lane,
                           const bf16x8 (&Bw)[2][2], const bf16x8 (&Ba)[2][2], const float (&w0v)[2], const float (&a0v)[2], const float (&kav)[2], const float (&rkv)[2], const float (&kkw)[4]) {
    const int j16 = lane & 15, q = lane >> 4, jc0 = 4 * j16 + 2 * jh;
    LAS bf16* pXS = (LAS bf16*)(set + RW_XS); LAS bf16* pYS = (LAS bf16*)(set + RW_YS); LAS bf16* pYT = (LAS bf16*)(set + RW_YT); LAS bf16* pVT = (LAS bf16*)(set + RW_VT); LAS float* pGC = (LAS float*)(set + RW_GC);
    f32x4 Dw[2], Da[2];
#pragma unroll
    for (int n = 0; n < 2; ++n) { Dw[n] = (f32x4){0.f, 0.f, 0.f, 0.f}; Da[n] = (f32x4){0.f, 0.f, 0.f, 0.f}; }
#pragma unroll
    for (int ks = 0; ks < 2; ++ks)
#pragma unroll
        for (int n = 0; n < 2; ++n) { Dw[n] = MFMA16(__builtin_bit_cast(bf16x8, w.aw[ks]), Bw[n][ks], Dw[n]); Da[n] = MFMA16(__builtin_bit_cast(bf16x8, w.aa[ks]), Ba[n][ks], Da[n]); }
    float lwd[2][4], asg[2][4], kkv[2][4], kdv[2][4], rvv[2][4];
#pragma unroll
    for (int rr = 0; rr < 4; ++rr) {
        float kx[4]; kx[0] = __uint_as_float(w.k[rr][0] << 16); kx[1] = __uint_as_float(w.k[rr][0] & 0xffff0000u); kx[2] = __uint_as_float(w.k[rr][1] << 16); kx[3] = __uint_as_float(w.k[rr][1] & 0xffff0000u);
        float n2s = 0.f;
#pragma unroll
        for (int c = 0; c < 4; ++c) { const float kq = kx[c] * kkw[c]; n2s += kq * kq; }
        RED16(n2s);
        const float inv = FRSQ(fmaxf(n2s, 1e-24f));
        rvv[0][rr] = __uint_as_float(w.r[rr][jh] << 16); rvv[1][rr] = __uint_as_float(w.r[rr][jh] & 0xffff0000u);
        float bp = 0.f;
#pragma unroll
        for (int n = 0; n < 2; ++n) { const float wpre = w0v[n] + Dw[n][rr], apre = a0v[n] + Da[n][rr];
            lwd[n][rr] = -0.6065306597126334f * FRCP(1.f + fast_exp(-wpre));
            asg[n][rr] = FRCP(1.f + fast_exp(-apre));
            const float kraw = jh ? kx[2 + n] : kx[n], kself = jh ? kkw[2 + n] : kkw[n];
            kkv[n][rr] = kraw * kself * inv;
            kdv[n][rr] = kraw * (1.f + (asg[n][rr] - 1.f) * kav[n]);
            bp += rvv[n][rr] * kdv[n][rr] * rkv[n]; }
        RED16(bp);
        bonp[rr] += bp; }
    float at_[2][4], rt_[2][4], bt_[2][4], kt_[2][4];
#pragma unroll
    for (int n = 0; n < 2; ++n) {
        const float tot = (lwd[n][0] + lwd[n][1]) + (lwd[n][2] + lwd[n][3]);
        const float bq = SHFLX(tot, 16), pr = tot + bq, cq = SHFLX(pr, 32);
        float cum = ((q & 1) ? bq : 0.f) + ((q & 2) ? cq : 0.f);
        float gp = fast_exp(cum);
#pragma unroll
        for (int rr = 0; rr < 4; ++rr) { cum += lwd[n][rr];
            const float g = fast_exp(cum), gi = FRCP(g);
            at_[n][rr] = -kkv[n][rr] * gp; bt_[n][rr] = kkv[n][rr] * asg[n][rr] * gi; kt_[n][rr] = kdv[n][rr] * gi; rt_[n][rr] = rvv[n][rr] * g;
            gp = g; }
        *(LAS v2u*)(pYT + (jc0 + n) * 40 + 4 * q) = (v2u){CVTPK(bt_[n][0], bt_[n][1]), CVTPK(bt_[n][2], bt_[n][3])};
        *(LAS v2u*)(pYT + (jc0 + n) * 40 + 16 + 4 * q) = (v2u){CVTPK(kt_[n][0], kt_[n][1]), CVTPK(kt_[n][2], kt_[n][3])};
        if (q == 0) pGC[jc0 + n] = fast_exp(pr + cq); }
#pragma unroll
    for (int rr = 0; rr < 4; ++rr) { const int rho = rr + 8 * q;
        *(LAS unsigned*)(pXS + rho * 72 + jc0) = CVTPK(at_[0][rr], at_[1][rr]); *(LAS unsigned*)(pXS + (rho + 4) * 72 + jc0) = CVTPK(rt_[0][rr], rt_[1][rr]);
        *(LAS unsigned*)(pYS + rho * 72 + jc0) = CVTPK(bt_[0][rr], bt_[1][rr]); *(LAS unsigned*)(pYS + (rho + 4) * 72 + jc0) = CVTPK(kt_[0][rr], kt_[1][rr]); }
    *(LAS v2u*)(pVT + jc0 * 24 + 4 * q) = (v2u){(w.v[0][jh] & 0xffffu) | (w.v[1][jh] << 16), (w.v[2][jh] & 0xffffu) | (w.v[3][jh] << 16)};
    *(LAS v2u*)(pVT + (jc0 + 1) * 24 + 4 * q) = (v2u){(w.v[0][jh] >> 16) | (w.v[1][jh] & 0xffff0000u), (w.v[2][jh] >> 16) | (w.v[3][jh] & 0xffff0000u)};
}

FORCEINLINE void rwkv_core(const Args& A, const LAS unsigned char* set, LAS float* LAB, f32x16 (&Z)[2], const RwItem it, int ch, int c_it, int lane) {
    const int l31 = lane & 31, hh = lane >> 5;
    const LAS bf16* cXS = (const LAS bf16*)(set + RW_XS); const LAS bf16* cYS = (const LAS bf16*)(set + RW_YS); const LAS bf16* cYT = (const LAS bf16*)(set + RW_YT); const LAS bf16* cVT = (const LAS bf16*)(set + RW_VT); const LAS float* cGC = (const LAS float*)(set + RW_GC);
    const int h = it.h, d = it.d, T = it.T, row0 = it.row0, icol = 32 * c_it + l31;
    f32x16 Gp;
#pragma unroll
    for (int r = 0; r < 16; ++r) Gp[r] = 0.f;
#pragma unroll
    for (int ks = 0; ks < 4; ++ks) { const bf16x8 a = *(const LAS bf16x8*)(cYS + l31 * 72 + 16 * ks + 8 * hh), bx = *(const LAS bf16x8*)(cXS + l31 * 72 + 16 * ks + 8 * hh); Gp = MFMA32(a, bx, Gp); }
    f32x16 Dm;
#pragma unroll
    for (int r = 0; r < 16; ++r) Dm[r] = 0.f;
#pragma unroll
    for (int jt = 0; jt < 2; ++jt)
#pragma unroll
        for (int ks = 0; ks < 2; ++ks) { const LAS bf16* ap = cXS + l31 * 72 + 32 * jt + 16 * ks + 4 * hh; const v2u lo = *(const LAS v2u*)ap, hi = *(const LAS v2u*)(ap + 8);
            const v4u av = (v4u){lo[0], lo[1], hi[0], hi[1]};
            const v4u zk = (v4u){CVTPK(Z[jt][8 * ks], Z[jt][8 * ks + 1]), CVTPK(Z[jt][8 * ks + 2], Z[jt][8 * ks + 3]), CVTPK(Z[jt][8 * ks + 4], Z[jt][8 * ks + 5]), CVTPK(Z[jt][8 * ks + 6], Z[jt][8 * ks + 7])};
            Dm = MFMA32(__builtin_bit_cast(bf16x8, av), __builtin_bit_cast(bf16x8, zk), Dm); }
    const int hx = (l31 >> 2) & 1, tx = (l31 & 3) + 4 * (l31 >> 3);
#pragma unroll
    for (int r = 0; r < 16; ++r) Gp[r] = r < tx + hx ? Gp[r] : 0.f;
    if (hh == 0 && hx == 0) {
#pragma unroll
        for (int g = 0; g < 4; ++g) *(LAS f32x4*)(LAB + tx * 16 + 4 * g) = (f32x4){Gp[4 * g], Gp[4 * g + 1], Gp[4 * g + 2], Gp[4 * g + 3]}; }
    bf16x8 Ag[2];
#pragma unroll
    for (int ks = 0; ks < 2; ++ks) { const v4u pk = (v4u){CVTPK(Gp[8 * ks], Gp[8 * ks + 1]), CVTPK(Gp[8 * ks + 2], Gp[8 * ks + 3]), CVTPK(Gp[8 * ks + 4], Gp[8 * ks + 5]), CVTPK(Gp[8 * ks + 6], Gp[8 * ks + 7])}; Ag[ks] = __builtin_bit_cast(bf16x8, pk); }
    bf16x8 Vf[2];
#pragma unroll
    for (int ks = 0; ks < 2; ++ks) { const v4u vz = *(const LAS v4u*)(cVT + icol * 24 + 8 * ks); Vf[ks] = __builtin_bit_cast(bf16x8, hh ? vz : (v4u){0u, 0u, 0u, 0u}); }
#pragma unroll
    for (int ks = 0; ks < 2; ++ks) Dm = MFMA32(Ag[ks], Vf[ks], Dm);
    LDS_WAIT();
    float u[16];
#pragma unroll
    for (int t = 0; t < 16; ++t) { float acc_ = Dm[t];
#pragma unroll
        for (int g = 0; g < 4; ++g) if (4 * g < t) { const f32x4 lv = *(const LAS f32x4*)(LAB + t * 16 + 4 * g);
#pragma unroll
            for (int c = 0; c < 4; ++c) if (4 * g + c < t) acc_ += lv[c] * u[4 * g + c]; }
        u[t] = acc_;
        if ((t & 3) == 3) COMPILER_FENCE(); }
    bf16x8 Uf[2];
#pragma unroll
    for (int ks = 0; ks < 2; ++ks) { const v4u pk = (v4u){CVTPK(u[8 * ks], u[8 * ks + 1]), CVTPK(u[8 * ks + 2], u[8 * ks + 3]), CVTPK(u[8 * ks + 4], u[8 * ks + 5]), CVTPK(u[8 * ks + 6], u[8 * ks + 7])};
        Uf[ks] = __builtin_bit_cast(bf16x8, hh ? (v4u){0u, 0u, 0u, 0u} : pk); }
#pragma unroll
    for (int ks = 0; ks < 2; ++ks) Dm = MFMA32(Ag[ks], Uf[ks], Dm);
    { bf16* YO = (bf16*)(A.ws + (d ? WS_YB : WS_YF)); LAS bf16* YST = (LAS bf16*)(LAB + 256);
        if (hh) {
#pragma unroll
            for (int r = 0; r < 16; r += 2) { const unsigned pk = CVTPK(Dm[r], Dm[r + 1]); YST[r * 32 + l31] = (bf16)(pk & 0xffffu); YST[(r + 1) * 32 + l31] = (bf16)(pk >> 16); } }
        LDS_WAIT();
        { const int tk = lane >> 2, s = 16 * ch + tk, t = d ? T - 1 - s : s; const v4u w = *(const LAS v4u*)(YST + tk * 32 + 8 * (lane & 3));
            *(v4u*)(YO + ((size_t)row0 + t) * 1024 + h * 64 + 32 * c_it + 8 * (lane & 3)) = w; } }
#pragma unroll
    for (int ks = 0; ks < 2; ++ks) { const v4u uu = __builtin_bit_cast(v4u, Uf[ks]), vv = __builtin_bit_cast(v4u, Vf[ks]); Uf[ks] = __builtin_bit_cast(bf16x8, hh ? vv : uu); }
#pragma unroll
    for (int jt = 0; jt < 2; ++jt) {
#pragma unroll
        for (int ks = 0; ks < 2; ++ks) { const bf16x8 a = *(const LAS bf16x8*)(cYT + (32 * jt + l31) * 40 + 16 * hh + 8 * ks); Z[jt] = MFMA32(a, Uf[ks], Z[jt]); }
#pragma unroll
        for (int g = 0; g < 4; ++g) { const f32x4 dc = *(const LAS f32x4*)(cGC + 32 * jt + 8 * g + 4 * hh);
#pragma unroll
            for (int c = 0; c < 4; ++c) Z[jt][4 * g + c] *= dc[c]; } }
    if (c_it == 0 && lane < 16) { const int s = 16 * ch + lane, t = d ? T - 1 - s : s; float* BON = (float*)(A.ws + WS_BONUS);
        BON[(((size_t)row0 + t) * 16 + h) * 2 + d] = ((const LAS float*)(set + RW_BL))[lane]; }
}

FORCEINLINE void rwkv_core2(const Args& A, const LAS unsigned char* set, LAS float* LAB, f32x16 (&Z)[2][2], const RwItem it, int ch, int lane) {
    const int l31 = lane & 31, hh = lane >> 5;
    const LAS bf16* cXS = (const LAS bf16*)(set + RW_XS); const LAS bf16* cYS = (const LAS bf16*)(set + RW_YS); const LAS bf16* cYT = (const LAS bf16*)(set + RW_YT); const LAS bf16* cVT = (const LAS bf16*)(set + RW_VT); const LAS float* cGC = (const LAS float*)(set + RW_GC);
    const int h = it.h, d = it.d, T = it.T, row0 = it.row0;
    f32x16 Gp;
#pragma unroll
    for (int r = 0; r < 16; ++r) Gp[r] = 0.f;
#pragma unroll
    for (int ks = 0; ks < 4; ++ks) { const bf16x8 a = *(const LAS bf16x8*)(cYS + l31 * 72 + 16 * ks + 8 * hh), bx = *(const LAS bf16x8*)(cXS + l31 * 72 + 16 * ks + 8 * hh); Gp = MFMA32(a, bx, Gp); }
    f32x16 Dm[2];
#pragma unroll
    for (int ti = 0; ti < 2; ++ti) {
#pragma unroll
        for (int r = 0; r < 16; ++r) Dm[ti][r] = 0.f; }
#pragma unroll
    for (int jt = 0; jt < 2; ++jt)
#pragma unroll
        for (int ks = 0; ks < 2; ++ks) { const LAS bf16* ap = cXS + l31 * 72 + 32 * jt + 16 * ks + 4 * hh; const v2u lo = *(const LAS v2u*)ap, hi = *(const LAS v2u*)(ap + 8);
            const bf16x8 av = __builtin_bit_cast(bf16x8, (v4u){lo[0], lo[1], hi[0], hi[1]});
#pragma unroll
            for (int ti = 0; ti < 2; ++ti) { const v4u zk = (v4u){CVTPK(Z[ti][jt][8 * ks], Z[ti][jt][8 * ks + 1]), CVTPK(Z[ti][jt][8 * ks + 2], Z[ti][jt][8 * ks + 3]), CVTPK(Z[ti][jt][8 * ks + 4], Z[ti][jt][8 * ks + 5]), CVTPK(Z[ti][jt][8 * ks + 6], Z[ti][jt][8 * ks + 7])};
                Dm[ti] = MFMA32(av, __builtin_bit_cast(bf16x8, zk), Dm[ti]); } }
    const int hx = (l31 >> 2) & 1, tx = (l31 & 3) + 4 * (l31 >> 3);
#pragma unroll
    for (int r = 0; r < 16; ++r) Gp[r] = r < tx + hx ? Gp[r] : 0.f;
    if (hh == 0 && hx == 0) {
#pragma unroll
        for (int g = 0; g < 4; ++g) *(LAS f32x4*)(LAB + tx * 16 + 4 * g) = (f32x4){Gp[4 * g], Gp[4 * g + 1], Gp[4 * g + 2], Gp[4 * g + 3]}; }
    bf16x8 Ag[2];
#pragma unroll
    for (int ks = 0; ks < 2; ++ks) { const v4u pk = (v4u){CVTPK(Gp[8 * ks], Gp[8 * ks + 1]), CVTPK(Gp[8 * ks + 2], Gp[8 * ks + 3]), CVTPK(Gp[8 * ks + 4], Gp[8 * ks + 5]), CVTPK(Gp[8 * ks + 6], Gp[8 * ks + 7])}; Ag[ks] = __builtin_bit_cast(bf16x8, pk); }
#pragma unroll
    for (int ti = 0; ti < 2; ++ti)
#pragma unroll
        for (int ks = 0; ks < 2; ++ks) { const v4u vz = *(const LAS v4u*)(cVT + (32 * ti + l31) * 24 + 8 * ks); const v4u vf = hh ? vz : (v4u){0u, 0u, 0u, 0u};
            Dm[ti] = MFMA32(Ag[ks], __builtin_bit_cast(bf16x8, vf), Dm[ti]); }
    float u[16];
#pragma unroll
    for (int r = 0; r < 16; ++r) u[r] = SWAP32_LO(Dm[0][r], Dm[1][r]);
    LDS_WAIT();
#pragma unroll
    for (int t = 0; t < 16; ++t) { float acc_ = u[t];
#pragma unroll
        for (int g = 0; g < 4; ++g) if (4 * g < t) { const f32x4 lv = *(const LAS f32x4*)(LAB + t * 16 + 4 * g);
#pragma unroll
            for (int c = 0; c < 4; ++c) if (4 * g + c < t) acc_ += lv[c] * u[4 * g + c]; }
        u[t] = acc_;
        if ((t & 3) == 3) COMPILER_FENCE(); }
    v4u Uf[2][2];
#pragma unroll
    for (int ks = 0; ks < 2; ++ks) {
#pragma unroll
        for (int c = 0; c < 4; ++c) { const unsigned pk = CVTPK(u[8 * ks + 2 * c], u[8 * ks + 2 * c + 1]); const unsigned up = SWAP32_HI2LO(pk);
            Uf[0][ks][c] = hh ? 0u : pk; Uf[1][ks][c] = hh ? 0u : up; } }
    bf16* YO = (bf16*)(A.ws + (d ? WS_YB : WS_YF));
#pragma unroll
    for (int ti = 0; ti < 2; ++ti) {
#pragma unroll
        for (int ks = 0; ks < 2; ++ks) Dm[ti] = MFMA32(Ag[ks], __builtin_bit_cast(bf16x8, Uf[ti][ks]), Dm[ti]);
        if (hh) {
#pragma unroll
            for (int r = 0; r < 16; r += 2) { const unsigned pk = CVTPK(Dm[ti][r], Dm[ti][r + 1]); const int s0 = 16 * ch + r, t0 = d ? T - 1 - s0 : s0, t1 = d ? t0 - 1 : t0 + 1;
                YO[((size_t)row0 + t0) * 1024 + h * 64 + 32 * ti + l31] = (bf16)(pk & 0xffffu); YO[((size_t)row0 + t1) * 1024 + h * 64 + 32 * ti + l31] = (bf16)(pk >> 16); } } }
#pragma unroll
    for (int jt = 0; jt < 2; ++jt) {
        f32x4 dc[4];
#pragma unroll
        for (int g = 0; g < 4; ++g) dc[g] = *(const LAS f32x4*)(cGC + 32 * jt + 8 * g + 4 * hh);
#pragma unroll
        for (int ks = 0; ks < 2; ++ks) { const bf16x8 a = *(const LAS bf16x8*)(cYT + (32 * jt + l31) * 40 + 16 * hh + 8 * ks);
#pragma unroll
            for (int ti = 0; ti < 2; ++ti) { const v4u vz = *(const LAS v4u*)(cVT + (32 * ti + l31) * 24 + 8 * ks); const v4u bv = hh ? vz : Uf[ti][ks]; Z[ti][jt] = MFMA32(a, __builtin_bit_cast(bf16x8, bv), Z[ti][jt]); } }
#pragma unroll
        for (int ti = 0; ti < 2; ++ti)
#pragma unroll
            for (int g = 0; g < 4; ++g)
#pragma unroll
                for (int c = 0; c < 4; ++c) Z[ti][jt][4 * g + c] *= dc[g][c]; }
    if (lane < 16) { const int s = 16 * ch + lane, t = d ? T - 1 - s : s; float* BON = (float*)(A.ws + WS_BONUS);
        BON[(((size_t)row0 + t) * 16 + h) * 2 + d] = ((const LAS float*)(set + RW_BL))[lane]; }
}

FORCEINLINE RwItem rw_item(bool smp, int idx) { RwItem it; it.b = idx >> 5; it.h = (idx >> 1) & 15; it.d = idx & 1; it.T = smp ? 1024 : 256; it.row0 = smp ? MP + it.b * 1024 : it.b * 256; return it; }

FORCEINLINE void rw_consts(const Args& A, const RwItem it, int sub, int lane, bf16x8 (&Bw)[2][2], bf16x8 (&Ba)[2][2], float (&w0v)[2], float (&a0v)[2], float (&kav)[2], float (&rkv)[2], float (&kkw)[4]) {
    const int j16 = lane & 15, q = lane >> 4;
#pragma unroll
    for (int n = 0; n < 2; ++n) { const int jc = 4 * j16 + 2 * sub + n, hj = it.h * 64 + jc;
        float tw[16], ta[16];
#pragma unroll
        for (int ks = 0; ks < 2; ++ks)
#pragma unroll
            for (int u = 0; u < 8; ++u) { const int m = 32 * ks + 8 * q + u; tw[8 * ks + u] = A.in[I_W2][((size_t)it.d * 64 + m) * 1024 + hj]; ta[8 * ks + u] = A.in[I_A2][((size_t)it.d * 64 + m) * 1024 + hj]; }
        w0v[n] = A.in[I_W0][it.d * 1024 + hj]; a0v[n] = A.in[I_A0][it.d * 1024 + hj]; kav[n] = A.in[I_KA][it.d * 1024 + hj]; rkv[n] = A.in[I_RK][(it.d * 16 + it.h) * 64 + jc];
#pragma unroll
        for (int ks = 0; ks < 2; ++ks) { v4u pw_, pa_;
#pragma unroll
            for (int u = 0; u < 4; ++u) { pw_[u] = CVTPK(tw[8 * ks + 2 * u], tw[8 * ks + 2 * u + 1]); pa_[u] = CVTPK(ta[8 * ks + 2 * u], ta[8 * ks + 2 * u + 1]); }
            Bw[n][ks] = __builtin_bit_cast(bf16x8, pw_); Ba[n][ks] = __builtin_bit_cast(bf16x8, pa_); } }
#pragma unroll
    for (int c = 0; c < 4; ++c) kkw[c] = A.in[I_KK][it.d * 1024 + it.h * 64 + 4 * j16 + c];
}

FORCEINLINE void phase_rwkv_chunk(const Args& A, LAS unsigned char* lds, int tid, int blk, int mode = 0) {
    const int lane = tid & 63, wave = RFL(tid >> 6), l31 = lane & 31, hh = lane >> 5, j16 = lane & 15, q = lane >> 4;
    volatile LAS unsigned* FL = (volatile LAS unsigned*)(lds + RW_FLAGS);
    if (tid < 256) FL[tid] = 0u;
    BAR();
    const int sel = (wave >> 1) & 1, sub = wave & 1; const bool smp = sel == 0;
    if (wave >= 4) {
        bf16x8 Bw[2][2][2], Ba[2][2][2]; float w0v[2][2], a0v[2][2], kav[2][2], rkv[2][2], kkw[4] = {0.f, 0.f, 0.f, 0.f};
        int have = -1;
        RwRaw raw;
        rwkv_prep_load(A, raw, rw_item(smp, smp ? blk : blk * 4), sub, lane);
        for (int rd = sub; rd < 64; rd += 2) {
            const int idx = smp ? blk : blk * 4 + (rd >> 4); const RwItem it = rw_item(smp, idx);
            if (idx != have) { rw_consts(A, it, 0, lane, Bw[0], Ba[0], w0v[0], a0v[0], kav[0], rkv[0], kkw); rw_consts(A, it, 1, lane, Bw[1], Ba[1], w0v[1], a0v[1], kav[1], rkv[1], kkw); have = idx; }
            const int slot = rd % 3; LAS unsigned char* set = lds + (sel * 3 + slot) * RW_SET;
            if (rd >= 3) { SPIN_UNTIL_GE(FL + 96 + 8 * (sel * 6 + slot), (unsigned)(rd - 2)); SPIN_UNTIL_GE(FL + 96 + 8 * (sel * 6 + 3 + slot), (unsigned)(rd - 2)); }
            float bonp[4] = {0.f, 0.f, 0.f, 0.f};
            if (mode != 2) { rwkv_prep(set, bonp, raw, 0, lane, Bw[0], Ba[0], w0v[0], a0v[0], kav[0], rkv[0], kkw); rwkv_prep(set, bonp, raw, 1, lane, Bw[1], Ba[1], w0v[1], a0v[1], kav[1], rkv[1], kkw); }
            if (j16 == 0) {
#pragma unroll
                for (int rr = 0; rr < 4; ++rr) ((LAS float*)(set + RW_BL))[4 * q + rr] = bonp[rr]; }
            { const int r1 = rd + 2 < 64 ? rd + 2 : rd; rwkv_prep_load(A, raw, rw_item(smp, smp ? blk : blk * 4 + (r1 >> 4)), smp ? r1 : (r1 & 15), lane); }
            LDS_WAIT();
            if (lane == 0) FL[8 * (sel * 3 + slot)] = (unsigned)(rd + 1);
        }
    } else if (mode == 0) {
        LAS float* LAB = (LAS float*)(lds + RW_LAB) + wave * 512;
        SETPRIO(1);
        f32x16 Z[2];
#pragma unroll
        for (int r = 0; r < 16; ++r) { Z[0][r] = 0.f; Z[1][r] = 0.f; }
        for (int rd = 0; rd < 64; ++rd) {
            const RwItem it = rw_item(smp, smp ? blk : blk * 4 + (rd >> 4)); const int ch = smp ? rd : (rd & 15); const int icol = 32 * sub + l31;
            if (smp ? rd == 0 : (rd & 15) == 0) {
                if (smp) { const float* sp = A.in[I_SR] + ((((size_t)it.b * 2 + it.d) * 16 + it.h) * 64 + icol) * 64;
#pragma unroll
                    for (int jt = 0; jt < 2; ++jt)
#pragma unroll
                        for (int g = 0; g < 4; ++g) { const f32x4 v = *(const f32x4*)(sp + 32 * jt + 8 * g + 4 * hh); Z[jt][4 * g] = v[0]; Z[jt][4 * g + 1] = v[1]; Z[jt][4 * g + 2] = v[2]; Z[jt][4 * g + 3] = v[3]; } }
                else {
#pragma unroll
                    for (int r = 0; r < 16; ++r) { Z[0][r] = 0.f; Z[1][r] = 0.f; } }
            }
            const int slot = rd % 3;
            SPIN_UNTIL_GE(FL + 8 * (sel * 3 + slot), (unsigned)(rd + 1));
            rwkv_core(A, lds + (sel * 3 + slot) * RW_SET, LAB, Z, it, ch, sub, lane);
            LDS_WAIT();
            if (lane == 0) FL[96 + 8 * (sel * 6 + sub * 3 + slot)] = (unsigned)(rd + 1);
            if (!smp && (rd & 15) == 15) { float* dp = A.out + OUT_SR + ((((size_t)it.b * 2 + it.d) * 16 + it.h) * 64 + icol) * 64;
#pragma unroll
                for (int jt = 0; jt < 2; ++jt)
#pragma unroll
                    for (int g = 0; g < 4; ++g) *(f32x4*)(dp + 32 * jt + 8 * g + 4 * hh) = (f32x4){Z[jt][4 * g], Z[jt][4 * g + 1], Z[jt][4 * g + 2], Z[jt][4 * g + 3]}; }
        }
        SETPRIO(0);
    } else {
        if (lane == 0) for (int s_ = 0; s_ < 12; ++s_) FL[96 + 8 * s_] = 1000u;
    }
    BAR();
}
constexpr int RH_LD = 1032;
FORCEINLINE int cond_of_row(int r) { return r < MP ? 0 : 1 + ((r - MP) >> 10); }
FORCEINLINE float row_rstd16(const float* ssq, int r, int lane) { float s = lane < 16 ? ssq[(size_t)r * 16 + lane] : 0.f; return FRSQ(wave_sum(s) * (1.f / D) + EPS); }

FORCEINLINE void phase_h0_ha(const Args& A, LAS unsigned char* lds, int tid, int blk) {
    LAS bf16* HL = (LAS bf16*)lds; LAS float* RED = (LAS float*)lds;
    const int lane = tid & 63, wave = RFL(tid >> 6), l31 = lane & 31, hh = lane >> 5;
    const float* MOD = (const float*)(A.ws + WS_MOD); bf16* XN = (bf16*)(A.ws + WS_ABUF); const float* nw = A.in[I_NORMW];
    const bf16* WA1 = (const bf16*)(A.ws + WS_WIN) + (size_t)3072 * 1024; float* HA = (float*)(A.ws + WS_HA);
    const int rbase = blk * 64;
    BAR();
    for (int k = 0; k < 8; ++k) { const int rl = wave * 8 + k, r = rbase + rl;
        const f32x4* xr = (const f32x4*)(r < MP ? A.in[I_XP] + (size_t)r * D : A.in[I_XS] + (size_t)(r - MP) * D) + lane;
        f32x4 v[4]; float s = 0.f;
#pragma unroll
        for (int j = 0; j < 4; ++j) { v[j] = xr[64 * j]; s += (v[j][0] * v[j][0] + v[j][1] * v[j][1]) + (v[j][2] * v[j][2] + v[j][3] * v[j][3]); }
        const float rstd = FRSQ(wave_sum(s) * (1.f / D) + EPS);
        const float* md = MOD + cond_of_row(r) * 3072;
#pragma unroll
        for (int j = 0; j < 4; ++j) { const int c = 256 * j + 4 * lane; const f32x4 w = *(const f32x4*)(nw + c), sh = *(const f32x4*)(md + c), sc = *(const f32x4*)(md + 1024 + c);
            const f32x4 hv = (v[j] * rstd) * w * (sc + 1.f) + sh; const v2u pk = (v2u){CVTPK(hv[0], hv[1]), CVTPK(hv[2], hv[3])};
            *(v2u*)(XN + (size_t)r * D + c) = pk; *(LAS v2u*)(HL + rl * RH_LD + c) = pk; }
    }
    BAR();
    f32x16 acc[2];
#pragma unroll
    for (int r = 0; r < 16; ++r) { acc[0][r] = 0.f; acc[1][r] = 0.f; }
#pragma unroll
    for (int ks = 0; ks < 8; ++ks) { const int kk = 128 * wave + 16 * ks + 8 * hh; const bf16x8 bfr = *(const bf16x8*)(WA1 + (size_t)l31 * 1024 + kk);
#pragma unroll
        for (int rt = 0; rt < 2; ++rt) { const bf16x8 a = *(const LAS bf16x8*)(HL + (32 * rt + l31) * RH_LD + kk); acc[rt] = MFMA32(a, bfr, acc[rt]); } }
    BAR();
#pragma unroll
    for (int rt = 0; rt < 2; ++rt)
#pragma unroll
        for (int r = 0; r < 16; ++r) RED[(wave * 64 + 32 * rt + (r & 3) + 8 * (r >> 2) + 4 * hh) * 32 + l31] = acc[rt][r];
    BAR();
    for (int idx = tid; idx < 2048; idx += 512) { float s = 0.f;
#pragma unroll
        for (int w = 0; w < 8; ++w) s += RED[w * 2048 + idx];
        HA[(size_t)rbase * 32 + idx] = s; }
    BAR();
}

FORCEINLINE void lr_pass(const LAS bf16* HL, const bf16* W, f32x16 (&acc)[2], int l31, int hh, int rot) {
    bf16x8 b0[8], b1[8];
#pragma unroll
    for (int u = 0; u < 8; ++u) b0[u] = *(const bf16x8*)(W + 16 * ((u + rot) & 63) + 8 * hh);
    for (int g = 0; g < 8; g += 2) {
#pragma unroll
        for (int u = 0; u < 8; ++u) b1[u] = *(const bf16x8*)(W + 16 * ((8 * (g + 1) + u + rot) & 63) + 8 * hh);
#pragma unroll
        for (int u = 0; u < 8; ++u) { const int kk = 16 * ((8 * g + u + rot) & 63) + 8 * hh;
#pragma unroll
            for (int rt = 0; rt < 2; ++rt) { const bf16x8 a = *(const LAS bf16x8*)(HL + (32 * rt + l31) * RH_LD + kk); acc[rt] = MFMA32(a, b0[u], acc[rt]); } }
        if (g + 2 < 8) {
#pragma unroll
            for (int u = 0; u < 8; ++u) b0[u] = *(const bf16x8*)(W + 16 * ((8 * (g + 2) + u + rot) & 63) + 8 * hh); }
#pragma unroll
        for (int u = 0; u < 8; ++u) { const int kk = 16 * ((8 * (g + 1) + u + rot) & 63) + 8 * hh;
#pragma unroll
            for (int rt = 0; rt < 2; ++rt) { const bf16x8 a = *(const LAS bf16x8*)(HL + (32 * rt + l31) * RH_LD + kk); acc[rt] = MFMA32(a, b1[u], acc[rt]); } }
    }
}

FORCEINLINE void phase_hh_lr(const Args& A, LAS unsigned char* lds, int tid, int blk) {
    LAS bf16* HL = (LAS bf16*)lds;
    const int lane = tid & 63, wave = RFL(tid >> 6), l31 = lane & 31, hh = lane >> 5;
    const float* MOD = (const float*)(A.ws + WS_MOD) + 9 * 3072; const float* ssq = (const float*)(A.ws + WS_SSQ1); bf16* HH = (bf16*)(A.ws + WS_HH); const float* nw = A.in[I_NORMW] + 1024; const float* X1 = A.out;
    const bf16* WL = (const bf16*)(A.ws + WS_W4) + (size_t)(4096 + 32 * wave + l31) * 2048; bf16* LWA = (bf16*)(A.ws + WS_LWA);
    const int rbase = blk * 64;
    v2u hsp[8][4];
    BAR();
#pragma unroll
    for (int k = 0; k < 8; ++k) { const int rl = wave * 8 + k, r = rbase + rl;
        const float* md = MOD + cond_of_row(r) * 3072;
        int n0, n1, n2, n3; bool v0, v1, v2, v3; float wgt;
        if (r < MP) { const int t = r & 255; wgt = 0.5f; n0 = r - 1; v0 = t > 0; n1 = r + 1; v1 = t < 255; n2 = r; v2 = false; n3 = r; v3 = false; }
        else { const int t = (r - MP) & 1023, gr = t >> 6, gc = t & 63; wgt = 0.25f; n0 = r - 64; v0 = gr > 0; n1 = r + 64; v1 = gr < 15; n2 = r - 1; v2 = gc > 0; n3 = r + 1; v3 = gc < 63; }
        const int cnt = (int)v0 + (int)v1 + (int)v2 + (int)v3;
        const float rs = row_rstd16(ssq, r, lane);
        f32x4 acc[4];
#pragma unroll
        for (int j = 0; j < 4; ++j) acc[j] = (f32x4){0.f, 0.f, 0.f, 0.f};
#pragma unroll
        for (int q = 0; q < 4; ++q) { const int n = q == 0 ? n0 : q == 1 ? n1 : q == 2 ? n2 : n3; const bool vld = q == 0 ? v0 : q == 1 ? v1 : q == 2 ? v2 : v3;
            if (vld) { const float rn = row_rstd16(ssq, n, lane); const f32x4* xp = (const f32x4*)(X1 + (size_t)n * D) + lane;
#pragma unroll
                for (int j = 0; j < 4; ++j) acc[j] += xp[64 * j] * rn; } }
        const f32x4* xr = (const f32x4*)(X1 + (size_t)r * D) + lane;
#pragma unroll
        for (int j = 0; j < 4; ++j) { const int c = 256 * j + 4 * lane; const f32x4 w = *(const f32x4*)(nw + c), sh = *(const f32x4*)(md + c), sc = *(const f32x4*)(md + 1024 + c); const f32x4 cc = w * (sc + 1.f);
            const f32x4 h1 = (xr[64 * j] * rs) * cc + sh, hs = (acc[j] * cc + sh * (float)cnt) * wgt;
            const v2u p1 = (v2u){CVTPK(h1[0], h1[1]), CVTPK(h1[2], h1[3])}; hsp[k][j] = (v2u){CVTPK(hs[0], hs[1]), CVTPK(hs[2], hs[3])};
            *(v2u*)(HH + (size_t)r * 2048 + c) = p1; *(v2u*)(HH + (size_t)r * 2048 + 1024 + c) = hsp[k][j];
            *(LAS v2u*)(HL + rl * RH_LD + c) = p1; }
    }
    BAR();
    f32x16 acc2[2];
#pragma unroll
    for (int r = 0; r < 16; ++r) { acc2[0][r] = 0.f; acc2[1][r] = 0.f; }
    lr_pass(HL, WL, acc2, l31, hh, (blk * 8) & 63);
    BAR();
#pragma unroll
    for (int k = 0; k < 8; ++k)
#pragma unroll
        for (int j = 0; j < 4; ++j) *(LAS v2u*)(HL + (wave * 8 + k) * RH_LD + 256 * j + 4 * lane) = hsp[k][j];
    BAR();
    lr_pass(HL, WL + 1024, acc2, l31, hh, (blk * 8 + 32) & 63);
#pragma unroll
    for (int rt = 0; rt < 2; ++rt)
#pragma unroll
        for (int r = 0; r < 16; r += 2) { float a0 = acc2[rt][r], a1 = acc2[rt][r + 1];
            if (wave < 4) { a0 = 1.f - 2.f * FRCP(1.f + FEXP(2.f * a0)); a1 = 1.f - 2.f * FRCP(1.f + FEXP(2.f * a1)); }
            const unsigned pk = CVTPK(a0, a1); const int rho = 32 * rt + (r & 3) + 8 * (r >> 2) + 4 * hh;
            LWA[(size_t)(rbase + rho) * 256 + 32 * wave + l31] = (bf16)(pk & 0xffffu); LWA[(size_t)(rbase + rho + 1) * 256 + 32 * wave + l31] = (bf16)(pk >> 16); }
    BAR();
}
__device__ __forceinline__ void tr_item(const float* W, int N, bf16* WT, int ldo, int row_off, int col_off, const float* mu, int mode, LAS float* scr, int item, int lane) {
    const int nblk = N / 32, kb = item / nblk, nb = item % nblk, k0 = 64 * kb, n0 = 32 * nb;
#pragma unroll 8
    for (int i = 0; i < 32; ++i) { const int kk = 2 * i + (lane >> 5); float s = 1.f; if (mode) { const float m_ = mu[k0 + kk]; s = mode == 1 ? 1.f - m_ : m_; }
        scr[kk * 33 + (lane & 31)] = W[(size_t)(k0 + kk) * N + n0 + (lane & 31)] * s; }
    LDS_WAIT(); asm volatile("" ::: "memory");
    const int c = lane & 7;
#pragma unroll
    for (int j = 0; j < 4; ++j) { const int n = (lane >> 3) + 8 * j; const LAS float* s = scr + (8 * c) * 33 + n;
        v4u o; o.x = pk2(s[0 * 33], s[1 * 33]); o.y = pk2(s[2 * 33], s[3 * 33]); o.z = pk2(s[4 * 33], s[5 * 33]); o.w = pk2(s[6 * 33], s[7 * 33]);
        *(v4u*)(WT + (size_t)(row_off + n0 + n) * ldo + col_off + k0 + 8 * c) = o; }
    LDS_WAIT(); asm volatile("" ::: "memory");
}
__device__ __forceinline__ void phase0(const Args& A, LAS unsigned char* lds, int tid, int lane, int wave) {
    __syncthreads();
    unsigned char* ws = A.ws;
    const int G = gridDim.x, blk = blockIdx.x;
    {
        LAS float* scond = (LAS float*)lds;
        LAS float* red = scond + 9 * 1024;
        bool filled = false;
        for (int item = blk; item < 96; item += G) {
            if (!filled) {
                for (int idx = tid; idx < 9 * 1024; idx += NTHR) { const int r = idx >> 10, k = idx & 1023; const float c = r == 0 ? A.in[I_CCTX][k] : A.in[I_C][(r - 1) * 1024 + k]; scond[idx] = silu_f(c); }
                filled = true;
            }
            __syncthreads();
            const int l = item / 48, g = item % 48, col = g * 64 + lane;
            float acc[9];
#pragma unroll
            for (int r = 0; r < 9; ++r) acc[r] = 0.f;
            const float* wp = A.in[I_WMOD] + ((size_t)l * 1024 + wave * 128) * 3072 + col;
#pragma unroll 4
            for (int k = 0; k < 128; ++k) { const float wv = wp[(size_t)k * 3072];
#pragma unroll
                for (int r = 0; r < 9; ++r) acc[r] += scond[r * 1024 + wave * 128 + k] * wv; }
#pragma unroll
            for (int r = 0; r < 9; ++r) red[(wave * 9 + r) * 64 + lane] = acc[r];
            __syncthreads();
            for (int idx = tid; idx < 576; idx += NTHR) { const int r = idx >> 6, ln = idx & 63; float s = A.in[I_BMOD][l * 3072 + g * 64 + ln];
#pragma unroll
                for (int w = 0; w < 8; ++w) s += red[(w * 9 + r) * 64 + ln];
                ((float*)(ws + WS_MOD))[(l * 9 + r) * 3072 + g * 64 + ln] = s; }
            __syncthreads();
        }
        __syncthreads();
    }
    LAS float* scr = (LAS float*)(lds + wave * 16384);
    const int gw = blk * NWAVES + wave, NGW = G * NWAVES;
    bf16* WIN = (bf16*)(ws + WS_WIN); bf16* WO0 = (bf16*)(ws + WS_WO0);
    constexpr int I_IN = 16 * 96, I_SQ = 16 * 32;
    constexpr int NITEMS = I_IN + I_SQ;
    for (int it = gw; it < NITEMS; it += NGW) {
        int r = it;
        if (r < I_IN) { tr_item(A.in[I_GWIN], 3072, WIN, 1024, 0, 0, nullptr, 0, scr, r, lane); continue; } r -= I_IN;
        tr_item(A.in[I_GWOUT], 1024, WO0, 1024, 0, 0, nullptr, 0, scr, r, lane);
    }
    const int gt = blk * NTHR + tid, NGT = G * NTHR;
    for (int idx = gt; idx < 2 * 16 * 1024; idx += NGT) { const int k = idx & 1023, j = (idx >> 10) & 15, d = idx >> 14;
        WIN[(size_t)(3072 + d * 16 + j) * 1024 + k] = (bf16)f2bf(A.in[I_GWA1][((size_t)d * 1024 + k) * 16 + j]); }
}

__device__ __forceinline__ void transposes_l1(const Args& A, LAS unsigned char* lds, int lane, int wave, int widx, int nw) {
    LAS float* scr = (LAS float*)(lds + wave * 16384);
    bf16* W4 = (bf16*)(A.ws + WS_W4); bf16* WO1 = (bf16*)(A.ws + WS_WO1);
    constexpr int I_SQ = 16 * 32, I_LR = 16 * 2;
    constexpr int NITEMS = 8 * I_SQ + 8 * I_LR + I_SQ;
    for (int it = widx; it < NITEMS; it += nw) {
        int r = it;
        if (r < 8 * I_SQ) { const int p = r / (2 * I_SQ), hf = (r / I_SQ) & 1; tr_item(A.in[I_WRKVG] + (size_t)p * 1024 * 1024, 1024, W4, 2048, p * 1024, hf * 1024, A.in[I_MU] + p * 1024, 1 + hf, scr, r % I_SQ, lane); continue; } r -= 8 * I_SQ;
        if (r < 8 * I_LR) { const int q = r / I_LR, which = q >> 2, d = (q >> 1) & 1, hf = q & 1;
            tr_item((which ? A.in[I_A1] : A.in[I_W1]) + (size_t)d * 1024 * 64, 64, W4, 2048, 4096 + which * 128 + d * 64, hf * 1024, A.in[I_MU] + (4 + which) * 1024, 1 + hf, scr, r % I_LR, lane); continue; } r -= 8 * I_LR;
        tr_item(A.in[I_RWOUT], 1024, WO1, 1024, 0, 0, nullptr, 0, scr, r, lane);
    }
}

__device__ __forceinline__ const float* xrow_in(const Args& A, int r) { return r < MP ? A.in[I_XP] + (size_t)r * D : A.in[I_XS] + (size_t)(r - MP) * D; }
__device__ __forceinline__ int cond_of(int r) { return r < MP ? 0 : 1 + ((r - MP) >> 10); }
__device__ __forceinline__ void store_bf4(bf16* p, f32x4 v) { *(unsigned long long*)p = (unsigned long long)pk2(v[0], v[1]) | ((unsigned long long)pk2(v[2], v[3]) << 32); }
__device__ __forceinline__ f32x4 load_bf4(const bf16* p) { const unsigned long long w = *(const unsigned long long*)p; const unsigned lo = (unsigned)w, hi = (unsigned)(w >> 32);
    return (f32x4){__uint_as_float(lo << 16), __uint_as_float(lo & 0xffff0000u), __uint_as_float(hi << 16), __uint_as_float(hi & 0xffff0000u)}; }

__device__ __forceinline__ void phase_og0(const Args& A, int lane, int gw, int NGW) {
    const bf16* OF = (const bf16*)(A.ws + WS_OF); const bf16* OB = (const bf16*)(A.ws + WS_OB); const bf16* G0 = (const bf16*)(A.ws + WS_G0); bf16* OG = (bf16*)(A.ws + WS_ABUF);
    const f32x4 wn = *(const f32x4*)(A.in[I_GNORM] + 4 * lane);
    for (int r = gw; r < M; r += NGW) {
#pragma unroll
        for (int j = 0; j < 4; ++j) { const size_t o = (size_t)r * D + 256 * j + 4 * lane; const f32x4 v = load_bf4(OF + o) + load_bf4(OB + o);
            const float ms = wave_sum((v[0] * v[0] + v[1] * v[1]) + (v[2] * v[2] + v[3] * v[3])) * (1.f / 256.f); const float rs = 1.f / sqrtf(ms + EPS);
            const f32x4 g = load_bf4(G0 + o); f32x4 y = v * rs * wn;
            y[0] *= silu_f(g[0]); y[1] *= silu_f(g[1]); y[2] *= silu_f(g[2]); y[3] *= silu_f(g[3]);
            store_bf4(OG + o, y); }
    }
}
__device__ __forceinline__ float row_rstd(const float* ssq, int r, int lane) { float s = lane < 16 ? ssq[(size_t)r * 16 + lane] : 0.f; return 1.f / sqrtf(wave_sum(s) * (1.f / D) + EPS); }
__device__ __forceinline__ void phase_og1(const Args& A, int lane, int gw, int NGW) {
    const bf16* YF = (const bf16*)(A.ws + WS_YF); const bf16* YB = (const bf16*)(A.ws + WS_YB); const bf16* V1 = (const bf16*)(A.ws + WS_V1); const bf16* G1 = (const bf16*)(A.ws + WS_G1);
    const float* BON = (const float*)(A.ws + WS_BONUS); bf16* OG = (bf16*)(A.ws + WS_OG1);
    for (int r = gw; r < M; r += NGW) {
#pragma unroll
        for (int j = 0; j < 4; ++j) { const int c = 256 * j + 4 * lane, h = c >> 6; const size_t o = (size_t)r * D + c; const f32x4 y = load_bf4(YF + o) + load_bf4(YB + o);
            float s = (y[0] + y[1]) + (y[2] + y[3]);
            s += __shfl_xor(s, 1); s += __shfl_xor(s, 2); s += __shfl_xor(s, 4); s += __shfl_xor(s, 8);
            const float mean = s * (1.f / 64.f); const f32x4 dv = y - mean; float q = (dv[0] * dv[0] + dv[1] * dv[1]) + (dv[2] * dv[2] + dv[3] * dv[3]);
            q += __shfl_xor(q, 1); q += __shfl_xor(q, 2); q += __shfl_xor(q, 4); q += __shfl_xor(q, 8);
            const float rs = 1.f / sqrtf(q * (1.f / 64.f) + LNX_EPS);
            const f32x4 lw = *(const f32x4*)(A.in[I_LNW] + c), lb = *(const f32x4*)(A.in[I_LNB] + c);
            const float bon = BON[((size_t)r * 16 + h) * 2] + BON[((size_t)r * 16 + h) * 2 + 1];
            const f32x4 v = load_bf4(V1 + o), g = load_bf4(G1 + o);
            f32x4 z = dv * rs * lw + lb + v * bon;
            z[0] *= silu_f(g[0]); z[1] *= silu_f(g[1]); z[2] *= silu_f(g[2]); z[3] *= silu_f(g[3]);
            store_bf4(OG + o, z); }
    }
}
__device__ __forceinline__ void phase_final(const Args& A, int lane, int gw, int NGW) {
    const float* ssq = (const float*)(A.ws + WS_SSQ2); const float* nf = A.in[I_NORMF];
    for (int r = gw; r < M; r += NGW) {
        const float rs = row_rstd(ssq, r, lane); f32x4* xr = (f32x4*)(A.out + (size_t)r * D) + lane;
#pragma unroll
        for (int j = 0; j < 4; ++j) { const f32x4 w = *(const f32x4*)(nf + 256 * j + 4 * lane); xr[64 * j] = xr[64 * j] * rs * w; }
    }
}

__global__ void __launch_bounds__(NTHR, 2) trunk_fwd(Args args) {
    extern __shared__ __attribute__((aligned(16))) unsigned char lds_raw[];
    LAS unsigned char* lds = (LAS unsigned char*)lds_raw;
    const int tid = threadIdx.x, lane = tid & 63, wave = __builtin_amdgcn_readfirstlane(tid >> 6);
    const int G = gridDim.x, gw = blockIdx.x * NWAVES + wave, NGW = G * NWAVES;
    volatile LAS unsigned* MISC = (volatile LAS unsigned*)(lds + MISC_OFF);
    for (int u = tid; u < (LDS_BYTES - LDSCTL_OFF) / 4; u += NTHR) ((LAS unsigned*)(lds + LDSCTL_OFF))[u] = 0u;
    __syncthreads();
    unsigned char* ws = args.ws;
    XcdBarrier bar; bar.bar = (unsigned*)(ws + WS_CTL) + CW_BAR; bar.x = 0; bar.st = nullptr;
    if (N_LAUNCHES == 1) bar = xcd_barrier_post((unsigned*)(ws + WS_CTL) + CW_BAR, MISC + 8);
    const int lo = args.ph_lo, hi = args.ph_hi;
#ifndef PROBE_MASK
#define PROBE_MASK 0
#endif
#define REP(k) for (int rep_ = 0; rep_ < (((PROBE_MASK) >> (k)) & 1) + 1; ++rep_)
#define IN(k) (lo <= (k) && (k) < hi)
#ifdef PROBE_EXTRA_BAR
#define SEAM(k) do { if (IN(k) && IN((k) + 1)) { xcd_barrier(bar); xcd_barrier(bar); } } while (0)
#else
#define SEAM(k) do { if (IN(k) && IN((k) + 1)) xcd_barrier(bar); } while (0)
#endif
    if (IN(0)) REP(0) { phase0(args, lds, tid, lane, wave); } SEAM(0);
    if (IN(1)) REP(1) { phase_h0_ha(args, lds, tid, (int)blockIdx.x); } SEAM(1);
    if (IN(2)) REP(2) {
        pg8::Gemm g{(const pg8::bf16_t*)(ws + WS_ABUF), (const pg8::bf16_t*)(ws + WS_WIN), M, 3072, 1024}; pg8::StaticOrder S; S.init(M, 3072, G, (int)blockIdx.x);
        pg8::EpiPlanes<0> E{ws};
        pg8::gemm_phase<pg8::EpiPlanes<0>, pg8::StaticOrder, true, true>(lds, g, S, E);
    } SEAM(2);
        if (IN(3)) REP(3) { phase_gla_chunk(args, lds, tid, (int)blockIdx.x); if (blockIdx.x >= 64) transposes_l1(args, lds, lane, wave, ((int)blockIdx.x - 64) * NWAVES + wave, (G - 64) * NWAVES); } SEAM(3);
    if (IN(4)) REP(4) { phase_og0(args, lane, gw, NGW); } SEAM(4);
    if (IN(5)) REP(5) {
        pg8::Gemm g{(const pg8::bf16_t*)(ws + WS_ABUF), (const pg8::bf16_t*)(ws + WS_WO0), M, 1024, 1024}; pg8::StaticOrder S; S.init(M, 1024, G, (int)blockIdx.x);
        pg8::EpiRes E{args.in[I_XP], args.in[I_XS], args.out, (const float*)(ws + WS_MOD) + 2048, (float*)(ws + WS_SSQ1)};
        pg8::gemm_phase<pg8::EpiRes, pg8::StaticOrder, true, true>(lds, g, S, E);
    } SEAM(5);
    if (IN(6)) REP(6) { phase_hh_lr(args, lds, tid, (int)blockIdx.x); } SEAM(6);
    if (IN(7)) REP(7) {
        pg8::Gemm g{(const pg8::bf16_t*)(ws + WS_HH), (const pg8::bf16_t*)(ws + WS_W4), M, 4096, 2048}; pg8::StaticOrder S; S.init(M, 4096, G, (int)blockIdx.x);
        pg8::EpiPlanes<1> E{ws};
        pg8::gemm_phase<pg8::EpiPlanes<1>, pg8::StaticOrder, true, true>(lds, g, S, E);
    } SEAM(7);
        if (IN(8)) REP(8) { phase_rwkv_chunk(args, lds, tid, (int)blockIdx.x, args.li >= 100 ? args.li - 100 : 0); } SEAM(8);
    if (IN(9)) REP(9) { phase_og1(args, lane, gw, NGW); } SEAM(9);
    if (IN(10)) REP(10) {
        pg8::Gemm g{(const pg8::bf16_t*)(ws + WS_OG1), (const pg8::bf16_t*)(ws + WS_WO1), M, 1024, 1024}; pg8::StaticOrder S; S.init(M, 1024, G, (int)blockIdx.x);
        pg8::EpiRes E{args.out, args.out + OUT_YS, args.out, (const float*)(ws + WS_MOD) + 9 * 3072 + 2048, (float*)(ws + WS_SSQ2)};
        pg8::gemm_phase<pg8::EpiRes, pg8::StaticOrder, true, true>(lds, g, S, E);
    } SEAM(10);
    if (IN(11)) REP(11) { phase_final(args, lane, gw, NGW); }
#undef IN
#undef SEAM
}

extern "C" void kernel_launch(void* const* d_in, const int* in_sizes, int n_in, void* d_out, int out_size, void* d_ws, size_t ws_size, hipStream_t stream) {
    static int grid = 0;
    if (grid == 0) {
        if (n_in != 30 || ws_size < WS_END) { fprintf(stderr, "kernel_launch: built for 30 inputs and >= %zu bytes of workspace; got n_in %d ws %zu\n", (size_t)WS_END, n_in, ws_size); grid = -1; return; }
        int dev = 0, cus = 0, per_cu = 0;
        if (hipGetDevice(&dev) != hipSuccess || hipDeviceGetAttribute(&cus, hipDeviceAttributeMultiprocessorCount, dev) != hipSuccess) { grid = -1; return; }
        if (hipFuncSetAttribute((const void*)trunk_fwd, hipFuncAttributeMaxDynamicSharedMemorySize, LDS_BYTES) != hipSuccess) { fprintf(stderr, "kernel_launch: hipFuncSetAttribute failed\n"); grid = -1; return; }
        if (hipOccupancyMaxActiveBlocksPerMultiprocessor(&per_cu, (const void*)trunk_fwd, NTHR, LDS_BYTES) != hipSuccess || per_cu < 1) { fprintf(stderr, "kernel_launch: occupancy query reports %d workgroups per CU\n", per_cu); per_cu = 1; }
        (void)hipGetLastError();
        grid = cus;
        if (grid > 256) grid = 256;
    }
    if (grid < 0) return;
    (void)hipMemsetAsync((char*)d_ws + WS_CTL, 0, CTL_ZERO_BYTES, stream);
    Args a{};
    for (int i = 0; i < 30; ++i) a.in[i] = (const float*)d_in[i];
    a.out = (float*)d_out; a.ws = (unsigned char*)d_ws;
    if (N_LAUNCHES == 1) {
        a.ph_lo = 0; a.ph_hi = N_PHASES; a.li = 0;
        void* kargs[] = {&a};
        hipError_t e = hipLaunchCooperativeKernel((const void*)trunk_fwd, dim3(grid), dim3(NTHR), kargs, LDS_BYTES, stream);
        if (e != hipSuccess) fprintf(stderr, "kernel_launch: cooperative launch failed: %s (grid %d)\n", hipGetErrorString(e), grid);
    } else {
        for (int li = 0; li < N_PHASES; ++li) { a.ph_lo = li; a.ph_hi = li + 1; a.li = li;
            hipLaunchKernelGGL(trunk_fwd, dim3(grid), dim3(NTHR), LDS_BYTES, stream, a);
#ifdef PROBE_LAUNCH_REPEAT
            if (li == PROBE_LAUNCH_REPEAT) hipLaunchKernelGGL(trunk_fwd, dim3(grid), dim3(NTHR), LDS_BYTES, stream, a);
#endif
#ifdef PROBE_GLA_MODE
            if (li == 3) { a.li = 200 + PROBE_GLA_MODE; hipLaunchKernelGGL(trunk_fwd, dim3(grid), dim3(NTHR), LDS_BYTES, stream, a); }
#endif
#ifdef PROBE_RW_MODE
            if (li == 8) { a.li = 100 + PROBE_RW_MODE; hipLaunchKernelGGL(trunk_fwd, dim3(grid), dim3(NTHR), LDS_BYTES, stream, a); }
#endif
        }
    }
}
```
